# Optimizing an MI355X kernel written in HIP

```python
import jax, jax.numpy as jnp
from jax import lax
import numpy as np

D_MODEL = 1024
BATCH = 8
SEQ = 2048
DEPTH = 2

GRID_W = 64
CTX_LEN = 256
HEAD_DIM = 64
EPS = 1e-6
A_W = 512
A_IN = 2 * A_W
CONV_K = 31
B_HQ = 8
B_HKV = 2
B_GROUP = B_HQ // B_HKV
B_Q = B_HQ * HEAD_DIM
B_KV = B_HKV * HEAD_DIM
AB_COLS = A_IN + B_Q + 2 * B_KV
ROPE_THETA = 10000.0
Q_BLOCK = 128
C_W = 512
C_IN = 2 * C_W
CHUNK = 128
C_GROUPS = 8
C_GROUP_W = C_W // C_GROUPS
D_HEADS = 8
D_W = D_HEADS * HEAD_DIM
WIN_R = 8
WIN_C = 16
CD_COLS = C_IN + 3 * D_W
MIX_W = A_W + B_Q
N_EXPERTS = 64
TOP_K = 8
N_GROUPS = 8
TOPK_GROUPS = 4
EXPERT_F = 256
SHARED_F = 256
ROUTED_SCALE = 2.5
EXPERT_BLOCK = 256

kernel_name = "hybrid_conv_gqa_gmlp_natten_moe_dit"


def rms_norm(x, g):
    xf = x.astype(jnp.float32)
    y = xf * lax.rsqrt(jnp.mean(xf * xf, axis=-1, keepdims=True) + EPS)
    return (y * g.astype(jnp.float32)).astype(x.dtype)


def layer_norm(x, g, b):
    xf = x.astype(jnp.float32)
    mu = jnp.mean(xf, axis=-1, keepdims=True)
    var = jnp.mean(jnp.square(xf - mu), axis=-1, keepdims=True)
    y = (xf - mu) * lax.rsqrt(var + EPS)
    return (y * g.astype(jnp.float32) + b.astype(jnp.float32)).astype(x.dtype)


def adaln(cond, w, b):
    m = jax.nn.silu(cond) @ w + b
    return m.reshape(cond.shape[0], 6, -1).transpose(1, 0, 2)[:, :, None, :]


def modulate(h, shift, scale):
    return h * (1 + scale) + shift


def axial_rope_tables(t):
    pos = jnp.arange(t)
    row = (pos // GRID_W).astype(jnp.float32)
    col = (pos % GRID_W).astype(jnp.float32)
    nf = HEAD_DIM // 4
    inv = ROPE_THETA ** (-jnp.arange(nf, dtype=jnp.float32) / nf)
    ar = row[:, None] * inv
    ac = col[:, None] * inv
    return (jnp.cos(ar), jnp.sin(ar), jnp.cos(ac), jnp.sin(ac))


def rotate(x, cos, sin):
    f = x.shape[-1] // 2
    x1, x2 = x[..., :f], x[..., f:]
    cs = cos[None, :, None, :].astype(x.dtype)
    sn = sin[None, :, None, :].astype(x.dtype)
    return jnp.concatenate([x1 * cs - x2 * sn, x2 * cs + x1 * sn], axis=-1)


def rope_2d(x, cos_r, sin_r, cos_c, sin_c):
    half = x.shape[-1] // 2
    return jnp.concatenate([rotate(x[..., :half], cos_r, sin_r),
                            rotate(x[..., half:], cos_c, sin_c)], axis=-1)


def softmax_attend(q, k, v):
    s = jnp.einsum('bqhgd,bkhd->bhgqk', q, k).astype(jnp.float32) * (q.shape[-1] ** -0.5)
    p = jax.nn.softmax(s, axis=-1).astype(v.dtype)
    return jnp.einsum('bhgqk,bkhd->bqhgd', p, v)


def blockwise_gqa(q, k, v, kc, vc):
    bsz, t = q.shape[:2]
    k_all = jnp.concatenate([k, kc], axis=1)
    v_all = jnp.concatenate([v, vc], axis=1)
    qb = q.reshape(bsz, t // Q_BLOCK, Q_BLOCK, B_HKV, B_GROUP, HEAD_DIM).transpose(1, 0, 2, 3, 4, 5)
    o = lax.map(lambda qi: softmax_attend(qi, k_all, v_all), qb)
    return o.transpose(1, 0, 2, 3, 4, 5).reshape(bsz, t, B_Q)


def depthwise_conv(x, w, b):
    y = lax.conv_general_dilated(x, w[:, None, :].astype(x.dtype), window_strides=(1,),
                                 padding=[(CONV_K // 2, CONV_K // 2)],
                                 dimension_numbers=('NWC', 'WIO', 'NWC'),
                                 feature_group_count=x.shape[-1])
    return y + b


def conformer_conv(z, conv_w, conv_b, ln_g, ln_b):
    a, g = z[..., :A_W], z[..., A_W:]
    y = depthwise_conv(a * jax.nn.sigmoid(g), conv_w, conv_b)
    return jax.nn.silu(layer_norm(y, ln_g, ln_b))


def spatial_gating(z, ln_g, ln_b, w_s, b_s):
    z = jax.nn.gelu(z, approximate=False)
    u, v = z[..., :C_W], z[..., C_W:]
    v = layer_norm(v, ln_g, ln_b)
    bsz, l, _ = v.shape
    vc = v.reshape(bsz, l // CHUNK, CHUNK, C_GROUPS, C_GROUP_W)
    s = jnp.einsum('gpq,bnqgc->bnpgc', w_s, vc) + b_s.T[None, None, :, :, None]
    return u * s.reshape(bsz, l, C_W)


def neighbourhood_attention(q, k, v, kc, vc, rpb):
    bsz, t, h, dh = q.shape
    rows = t // GRID_W
    wr = min(WIN_R, rows)
    qg = q.reshape(bsz, rows, GRID_W, h, dh)
    kg = k.reshape(bsz, rows, GRID_W, h, dh)
    vg = v.reshape(bsz, rows, GRID_W, h, dh)
    cols = np.arange(GRID_W)
    c_start = np.clip(cols - WIN_C // 2, 0, GRID_W - WIN_C)
    col_idx = c_start[:, None] + np.arange(WIN_C)[None, :]
    rpb_c = rpb[:, :, col_idx - cols[:, None] + WIN_C - 1]
    scale = dh ** -0.5

    def row_block(r):
        rs = jnp.clip(r - wr // 2, 0, rows - wr)
        q_r = lax.dynamic_index_in_dim(qg, r, axis=1, keepdims=False)
        k_nb = lax.dynamic_slice_in_dim(kg, rs, wr, axis=1)[:, :, col_idx]
        v_nb = lax.dynamic_slice_in_dim(vg, rs, wr, axis=1)[:, :, col_idx]
        dr = rs + jnp.arange(wr) - r + WIN_R - 1
        bias = jnp.take(rpb_c, dr, axis=1).transpose(0, 2, 1, 3)
        s_nb = jnp.einsum('bqhd,bkqjhd->bhqkj', q_r, k_nb).astype(jnp.float32) * scale
        s_nb = (s_nb + bias[None].astype(jnp.float32)).reshape(bsz, h, GRID_W, wr * WIN_C)
        s_cx = jnp.einsum('bqhd,bkhd->bhqk', q_r, kc).astype(jnp.float32) * scale
        p = jax.nn.softmax(jnp.concatenate([s_nb, s_cx], axis=-1), axis=-1).astype(v.dtype)
        p_nb = p[..., :wr * WIN_C].reshape(bsz, h, GRID_W, wr, WIN_C)
        p_cx = p[..., wr * WIN_C:]
        return (jnp.einsum('bhqkj,bkqjhd->bqhd', p_nb, v_nb)
                + jnp.einsum('bhqk,bkhd->bqhd', p_cx, vc))

    o = lax.map(row_block, jnp.arange(rows))
    return o.transpose(1, 0, 2, 3, 4).reshape(bsz, t, h * dh)


def mixer_ab(h, hc, rope, w_in, w_out, conv_w, conv_b, cln_g, cln_b, qn_g, kn_g, last):
    bsz, t, _ = h.shape
    nc = hc.shape[1]
    z = h @ w_in
    q = rms_norm(z[..., A_IN:A_IN + B_Q].reshape(bsz, t, B_HQ, HEAD_DIM), qn_g)
    k = rms_norm(z[..., A_IN + B_Q:A_IN + B_Q + B_KV].reshape(bsz, t, B_HKV, HEAD_DIM), kn_g)
    v = z[..., A_IN + B_Q + B_KV:].reshape(bsz, t, B_HKV, HEAD_DIM)
    q, k = rope_2d(q, *rope), rope_2d(k, *rope)
    kv_off = A_IN + B_Q
    zc = hc @ (w_in[:, kv_off:] if last else w_in)
    base = 0 if last else kv_off
    kc = rms_norm(zc[..., base:base + B_KV].reshape(bsz, nc, B_HKV, HEAD_DIM), kn_g)
    vc = zc[..., base + B_KV:base + 2 * B_KV].reshape(bsz, nc, B_HKV, HEAD_DIM)
    ya = conformer_conv(z[..., :A_IN], conv_w, conv_b, cln_g, cln_b)
    yb = blockwise_gqa(q, k, v, kc, vc)
    out = jnp.concatenate([ya, yb], axis=-1) @ w_out
    if last:
        return out, None
    qc = rms_norm(zc[..., A_IN:A_IN + B_Q].reshape(bsz, nc, B_HQ, HEAD_DIM), qn_g)
    yac = conformer_conv(zc[..., :A_IN], conv_w, conv_b, cln_g, cln_b)
    ybc = softmax_attend(qc.reshape(bsz, nc, B_HKV, B_GROUP, HEAD_DIM), kc, vc).reshape(bsz, nc, B_Q)
    outc = jnp.concatenate([yac, ybc], axis=-1) @ w_out
    return out, outc


def mixer_cd(h, hc, w_in, w_out, sg_ln_g, sg_ln_b, sg_w, sg_b, rpb, last):
    bsz, t, _ = h.shape
    nc = hc.shape[1]
    z = h @ w_in
    q = z[..., C_IN:C_IN + D_W].reshape(bsz, t, D_HEADS, HEAD_DIM)
    k = z[..., C_IN + D_W:C_IN + 2 * D_W].reshape(bsz, t, D_HEADS, HEAD_DIM)
    v = z[..., C_IN + 2 * D_W:].reshape(bsz, t, D_HEADS, HEAD_DIM)
    kv_off = C_IN + D_W
    zc = hc @ (w_in[:, kv_off:] if last else w_in)
    base = 0 if last else kv_off
    kc = zc[..., base:base + D_W].reshape(bsz, nc, D_HEADS, HEAD_DIM)
    vc = zc[..., base + D_W:base + 2 * D_W].reshape(bsz, nc, D_HEADS, HEAD_DIM)
    yc = spatial_gating(z[..., :C_IN], sg_ln_g, sg_ln_b, sg_w, sg_b)
    yd = neighbourhood_attention(q, k, v, kc, vc, rpb)
    out = jnp.concatenate([yc, yd], axis=-1) @ w_out
    if last:
        return out, None
    qc = zc[..., C_IN:C_IN + D_W].reshape(bsz, nc, D_HEADS, 1, HEAD_DIM)
    ycc = spatial_gating(zc[..., :C_IN], sg_ln_g, sg_ln_b, sg_w, sg_b)
    ydc = softmax_attend(qc, kc, vc).reshape(bsz, nc, D_W)
    outc = jnp.concatenate([ycc, ydc], axis=-1) @ w_out
    return out, outc


def swiglu(h, wg, wu, wd):
    return (jax.nn.silu(h @ wg) * (h @ wu)) @ wd


def moe_ffn(h, w_router, b_router, w_gate, w_up, w_down, ws_gate, ws_up, ws_down):
    n, d = h.shape
    scores = jax.nn.sigmoid(h.astype(jnp.float32) @ w_router.astype(jnp.float32))
    biased = scores + b_router.astype(jnp.float32)
    per_group = N_EXPERTS // N_GROUPS
    group_score = lax.top_k(biased.reshape(n, N_GROUPS, per_group), 2)[0].sum(-1)
    _, top_groups = lax.top_k(group_score, TOPK_GROUPS)
    group_ok = jax.nn.one_hot(top_groups, N_GROUPS, dtype=jnp.float32).sum(1) > 0
    allowed = jnp.repeat(group_ok, per_group, axis=1)
    _, idx = lax.top_k(jnp.where(allowed, biased, -jnp.inf), TOP_K)
    gate = jnp.take_along_axis(scores, idx, axis=1)
    gate = gate / jnp.sum(gate, axis=-1, keepdims=True) * ROUTED_SCALE
    nk = n * TOP_K
    flat_e = idx.reshape(-1)
    order = jnp.argsort(flat_e)
    se = flat_e[order]
    counts = jnp.bincount(flat_e, length=N_EXPERTS)
    padded = (counts + EXPERT_BLOCK - 1) // EXPERT_BLOCK * EXPERT_BLOCK
    pad_end = jnp.cumsum(padded)
    pad_start = pad_end - padded
    cnt_start = jnp.cumsum(counts) - counts
    dest_sorted = (pad_start[se] + jnp.arange(nk) - cnt_start[se]).astype(jnp.int32)
    dest = jnp.zeros((nk,), jnp.int32).at[order].set(dest_sorted)
    n_blocks = -(-nk // EXPERT_BLOCK) + N_EXPERTS
    slots = n_blocks * EXPERT_BLOCK
    slot_tok = jnp.full((slots,), n, jnp.int32).at[dest].set(jnp.arange(nk, dtype=jnp.int32) // TOP_K)
    block_e = jnp.minimum(jnp.searchsorted(pad_end, jnp.arange(n_blocks) * EXPERT_BLOCK, side='right'),
                          N_EXPERTS - 1)
    h_pad = jnp.concatenate([h, jnp.zeros((1, d), h.dtype)], axis=0)
    xb = h_pad[slot_tok].reshape(n_blocks, EXPERT_BLOCK, d)

    def run_block(args):
        xblk, e = args
        return swiglu(xblk, w_gate[e], w_up[e], w_down[e])

    yb = lax.map(run_block, (xb, block_e)).reshape(slots, d)
    routed = jnp.sum(yb[dest].reshape(n, TOP_K, d) * gate.astype(h.dtype)[..., None], axis=1)
    return routed + swiglu(h, ws_gate, ws_up, ws_down)


def setup_inputs(seed: int = 0) -> dict:
    key = jax.random.key(seed)
    keys = iter(jax.random.split(key, 64))
    d = D_MODEL
    ne, no = (DEPTH + 1) // 2, DEPTH // 2

    def nrm(shape, scale):
        return jax.random.normal(next(keys), shape, jnp.float32) * scale

    return {
        "x": nrm((BATCH, SEQ, d), 1.0),
        "c": nrm((BATCH, d), 1.0),
        "ctx": nrm((BATCH, CTX_LEN, d), 1.0),
        "c_ctx": nrm((d,), 1.0),
        "norm_g": 1.0 + nrm((DEPTH, 2, d), 0.05),
        "w_ada": nrm((DEPTH, d, 6 * d), 0.5 * d ** -0.5),
        "b_ada": nrm((DEPTH, 6 * d), 0.02),
        "w_in_ab": nrm((ne, d, AB_COLS), d ** -0.5),
        "w_out_ab": nrm((ne, MIX_W, d), MIX_W ** -0.5),
        "conv_w": nrm((ne, CONV_K, A_W), CONV_K ** -0.5),
        "conv_b": nrm((ne, A_W), 0.02),
        "conv_ln_g": 1.0 + nrm((ne, A_W), 0.05),
        "conv_ln_b": nrm((ne, A_W), 0.02),
        "qn_g": 1.0 + nrm((ne, HEAD_DIM), 0.05),
        "kn_g": 1.0 + nrm((ne, HEAD_DIM), 0.05),
        "w_in_cd": nrm((no, d, CD_COLS), d ** -0.5),
        "w_out_cd": nrm((no, MIX_W, d), MIX_W ** -0.5),
        "sg_ln_g": 1.0 + nrm((no, C_W), 0.05),
        "sg_ln_b": nrm((no, C_W), 0.02),
        "sg_w": nrm((no, C_GROUPS, CHUNK, CHUNK), CHUNK ** -0.5),
        "sg_b": 1.0 + nrm((no, C_GROUPS, CHUNK), 0.05),
        "na_rpb": nrm((no, D_HEADS, 2 * WIN_R - 1, 2 * WIN_C - 1), 0.5),
        "w_router": nrm((DEPTH, d, N_EXPERTS), d ** -0.5),
        "b_router": nrm((DEPTH, N_EXPERTS), 0.01),
        "w_gate": nrm((DEPTH, N_EXPERTS, d, EXPERT_F), d ** -0.5),
        "w_up": nrm((DEPTH, N_EXPERTS, d, EXPERT_F), d ** -0.5),
        "w_down": nrm((DEPTH, N_EXPERTS, EXPERT_F, d), EXPERT_F ** -0.5),
        "ws_gate": nrm((DEPTH, d, SHARED_F), d ** -0.5),
        "ws_up": nrm((DEPTH, d, SHARED_F), d ** -0.5),
        "ws_down": nrm((DEPTH, SHARED_F, d), SHARED_F ** -0.5),
        "g_final": 1.0 + nrm((d,), 0.05),
    }


def reference(x, c, ctx, c_ctx, norm_g, w_ada, b_ada, w_in_ab, w_out_ab, conv_w, conv_b, conv_ln_g,
              conv_ln_b, qn_g, kn_g, w_in_cd, w_out_cd, sg_ln_g, sg_ln_b, sg_w, sg_b, na_rpb,
              w_router, b_router, w_gate, w_up, w_down, ws_gate, ws_up, ws_down, g_final):
    bsz, t, d = x.shape
    rope = axial_rope_tables(t)
    xc = ctx
    for i in range(DEPTH):
        last = i == DEPTH - 1
        j = i // 2
        m = adaln(c, w_ada[i], b_ada[i])
        mc = adaln(c_ctx[None], w_ada[i], b_ada[i])
        h = modulate(rms_norm(x, norm_g[i, 0]), m[0], m[1])
        hc = modulate(rms_norm(xc, norm_g[i, 0]), mc[0], mc[1])
        if i % 2 == 0:
            y, yc = mixer_ab(h, hc, rope, w_in_ab[j], w_out_ab[j], conv_w[j], conv_b[j],
                             conv_ln_g[j], conv_ln_b[j], qn_g[j], kn_g[j], last)
        else:
            y, yc = mixer_cd(h, hc, w_in_cd[j], w_out_cd[j], sg_ln_g[j], sg_ln_b[j],
                             sg_w[j], sg_b[j], na_rpb[j], last)
        x = x + m[2] * y
        h = modulate(rms_norm(x, norm_g[i, 1]), m[3], m[4])
        moe_args = (w_router[i], b_router[i], w_gate[i], w_up[i], w_down[i],
                    ws_gate[i], ws_up[i], ws_down[i])
        if last:
            x = x + m[5] * moe_ffn(h.reshape(-1, d), *moe_args).reshape(bsz, t, d)
        else:
            xc = xc + mc[2] * yc
            hc = modulate(rms_norm(xc, norm_g[i, 1]), mc[3], mc[4])
            nc = xc.shape[1]
            f = moe_ffn(jnp.concatenate([h.reshape(-1, d), hc.reshape(-1, d)], axis=0), *moe_args)
            x = x + m[5] * f[:bsz * t].reshape(bsz, t, d)
            xc = xc + mc[5] * f[bsz * t:].reshape(bsz, nc, d)
    return rms_norm(x, g_final)
```

```cpp
#include <hip/hip_runtime.h>
#include <hip/hip_bf16.h>
#include <cstdio>
#include <cstdint>
#include <cmath>
extern "C" __device__ float __ockl_wfred_max_f32(float);
extern "C" __device__ float __ockl_wfred_add_f32(float);
namespace mk {
#define LAS __attribute__((address_space(3)))
#define GAS __attribute__((address_space(1)))
typedef unsigned short bf16_t;
typedef short bf16x8 __attribute__((ext_vector_type(8)));
typedef float f32x4 __attribute__((ext_vector_type(4)));
typedef float f32x2 __attribute__((ext_vector_type(2)));
typedef unsigned u32x4 __attribute__((ext_vector_type(4)));
typedef unsigned u32x2 __attribute__((ext_vector_type(2)));
typedef GAS unsigned gu32;
#define RLX_AGENT __ATOMIC_RELAXED, __HIP_MEMORY_SCOPE_AGENT
#define LDS_WAIT() asm volatile("s_waitcnt lgkmcnt(0)" ::: "memory")
#define VM_WAIT() asm volatile("s_waitcnt vmcnt(0)" ::: "memory")

constexpr int D = 1024, NB = 8, T = 2048, NC = 256, NLAT = NB * T, NCTX = NB * NC, NR = NLAT + NCTX, KEYS = T + NC;
constexpr int ZROW = NR;
constexpr float EPS = 1e-6f;
constexpr int NWAVES = 8, NTHREADS = 512;
constexpr int ECAP = NR;
constexpr float C2 = 0.125f * 1.4426950408889634f;

constexpr size_t MiB = 1ull << 20;
constexpr size_t O_X = 0;
constexpr size_t O_ROUTE = 72 * MiB;
constexpr size_t O_WD = 82 * MiB;
constexpr size_t O_ACT = 114 * MiB;
constexpr size_t O_ACTS = 187 * MiB;
constexpr size_t O_Y = 196 * MiB;
constexpr size_t O_A = 120 * MiB;
constexpr size_t O_Z = 157 * MiB;
constexpr size_t O_CAT = 247 * MiB;
constexpr size_t O_Q = 283 * MiB;
constexpr size_t O_K = 301 * MiB;
constexpr size_t O_V = 319 * MiB;
constexpr size_t O_A2 = 340 * MiB;
constexpr size_t O_WD1 = 464 * MiB;
constexpr size_t O_WGU = 400 * MiB;
constexpr size_t O_MOD = 500 * MiB;
constexpr size_t O_CTL = 509 * MiB;
constexpr size_t O_WINAB = 510 * MiB;
constexpr size_t O_WOUTAB = 514 * MiB;
constexpr size_t O_WINCD = 516 * MiB;
constexpr size_t O_WOUTCD = 521 * MiB;
constexpr size_t O_WR = 523 * MiB;
constexpr size_t O_WSGU = 524 * MiB;
constexpr size_t O_WSD = 526 * MiB;
constexpr size_t O_SGW = 527 * MiB;
constexpr size_t O_END = 528 * MiB;
constexpr size_t R_DEST = 0;
constexpr size_t R_LIST = 1 * MiB;
constexpr size_t R_GTK = 5 * MiB + MiB / 2;
static_assert(R_LIST + (size_t)64 * ECAP * 4 <= R_GTK && R_GTK + (size_t)NR * 8 * 4 <= 10 * MiB, "route map");
constexpr int CW_TMO = 0;
constexpr int CW_CNT = 64;
constexpr int CW_BAR = 4096;

constexpr int RING_BYTES = 131072;
constexpr int LDSX_OFF = RING_BYTES;
constexpr int MISC_OFF = RING_BYTES + 12288;
constexpr int LDS_BYTES = 147456;

__device__ __forceinline__ unsigned f2bf(float f) { unsigned u = __builtin_bit_cast(unsigned, f); return (u + 0x7fffu + ((u >> 16) & 1u)) >> 16; }
__device__ __forceinline__ unsigned pk2(float lo, float hi) { return f2bf(lo) | (f2bf(hi) << 16); }
__device__ __forceinline__ float bf2f(unsigned short b) { return __builtin_bit_cast(float, (unsigned)b << 16); }
__device__ __forceinline__ float bflo(unsigned w) { return __builtin_bit_cast(float, w << 16); }
__device__ __forceinline__ float bfhi(unsigned w) { return __builtin_bit_cast(float, w & 0xffff0000u); }
__device__ __forceinline__ float wave_sum(float v) { return __ockl_wfred_add_f32(v); }
__device__ __forceinline__ float fast_sigmoid(float x) { return __builtin_amdgcn_rcpf(1.f + __builtin_amdgcn_exp2f(-1.4426950408889634f * x)); }
__device__ __forceinline__ float fast_silu(float x) { return x * fast_sigmoid(x); }
__device__ __forceinline__ int ci_of_row(int row) { return row < NLAT ? row / T : 8; }

#define XB_TMO      128
#define XB_XCNT(j)  (256  + 64 * (j))
#define XB_XSUB(j)  (1280 + 64 * (j))
#define XB_XGEN(j)  (2304 + 64 * (j))
#define XB_TOP      3328
#define XB_TOPGEN   3392
#define XCD_BAR_WORDS 3456
#define XB_SPIN_CAP (1u << 18)
__device__ __forceinline__ unsigned xb_ld(unsigned* p)              { return __hip_atomic_load(p, __ATOMIC_RELAXED, __HIP_MEMORY_SCOPE_AGENT); }
__device__ __forceinline__ unsigned xb_add(unsigned* p, unsigned v) { return __hip_atomic_fetch_add(p, v, __ATOMIC_RELAXED, __HIP_MEMORY_SCOPE_AGENT); }
__device__ __forceinline__ unsigned xb_xcc_id() { return (unsigned)__builtin_amdgcn_s_getreg((3 << 11) | 20) & 0xFu; }
#define XB_SPIN(cond, bar) do { unsigned _sp = 0; while (cond) { __builtin_amdgcn_s_sleep(1); \
    if ((++_sp & 255u) == 0u) { if (xb_ld(&(bar)[XB_TMO])) break; if (_sp > XB_SPIN_CAP) { atomicAdd(&(bar)[XB_TMO], 1u); break; } } } } while (0)
struct XcdBarrier { unsigned* bar; unsigned x; volatile LAS unsigned* st; };
__device__ __forceinline__ XcdBarrier xcd_barrier_post(unsigned* bar, volatile LAS unsigned* st) {
    XcdBarrier b; b.bar = bar; b.x = xb_xcc_id(); b.st = st;
    if (threadIdx.x == 0) (void)xb_add(&bar[XB_XCNT(b.x)], 1u);
    return b;
}
__device__ __forceinline__ void xcd_barrier_complete(unsigned* bar, unsigned x, unsigned& nloc, unsigned& nx) {
    const unsigned G = gridDim.x * gridDim.y * gridDim.z;
    unsigned sum, cnt, mine, sp = 0u;
    for (;;) {
        sum = 0u; cnt = 0u; mine = 0u;
#pragma unroll
        for (unsigned j = 0; j < 16; ++j) { const unsigned c = xb_ld(&bar[XB_XCNT(j)]); sum += c; cnt += (c > 0u) ? 1u : 0u; mine = (j == x) ? c : mine; }
        if (sum == G) break;
        __builtin_amdgcn_s_sleep(1);
        if ((++sp & 255u) == 0u) { if (xb_ld(&bar[XB_TMO])) break; if (sp > XB_SPIN_CAP) { atomicAdd(&bar[XB_TMO], 1u); break; } }
    }
    nloc = mine > 0u ? mine : 1u; nx = cnt > 0u ? cnt : 1u;
}
__device__ __forceinline__ void xcd_barrier(const XcdBarrier& b) {
    asm volatile("s_waitcnt vmcnt(0)" ::: "memory");
    __syncthreads();
    if (threadIdx.x == 0) {
        unsigned* bar = b.bar;
        __builtin_amdgcn_s_waitcnt(0);
        unsigned nloc = b.st[0], nx = b.st[1];
        if (nloc == 0u) { xcd_barrier_complete(bar, b.x, nloc, nx); b.st[0] = nloc; b.st[1] = nx; }
        const unsigned old = xb_add(&bar[XB_XSUB(b.x)], 1u);
        const unsigned gen = old / nloc;
        if (old + 1u == (gen + 1u) * nloc) {
            __builtin_amdgcn_fence(__ATOMIC_RELEASE, "agent");
            asm volatile("s_waitcnt vmcnt(0)" ::: "memory");
            const unsigned og = xb_add(&bar[XB_TOP], 1u);
            const unsigned tg = og / nx;
            if (og + 1u == (tg + 1u) * nx) xb_add(&bar[XB_TOPGEN], 1u);
            else XB_SPIN(xb_ld(&bar[XB_TOPGEN]) == tg, bar);
            __builtin_amdgcn_fence(__ATOMIC_ACQUIRE, "agent");
            xb_add(&bar[XB_XGEN(b.x)], 1u);
            asm volatile("s_waitcnt vmcnt(0)" ::: "memory");
        } else {
            XB_SPIN(xb_ld(&bar[XB_XGEN(b.x)]) == gen, bar);
            __builtin_amdgcn_fence(__ATOMIC_ACQUIRE, "agent");
            asm volatile("s_waitcnt vmcnt(0)" ::: "memory");
        }
    }
    __syncthreads();
}

struct In {
    const float *x, *c, *ctx, *c_ctx, *norm_g, *w_ada, *b_ada, *w_in_ab, *w_out_ab, *conv_w, *conv_b, *conv_ln_g, *conv_ln_b, *qn_g, *kn_g,
        *w_in_cd, *w_out_cd, *sg_ln_g, *sg_ln_b, *sg_w, *sg_b, *na_rpb, *w_router, *b_router, *w_gate, *w_up, *w_down, *ws_gate, *ws_up, *ws_down, *g_final;
};
struct Args { In in; float* out; unsigned char* ws; int ph_lo, ph_hi, li, pad; };
struct Frame {
    LAS unsigned char* lds;
    unsigned char* ws;
    int tid, lane, wave, vcu, G;
};

constexpr int BM = 256, BK = 64, HALF = 128, HTB = HALF * BK * 2, STAGE_BYTES = 8 * HTB;
__device__ __forceinline__ int lds_byte(int r, int c) { const int st = (r >> 4) * 2 + (c >> 5), rr = r & 15, cc = c & 31, ob = rr * 64 + cc * 2; return st * 1024 + (ob ^ (((ob >> 9) & 1) << 5)); }
__device__ __forceinline__ void stage_rc(int b, int& R, int& C) { const int st = b / 1024, sb = b % 1024, swz = sb ^ (((sb >> 9) & 1) << 5); R = (st >> 1) * 16 + swz / 64; C = (st & 1) * 32 + (swz % 64) / 2; }
__device__ __forceinline__ int perm32(int rho) { const int n = rho >> 4, i = rho & 15; return 8 * (i >> 2) + 4 * n + (i & 3); }
__device__ __forceinline__ unsigned cvt_pk_bf16(float lo, float hi) { unsigned r; asm volatile("v_cvt_pk_bf16_f32 %0, %1, %2" : "=v"(r) : "v"(lo), "v"(hi)); return r; }

struct GUnit {
    const char* Bp;
    const int* rows;
    int arow0;
    int orow0;
    int nvalid;
    int pn;
    int e;
};
typedef f32x4 Acc[2][2][4][2];

template <class Epi, class Sched>
__device__ __forceinline__ void gemm_phase(LAS unsigned char* lds, const char* Abase, const int K, const Sched& S, const Epi& E) {
    int tid = threadIdx.x; asm volatile("" : "+v"(tid));
    const int wid = __builtin_amdgcn_readfirstlane(tid >> 6), lane = tid & 63, wr = wid >> 2, wc = wid & 3, fr = lane & 15, fq = lane >> 4;
    const int nt = K / BK;
    int R0, C0; stage_rc(tid * 16, R0, C0);
    unsigned voffB[2];
#pragma unroll
    for (int i = 0; i < 2; ++i) { const int R = R0 + 64 * i; const int Rb = Epi::PERM ? ((R & ~31) + perm32(R & 31)) : R; voffB[i] = (unsigned)(Rb * K + C0) * 2u; }
    const size_t kstep = (size_t)(BK * 2);
    const size_t hstep = (size_t)HALF * K * 2;
    const unsigned ldsw = (unsigned)wid * 1024u;
    const int aoff = lds_byte(wr * 64 + fr, fq * 8), boff = lds_byte(wc * 32 + fr, fq * 8);
#define PG8_SA(b, h) (((b) * 2 + (h)) * HTB)
#define PG8_SB(b, h) ((4 + (b) * 2 + (h)) * HTB)
#define PG8_STAGE2(bufoff, gbase, v0, v1) do { \
        __builtin_amdgcn_global_load_lds((const unsigned*)((const char*)(gbase) + (v0)), (LAS unsigned*)(lds + (bufoff) + ldsw), 16, 0, 0); \
        __builtin_amdgcn_global_load_lds((const unsigned*)((const char*)(gbase) + (v1)), (LAS unsigned*)(lds + (bufoff) + ldsw + 8192), 16, 0, 0); } while (0)
#define PG8_STAGEB(bufoff, gbase) PG8_STAGE2(bufoff, gbase, voffB[0], voffB[1])
#define PG8_LDA(dst, b, h) do { _Pragma("unroll") for (int m = 0; m < 4; ++m) _Pragma("unroll") for (int k = 0; k < 2; ++k) dst[m][k] = *(const LAS bf16x8*)(lds + PG8_SA(b, h) + aoff + m * 2048 + k * 1024); } while (0)
#define PG8_LDB(dst, b, h) do { _Pragma("unroll") for (int n = 0; n < 2; ++n) _Pragma("unroll") for (int k = 0; k < 2; ++k) dst[n][k] = *(const LAS bf16x8*)(lds + PG8_SB(b, h) + boff + n * 2048 + k * 1024); } while (0)
#define PG8_MMA(ai, bj, At, Bt) do { __builtin_amdgcn_s_setprio(1); _Pragma("unroll") for (int m = 0; m < 4; ++m) _Pragma("unroll") for (int n = 0; n < 2; ++n) _Pragma("unroll") for (int k = 0; k < 2; ++k) \
        acc[ai][bj][m][n] = __builtin_amdgcn_mfma_f32_16x16x32_bf16(Bt[n][k], At[m][k], acc[ai][bj][m][n], 0, 0, 0); __builtin_amdgcn_s_setprio(0); } while (0)
#define PG8_WAIT_V(n) asm volatile("s_waitcnt vmcnt(" #n ")" ::: "memory")
#define PG8_WAIT_L(n) asm volatile("s_waitcnt lgkmcnt(" #n ")" ::: "memory")
#define PG8_BAR __builtin_amdgcn_s_barrier()
#define PG8_SCHED __builtin_amdgcn_sched_barrier(0)
#define PG8_VOFF(u, vo) do { _Pragma("unroll") for (int h_ = 0; h_ < 2; ++h_) _Pragma("unroll") for (int i_ = 0; i_ < 2; ++i_) { const int r_ = h_ * 128 + R0 + 64 * i_; \
        int row_; if ((u).rows) { row_ = ZROW; if (r_ < (u).nvalid) row_ = (u).rows[r_]; } else row_ = (u).arow0 + r_; vo[h_][i_] = (unsigned)(row_ * K + C0) * 2u; } } while (0)
    GUnit cur, nxt; int ui = 0;
    if (!S.next(0, cur)) return;
    Acc acc;
#pragma unroll
    for (int a = 0; a < 2; ++a)
#pragma unroll
        for (int b = 0; b < 2; ++b)
#pragma unroll
            for (int m = 0; m < 4; ++m)
#pragma unroll
                for (int n = 0; n < 2; ++n) acc[a][b][m][n] = (f32x4){0.f, 0.f, 0.f, 0.f};
    bf16x8 At[4][2], B0[2][2], B1[2][2];
    unsigned vA[2][2], vN[2][2];
    PG8_VOFF(cur, vA);
    const char* cB = cur.Bp;
    const char* const cA = Abase;
    PG8_STAGEB(PG8_SB(0, 0), cB); PG8_STAGEB(PG8_SB(0, 1), cB + hstep); PG8_STAGE2(PG8_SA(0, 0), cA, vA[0][0], vA[0][1]); PG8_STAGE2(PG8_SA(0, 1), cA, vA[1][0], vA[1][1]);
    if (wr == 1) PG8_BAR;
    PG8_WAIT_V(2); PG8_BAR;
    PG8_STAGEB(PG8_SB(1, 0), cB + kstep); PG8_STAGE2(PG8_SA(1, 0), cA + kstep, vA[0][0], vA[0][1]); PG8_STAGEB(PG8_SB(1, 1), cB + hstep + kstep);
    PG8_WAIT_V(6); PG8_BAR;
    for (;;) {
        const bool has_next = S.next(ui + 1, nxt);
        if (has_next) { PG8_VOFF(nxt, vN); }
        else {
#pragma unroll
            for (int h = 0; h < 2; ++h)
#pragma unroll
                for (int i = 0; i < 2; ++i) vN[h][i] = vA[h][i];
        }
        const char* nB = has_next ? nxt.Bp : cB;
#pragma nounroll
        for (int t = 0; t < nt; t += 2) {
            const bool last = (t == nt - 2);
            const char* a1 = cA + (size_t)(t + 1) * kstep;
            const char* a2 = last ? cA : cA + (size_t)(t + 2) * kstep; const char* b2 = last ? nB : cB + (size_t)(t + 2) * kstep;
            const char* a3 = a2 + kstep; const char* b3 = b2 + kstep;
            const unsigned w00 = last ? vN[0][0] : vA[0][0], w01 = last ? vN[0][1] : vA[0][1], w10 = last ? vN[1][0] : vA[1][0], w11 = last ? vN[1][1] : vA[1][1];
            PG8_LDB(B0, 0, 0); PG8_LDB(B1, 0, 1); PG8_SCHED; PG8_LDA(At, 0, 0); PG8_STAGE2(PG8_SA(1, 1), a1, vA[1][0], vA[1][1]);
            PG8_WAIT_V(8); PG8_WAIT_L(0); PG8_BAR; PG8_MMA(0, 0, At, B0); PG8_MMA(0, 1, At, B1); PG8_BAR; PG8_SCHED;
            PG8_LDA(At, 0, 1); PG8_STAGEB(PG8_SB(0, 0), b2); PG8_STAGEB(PG8_SB(0, 1), b2 + hstep); PG8_STAGE2(PG8_SA(0, 0), a2, w00, w01);
            PG8_WAIT_V(8); PG8_WAIT_L(0); PG8_BAR; PG8_MMA(1, 0, At, B0); PG8_MMA(1, 1, At, B1); PG8_BAR; PG8_SCHED;
            PG8_LDB(B0, 1, 0); PG8_LDB(B1, 1, 1); PG8_SCHED; PG8_LDA(At, 1, 0); PG8_STAGE2(PG8_SA(0, 1), a2, w10, w11);
            PG8_WAIT_V(8); PG8_WAIT_L(0); PG8_BAR; PG8_MMA(0, 0, At, B0); PG8_MMA(0, 1, At, B1); PG8_BAR; PG8_SCHED;
            PG8_LDA(At, 1, 1); PG8_STAGEB(PG8_SB(1, 0), b3); PG8_STAGEB(PG8_SB(1, 1), b3 + hstep); PG8_STAGE2(PG8_SA(1, 0), a3, w00, w01);
            PG8_WAIT_V(8); PG8_WAIT_L(0); PG8_BAR; PG8_MMA(1, 0, At, B0); PG8_MMA(1, 1, At, B1); PG8_BAR; PG8_SCHED;
        }
        if (wr == 0) PG8_BAR;
        E(acc, cur, wr, wc, fr, fq);
        S.done(cur, lane);
        if (!has_next) break;
#pragma unroll
        for (int a = 0; a < 2; ++a)
#pragma unroll
            for (int b = 0; b < 2; ++b)
#pragma unroll
                for (int m = 0; m < 4; ++m)
#pragma unroll
                    for (int n = 0; n < 2; ++n) acc[a][b][m][n] = (f32x4){0.f, 0.f, 0.f, 0.f};
        cur = nxt; cB = nB; ++ui;
#pragma unroll
        for (int h = 0; h < 2; ++h)
#pragma unroll
            for (int i = 0; i < 2; ++i) vA[h][i] = vN[h][i];
        if (wr == 1) PG8_BAR;
    }
    PG8_WAIT_V(0);
    PG8_BAR;
#undef PG8_SA
#undef PG8_SB
#undef PG8_STAGE2
#undef PG8_STAGEB
#undef PG8_LDA
#undef PG8_LDB
#undef PG8_MMA
#undef PG8_WAIT_V
#undef PG8_WAIT_L
#undef PG8_BAR
#undef PG8_SCHED
#undef PG8_VOFF
}

struct EpiBf16 {
    static constexpr bool PERM = true;
    bf16_t* O; int ldc;
    __device__ __forceinline__ void operator()(const Acc& acc, const GUnit& u, int wr, int wc, int fr, int fq) const {
        const int col0 = u.pn * BM + wc * 32 + 8 * fq;
#pragma unroll
        for (int ai = 0; ai < 2; ++ai)
#pragma unroll
            for (int m = 0; m < 4; ++m) {
                const int r = ai * HALF + wr * 64 + m * 16 + fr;
                if (r < u.nvalid) {
                    bf16_t* rowp = O + (size_t)(u.orow0 + r) * ldc + col0;
#pragma unroll
                    for (int bj = 0; bj < 2; ++bj) { const f32x4 v0 = acc[ai][bj][m][0], v1 = acc[ai][bj][m][1];
                        u32x4 w; w.x = cvt_pk_bf16(v0[0], v0[1]); w.y = cvt_pk_bf16(v0[2], v0[3]); w.z = cvt_pk_bf16(v1[0], v1[1]); w.w = cvt_pk_bf16(v1[2], v1[3]);
                        *(u32x4*)(rowp + bj * HALF) = w; }
                }
            }
    }
};
struct EpiResid {
    static constexpr bool PERM = true;
    const float* blat; const float* bctx; const bf16_t* bx; bf16_t* out; const float* gate;
    __device__ __forceinline__ void operator()(const Acc& acc, const GUnit& u, int wr, int wc, int fr, int fq) const {
        const int col0 = u.pn * BM + wc * 32 + 8 * fq;
        const int ci = ci_of_row(u.orow0);
        const float* basef = u.orow0 < NLAT ? blat + (size_t)u.orow0 * D : bctx + (size_t)(u.orow0 - NLAT) * D;
#pragma unroll
        for (int bj = 0; bj < 2; ++bj) {
            const f32x4 gv0 = *(const f32x4*)(gate + (size_t)ci * 6144 + col0 + bj * HALF), gv1 = *(const f32x4*)(gate + (size_t)ci * 6144 + col0 + bj * HALF + 4);
#pragma unroll
            for (int ai = 0; ai < 2; ++ai)
#pragma unroll
                for (int m = 0; m < 4; ++m) {
                    const int r = ai * HALF + wr * 64 + m * 16 + fr;
                    f32x4 b0, b1;
                    if (bx) { const u32x4 w = *(const u32x4*)(bx + (size_t)(u.orow0 + r) * D + col0 + bj * HALF);
                        b0 = (f32x4){bflo(w.x), bfhi(w.x), bflo(w.y), bfhi(w.y)}; b1 = (f32x4){bflo(w.z), bfhi(w.z), bflo(w.w), bfhi(w.w)}; }
                    else { b0 = *(const f32x4*)(basef + (size_t)r * D + col0 + bj * HALF); b1 = *(const f32x4*)(basef + (size_t)r * D + col0 + bj * HALF + 4); }
                    const f32x4 o0 = b0 + gv0 * acc[ai][bj][m][0], o1 = b1 + gv1 * acc[ai][bj][m][1];
                    u32x4 w; w.x = cvt_pk_bf16(o0[0], o0[1]); w.y = cvt_pk_bf16(o0[2], o0[3]); w.z = cvt_pk_bf16(o1[0], o1[1]); w.w = cvt_pk_bf16(o1[2], o1[3]);
                    *(u32x4*)(out + (size_t)(u.orow0 + r) * D + col0 + bj * HALF) = w;
                    if (m & 1) asm volatile("" ::: "memory");
                }
        }
    }
};
struct EpiSwiglu {
    static constexpr bool PERM = true;
    bf16_t* O;
    __device__ __forceinline__ void operator()(const Acc& acc, const GUnit& u, int wr, int wc, int fr, int fq) const {
        const int col0 = u.pn * HALF + wc * 32 + 8 * fq;
#pragma unroll
        for (int ai = 0; ai < 2; ++ai)
#pragma unroll
            for (int m = 0; m < 4; ++m) {
                const int r = ai * HALF + wr * 64 + m * 16 + fr;
                if (r < u.nvalid) {
                    const f32x4 g0 = acc[ai][0][m][0], g1 = acc[ai][0][m][1], u0 = acc[ai][1][m][0], u1 = acc[ai][1][m][1];
                    u32x4 w;
                    w.x = cvt_pk_bf16(fast_silu(g0[0]) * u0[0], fast_silu(g0[1]) * u0[1]); w.y = cvt_pk_bf16(fast_silu(g0[2]) * u0[2], fast_silu(g0[3]) * u0[3]);
                    w.z = cvt_pk_bf16(fast_silu(g1[0]) * u1[0], fast_silu(g1[1]) * u1[1]); w.w = cvt_pk_bf16(fast_silu(g1[2]) * u1[2], fast_silu(g1[3]) * u1[3]);
                    *(u32x4*)(O + (size_t)(u.orow0 + r) * 256 + col0) = w;
                }
            }
    }
};

struct DenseSched {
    const char* Bt; int K; int nM, nN; int G, vcu; int ctx_pm0, ctx_pn0;
    __device__ __forceinline__ bool next(int i, GUnit& u) const {
        int L = i * G + vcu;
        const int nfull = ctx_pm0 * nN;
        int pm, pn;
        if (L < nfull) { pm = L / nN; pn = L % nN; }
        else { L -= nfull; const int w = nN - ctx_pn0; pm = ctx_pm0 + L / w; pn = ctx_pn0 + L % w; if (pm >= nM) return false; }
        u.Bp = Bt + (size_t)pn * 256 * K * 2; u.rows = nullptr; u.arow0 = pm * 256; u.orow0 = pm * 256; u.nvalid = 256; u.pn = pn; u.e = 0;
        return true;
    }
    __device__ __forceinline__ void done(const GUnit&, int) const {}
};

__device__ __forceinline__ void cvt_item(const float* W, int N, int k0, int n0, bf16_t* WT, int K, int drow0, LAS float* scr, int lane) {
#pragma unroll 8
    for (int i = 0; i < 32; ++i) { const int kk = 2 * i + (lane >> 5); scr[kk * 33 + (lane & 31)] = W[(size_t)(k0 + kk) * N + n0 + (lane & 31)]; }
    LDS_WAIT(); asm volatile("" ::: "memory");
    const int c = lane & 7;
#pragma unroll
    for (int j = 0; j < 4; ++j) { const int n = (lane >> 3) + 8 * j; const LAS float* s = scr + (8 * c) * 33 + n;
        u32x4 o; o.x = pk2(s[0 * 33], s[1 * 33]); o.y = pk2(s[2 * 33], s[3 * 33]); o.z = pk2(s[4 * 33], s[5 * 33]); o.w = pk2(s[6 * 33], s[7 * 33]);
        *(GAS u32x4*)(WT + (size_t)(drow0 + n) * K + k0 + 8 * c) = o; }
    LDS_WAIT(); asm volatile("" ::: "memory");
}
__device__ __forceinline__ bool cvt_job(int& r, const float* W, int K, int N, bf16_t* WT, LAS float* scr, int lane) {
    const int nblk = N / 32, items = (K / 64) * nblk;
    if (r >= items) { r -= items; return false; }
    const int kb = r / nblk, nb = r % nblk;
    cvt_item(W, N, kb * 64, nb * 32, WT, K, nb * 32, scr, lane);
    return true;
}
__device__ __forceinline__ void phase_cvt_mixer(const Frame& F, const In& in) {
    LAS float* scr = (LAS float*)(F.lds + F.wave * 16384);
    const int gw = F.vcu * NWAVES + F.wave, NGW = F.G * NWAVES;
    constexpr int I_AB = 16 * 56, I_O = 16 * 32, I_CD = 16 * 80;
    constexpr int NITEMS = I_AB + I_O + I_CD + I_O;
    for (int it = gw; it < NITEMS; it += NGW) {
        int r = it;
        if (cvt_job(r, in.w_in_ab, D, 1792, (bf16_t*)(F.ws + O_WINAB), scr, F.lane)) continue;
        if (cvt_job(r, in.w_out_ab, D, D, (bf16_t*)(F.ws + O_WOUTAB), scr, F.lane)) continue;
        if (cvt_job(r, in.w_in_cd, D, 2560, (bf16_t*)(F.ws + O_WINCD), scr, F.lane)) continue;
        cvt_job(r, in.w_out_cd, D, D, (bf16_t*)(F.ws + O_WOUTCD), scr, F.lane);
    }
    bf16_t* sg = (bf16_t*)(F.ws + O_SGW);
    for (int i = (F.vcu * NTHREADS + F.tid) * 4; i < 8 * 128 * 128; i += F.G * NTHREADS * 4) {
        const f32x4 v = *(const f32x4*)(in.sg_w + i);
        u32x2 o; o.x = pk2(v[0], v[1]); o.y = pk2(v[2], v[3]);
        *(u32x2*)(sg + i) = o;
    }
}
__device__ __forceinline__ void phase_cvt_down(const Frame& F, const In& in, int l, int cu0, int ncu) {
    if (F.vcu < cu0 || F.vcu >= cu0 + ncu) return;
    LAS float* scr = (LAS float*)(F.lds + F.wave * 16384);
    const int gw = (F.vcu - cu0) * NWAVES + F.wave, NGW = ncu * NWAVES;
    constexpr int I_DN = 4 * 32, N_R = 64 * I_DN;
    bf16_t* WD = (bf16_t*)(F.ws + (l == 0 ? O_WD : O_WD1)); bf16_t* WSD = (bf16_t*)(F.ws + O_WSD) + (size_t)l * D * 256;
    for (int it = gw; it < N_R + 128; it += NGW) {
        int r = it;
        if (r < N_R) { const int e = r / I_DN, q = r % I_DN, kb = q / 32, nb = q % 32;
            cvt_item(in.w_down + ((size_t)l * 64 + e) * 256 * D, D, kb * 64, nb * 32, WD + (size_t)e * D * 256, 256, nb * 32, scr, F.lane); continue; }
        r -= N_R;
        { const int kb = r / 32, nb = r % 32; cvt_item(in.ws_down + (size_t)l * 256 * D, D, kb * 64, nb * 32, WSD, 256, nb * 32, scr, F.lane); }
    }
}

struct CvtDesc { const float* W; bf16_t* WT; bf16_t* WTL; int N, k0, n0, drow0, pitch; };
constexpr int CVT32_GU = 64 * 256;
constexpr int CVT32_ITEMS = 2 * CVT32_GU + 2 * 256 + 64;
__device__ __forceinline__ CvtDesc cvt32_desc(const In& in, unsigned char* ws, int l, int it) {
    CvtDesc d; d.WTL = nullptr; d.pitch = D;
    int r = it;
    if (r < 2 * CVT32_GU) {
        const int up = r >= CVT32_GU; if (up) r -= CVT32_GU;
        const int e = r >> 8, q = r & 255, kb = q >> 3, nb = q & 7;
        d.W = (up ? in.w_up : in.w_gate) + ((size_t)l * 64 + e) * D * 256; d.N = 256; d.k0 = kb * 32; d.n0 = nb * 32;
        d.WT = (bf16_t*)(ws + O_WGU); d.drow0 = e * 512 + (d.n0 / 128) * 256 + up * 128 + (d.n0 % 128);
        return d;
    }
    r -= 2 * CVT32_GU;
    if (r < 512) {
        const int up = r >= 256; if (up) r -= 256;
        const int kb = r >> 3, nb = r & 7;
        d.W = (up ? in.ws_up : in.ws_gate) + (size_t)l * D * 256; d.N = 256; d.k0 = kb * 32; d.n0 = nb * 32;
        d.WT = (bf16_t*)(ws + O_WSGU) + (size_t)l * 512 * D; d.drow0 = (d.n0 / 128) * 256 + up * 128 + (d.n0 % 128);
        return d;
    }
    r -= 512;
    d.W = in.w_router + (size_t)l * D * 64; d.N = 64; d.k0 = (r >> 1) * 32; d.n0 = (r & 1) * 32;
    d.WT = (bf16_t*)(ws + O_WR) + (size_t)l * 2 * 64 * D; d.WTL = d.WT + 64 * D; d.drow0 = d.n0;
    return d;
}
__device__ __forceinline__ void cvt_range(const Frame& F, const In& in, int l, int it0, int it1, int scr_base) {
    LAS float* scr = (LAS float*)(F.lds + scr_base + F.wave * 4224);
    const int lane = F.lane, lk = lane >> 3, ln4 = (lane & 7) * 4;
    for (int ib = it0 + 4 * F.wave; ib < it1; ib += 4 * NWAVES) {
        CvtDesc d[4]; f32x4 v[4][4];
#pragma unroll
        for (int b = 0; b < 4; ++b) { d[b] = cvt32_desc(in, F.ws, l, min(ib + b, it1 - 1));
#pragma unroll
            for (int i = 0; i < 4; ++i) v[b][i] = *(const f32x4*)(d[b].W + (size_t)(d[b].k0 + lk + 8 * i) * d[b].N + d[b].n0 + ln4); }
#pragma unroll
        for (int b = 0; b < 4; ++b) {
            if (ib + b < it1) {
#pragma unroll
                for (int i = 0; i < 4; ++i) { LAS float* sp = scr + (lk + 8 * i) * 33 + ln4; sp[0] = v[b][i][0]; sp[1] = v[b][i][1]; sp[2] = v[b][i][2]; sp[3] = v[b][i][3]; }
                LDS_WAIT(); asm volatile("" ::: "memory");
#pragma unroll
                for (int j = 0; j < 2; ++j) { const int t = lane + 64 * j, n = t >> 2, c = t & 3; const LAS float* sp = scr + (8 * c) * 33 + n;
                    float x[8];
#pragma unroll
                    for (int q = 0; q < 8; ++q) x[q] = sp[q * 33];
                    u32x4 o; o.x = cvt_pk_bf16(x[0], x[1]); o.y = cvt_pk_bf16(x[2], x[3]); o.z = cvt_pk_bf16(x[4], x[5]); o.w = cvt_pk_bf16(x[6], x[7]);
                    *(GAS u32x4*)(d[b].WT + (size_t)(d[b].drow0 + n) * d[b].pitch + d[b].k0 + 8 * c) = o;
                    if (d[b].WTL) { u32x4 p; p.x = cvt_pk_bf16(x[0] - bflo(o.x), x[1] - bfhi(o.x)); p.y = cvt_pk_bf16(x[2] - bflo(o.y), x[3] - bfhi(o.y));
                        p.z = cvt_pk_bf16(x[4] - bflo(o.z), x[5] - bfhi(o.z)); p.w = cvt_pk_bf16(x[6] - bflo(o.w), x[7] - bfhi(o.w));
                        *(GAS u32x4*)(d[b].WTL + (size_t)(d[b].drow0 + n) * d[b].pitch + d[b].k0 + 8 * c) = p; } }
                LDS_WAIT(); asm volatile("" ::: "memory");
            }
        }
    }
}
__device__ __forceinline__ void cvt_wgu_part(const Frame& F, const In& in, int l, int lo, int hi, int cu0, int ncu, int scr_base) {
    if (F.vcu < cu0 || F.vcu >= cu0 + ncu) return;
    const int k = F.vcu - cu0, n = hi - lo;
    cvt_range(F, in, l, lo + (int)(((long)k * n) / ncu), lo + (int)(((long)(k + 1) * n) / ncu), scr_base);
}

__device__ __forceinline__ void normmod_row(const float* xrow, const float* g, const float* sh, const float* sc, bf16_t* orow, int lane) {
    const GAS f32x4* xr = (const GAS f32x4*)xrow + lane;
    f32x4 v[4]; float s = 0.f;
#pragma unroll
    for (int j = 0; j < 4; ++j) { v[j] = xr[64 * j]; s += (v[j].x * v[j].x + v[j].y * v[j].y) + (v[j].z * v[j].z + v[j].w * v[j].w); }
    const float rstd = rsqrtf(wave_sum(s) * (1.f / D) + EPS);
    GAS u32x2* o8 = (GAS u32x2*)orow + lane;
#pragma unroll
    for (int j = 0; j < 4; ++j) {
        const f32x4 gg = ((const GAS f32x4*)g)[lane + 64 * j], ss = ((const GAS f32x4*)sh)[lane + 64 * j], cc = ((const GAS f32x4*)sc)[lane + 64 * j];
        const f32x4 h = v[j] * rstd * gg * (1.f + cc) + ss;
        u32x2 o; o.x = pk2(h.x, h.y); o.y = pk2(h.z, h.w);
        o8[64 * j] = o;
    }
}
__device__ __forceinline__ void phase_normmod(const Frame& F, const float* xlat, const float* xctx, const float* g, const float* MODl, int jshift, bf16_t* A, int nrows) {
    const int gw = F.vcu * NWAVES + F.wave, NGW = F.G * NWAVES;
    for (int row = gw; row < nrows; row += NGW) {
        const float* xr = row < NLAT ? xlat + (size_t)row * D : xctx + (size_t)(row - NLAT) * D;
        const float* sh = MODl + (size_t)ci_of_row(row) * 6144 + jshift * D;
        normmod_row(xr, g, sh, sh + D, A + (size_t)row * D, F.lane);
    }
    if (gw == 0) { GAS u32x4* z = (GAS u32x4*)(A + (size_t)ZROW * D); z[F.lane] = (u32x4){0u, 0u, 0u, 0u}; z[F.lane + 64] = (u32x4){0u, 0u, 0u, 0u}; }
}
namespace ab {
typedef short s16x4 __attribute__((ext_vector_type(4)));
typedef float f32x16 __attribute__((ext_vector_type(16)));
constexpr int NW = 8, QBLK = 32, QB = QBLK * NW, KVBLK = 64;
__device__ __forceinline__ int crow(int r, int hi) { return (r & 3) + 8 * (r >> 2) + 4 * hi; }
#define SBAR() __builtin_amdgcn_sched_barrier(0)
constexpr int NSLOT = 3, SLOTB = 8192;
constexpr int LDS_K = 0, LDS_V = NSLOT * SLOTB, LDS_WS = 2 * NSLOT * SLOTB, LDS_OST = LDS_WS + NW * 64 * 4, ATTN_LDS_BYTES = LDS_OST + NW * 4096;
__device__ __forceinline__ void glds16(const void* gsrc, unsigned lds_dst) { unsigned keep;
  asm volatile("s_mov_b32 %0, m0\n\ts_mov_b32 m0, %2\n\ts_nop 0\n\tglobal_load_lds_dwordx4 %1, off\n\ts_mov_b32 m0, %0" : "=&s"(keep) : "v"(gsrc), "s"(lds_dst) : "memory"); }
__device__ __forceinline__ float max3f(float a, float b, float c) { float r; asm("v_max3_f32 %0, %1, %2, %3" : "=v"(r) : "v"(a), "v"(b), "v"(c)); return r; }
__device__ __forceinline__ float max2f(float a, float b) { float r; asm("v_max_f32_e32 %0, %1, %2" : "=v"(r) : "v"(a), "v"(b)); return r; }
__device__ __forceinline__ float fadd_s(float a, float b) { float r; asm("v_add_f32_e32 %0, %1, %2" : "=v"(r) : "v"(a), "v"(b)); return r; }
__device__ __forceinline__ float fsub_s(float a, float b) { float r; asm("v_sub_f32_e32 %0, %1, %2" : "=v"(r) : "v"(a), "v"(b)); return r; }
typedef float f32x2_t __attribute__((ext_vector_type(2))); typedef __bf16 bf16x2_t __attribute__((ext_vector_type(2)));
__device__ __forceinline__ unsigned cvtpk_s(float lo, float hi) { f32x2_t v = {lo, hi}; bf16x2_t b = __builtin_convertvector(v, bf16x2_t); return __builtin_bit_cast(unsigned, b); }
#define WAIT_BAR(N) asm volatile("s_waitcnt vmcnt(" #N ") lgkmcnt(0)\n\ts_barrier" ::: "memory")

__device__ __forceinline__ void qkt(f32x16& p0, f32x16& p1, const char* Kslot, const bf16x8* qr, const f32x16& negm, int r32, int hi) {
  const char* kb = Kslot + hi * 1024 + r32 * 16;
  #pragma unroll
  for (int d0 = 0; d0 < 4; ++d0) {
    const bf16x8 b0 = *reinterpret_cast<const bf16x8*>(kb + d0 * 2048);
    const bf16x8 b1 = *reinterpret_cast<const bf16x8*>(kb + d0 * 2048 + 512);
    if (d0 == 0) { p0 = __builtin_amdgcn_mfma_f32_32x32x16_bf16(b0, qr[0], negm, 0, 0, 0); p1 = __builtin_amdgcn_mfma_f32_32x32x16_bf16(b1, qr[0], negm, 0, 0, 0); }
    else { p0 = __builtin_amdgcn_mfma_f32_32x32x16_bf16(b0, qr[d0], p0, 0, 0, 0); p1 = __builtin_amdgcn_mfma_f32_32x32x16_bf16(b1, qr[d0], p1, 0, 0, 0); } }
}
typedef __attribute__((address_space(3))) const char* lds_cptr;
typedef short v4i16_t __attribute__((ext_vector_type(4)));
__device__ __forceinline__ void kload8(bf16x8* kf, lds_cptr kp) {
  kf[0] = *(const __attribute__((address_space(3))) bf16x8*)(kp);        kf[1] = *(const __attribute__((address_space(3))) bf16x8*)(kp + 512);
  kf[2] = *(const __attribute__((address_space(3))) bf16x8*)(kp + 2048); kf[3] = *(const __attribute__((address_space(3))) bf16x8*)(kp + 2560);
  kf[4] = *(const __attribute__((address_space(3))) bf16x8*)(kp + 4096); kf[5] = *(const __attribute__((address_space(3))) bf16x8*)(kp + 4608);
  kf[6] = *(const __attribute__((address_space(3))) bf16x8*)(kp + 6144); kf[7] = *(const __attribute__((address_space(3))) bf16x8*)(kp + 6656);
}
__device__ __forceinline__ void kload2(bf16x8* kf, lds_cptr kp, int j) { kf[2 * j] = *(const __attribute__((address_space(3))) bf16x8*)(kp + j * 2048); kf[2 * j + 1] = *(const __attribute__((address_space(3))) bf16x8*)(kp + j * 2048 + 512); }
__device__ __forceinline__ s16x4 vtr(lds_cptr p) { return __builtin_bit_cast(s16x4, __builtin_amdgcn_ds_read_tr16_b64_v4i16((__attribute__((address_space(3))) v4i16_t*)p)); }
__device__ __forceinline__ float rowmax(const f32x16& p0, const f32x16& p1) {
  float a = max3f(p0[0], p0[1], p1[0]), b = max3f(p0[2], p0[3], p1[1]); a = max3f(a, p1[2], p1[3]);
  #pragma unroll
  for (int r = 4; r < 16; r += 4) { a = max3f(a, p0[r], p0[r + 1]); b = max3f(b, p0[r + 2], p0[r + 3]); a = max3f(a, p1[r], p1[r + 1]); b = max3f(b, p1[r + 2], p1[r + 3]); }
  const float m = max2f(a, b);
  auto rr = __builtin_amdgcn_permlane32_swap(__float_as_uint(m), __float_as_uint(m), false, false);
  return max2f(__uint_as_float(rr[0]), __uint_as_float(rr[1]));
}
__device__ __forceinline__ void pv(f32x16* o, int vb, bf16x8 pa0, bf16x8 pa1, bf16x8 pa2, bf16x8 pa3) {
  #pragma unroll
  for (int d0 = 0; d0 < 2; ++d0) { s16x4 lo[4], hi[4];
    #pragma unroll
    for (int ks = 0; ks < 4; ++ks) {
      asm volatile("ds_read_b64_tr_b16 %0,%1 offset:%c2" : "=&v"(lo[ks]) : "v"(vb), "i"(d0 * 4096 + ks * 1024) : "memory");
      asm volatile("ds_read_b64_tr_b16 %0,%1 offset:%c2" : "=&v"(hi[ks]) : "v"(vb), "i"(d0 * 4096 + ks * 1024 + 512) : "memory"); }
    asm volatile("s_waitcnt lgkmcnt(0)" ::: "memory"); SBAR();
    #define PK(k) (bf16x8){lo[k][0], lo[k][1], lo[k][2], lo[k][3], hi[k][0], hi[k][1], hi[k][2], hi[k][3]}
    o[d0] = __builtin_amdgcn_mfma_f32_32x32x16_bf16(pa0, PK(0), o[d0], 0, 0, 0);
    o[d0] = __builtin_amdgcn_mfma_f32_32x32x16_bf16(pa1, PK(1), o[d0], 0, 0, 0);
    o[d0] = __builtin_amdgcn_mfma_f32_32x32x16_bf16(pa2, PK(2), o[d0], 0, 0, 0);
    o[d0] = __builtin_amdgcn_mfma_f32_32x32x16_bf16(pa3, PK(3), o[d0], 0, 0, 0);
    #undef PK
  }
}
struct TileMap { int nA, tokA, tokB; __device__ __forceinline__ long tok(int t) const { return t < nA ? tokA + 64 * t : tokB + 64 * (t - nA); } };
struct NoHook { __device__ __forceinline__ void operator()(f32x16&, f32x16&, int) const {} };

template <int THRL, class Hook>
__device__ __forceinline__ void attn_unit(const bf16_t* Qw0, int QP, const bf16_t* __restrict__ Kh, const bf16_t* __restrict__ Vh, int KP, const TileMap tm, const int NT,
                                          bf16_t* Ow0, int OP, char* shm, const Hook& hook) {
  int tid = threadIdx.x; asm volatile("" : "+v"(tid)); const int lane = tid & 63, r32 = lane & 31, hi = lane >> 5; const int wid = __builtin_amdgcn_readfirstlane(tid >> 6);
  const bf16_t* Qw = Qw0 + (long)wid * QBLK * QP;
  const unsigned lds0 = (unsigned)(uintptr_t)shm;
  float* wsf = (float*)(shm + LDS_WS) + wid * 64;
  const bf16_t* ksrc = Kh + (long)lane * KP + wid * 8;
  const bf16_t* vsrc = Vh + (long)(16 * (wid & 3) + (lane >> 2)) * KP + (wid >> 2) * 32 + (lane & 3) * 8;
  const unsigned kdst = lds0 + LDS_K + wid * 1024, vdst = lds0 + LDS_V + wid * 1024;
  #define DMA_K(t, slot) glds16(ksrc + tm.tok(t) * KP, (unsigned)__builtin_amdgcn_readfirstlane(kdst + (slot)))
  #define DMA_V(t, slot) glds16(vsrc + tm.tok(t) * KP, (unsigned)__builtin_amdgcn_readfirstlane(vdst + (slot)))
  const int vb0 = (int)(lds0 + LDS_V) + ((lane >> 4) & 1) * 32 + (lane & 3) * 8 + (4 * hi + ((lane & 15) >> 2)) * 64;
  const char* Kbase = shm + LDS_K; bf16x8 kf[8];
  const lds_cptr shm3 = (lds_cptr)shm; const lds_cptr kp0 = shm3 + LDS_K + hi * 1024 + r32 * 16; const lds_cptr vp0 = shm3 + LDS_V + ((lane >> 4) & 1) * 32 + (lane & 3) * 8 + (4 * hi + ((lane & 15) >> 2)) * 64;
  DMA_K(0, 0); DMA_V(0, 0); DMA_K(1, SLOTB);
  bf16x8 qr[4];
  #pragma unroll
  for (int d0 = 0; d0 < 4; ++d0) qr[d0] = *reinterpret_cast<const bf16x8*>(&Qw[(long)r32 * QP + d0 * 16 + hi * 8]);
  float mhat = 0.f, l_reg = 0.f; f32x16 o[2]; o[0] = f32x16{}; o[1] = f32x16{}; f32x16 negm = f32x16{}; asm volatile("" : "+v"(negm));
  #define HOOK(P0, P1, t) hook(P0, P1, t)
  bool resc = false;
  #define START(P0, P1) do { const float rm = rowmax(P0, P1); resc = false; \
    { const float dl = rm; mhat = fadd_s(mhat, dl); \
      _Pragma("unroll") for (int r = 0; r < 16; ++r) { P0[r] = fsub_s(P0[r], dl); P1[r] = fsub_s(P1[r], dl); } \
      _Pragma("unroll") for (int r = 0; r < 16; ++r) negm[r] = -mhat; asm volatile("" : "+v"(negm)); } \
    _Pragma("unroll") for (int r = 0; r < 16; ++r) P0[r] = __builtin_amdgcn_exp2f(P0[r]); } while (0)
  #define RESC() do { if (resc) { asm volatile("s_waitcnt lgkmcnt(0)" ::: "memory"); \
      _Pragma("unroll") for (int d_ = 0; d_ < 2; ++d_) _Pragma("unroll") for (int r = 0; r < 16; ++r) o[d_][r] *= wsf[crow(r, hi)]; } } while (0)
  f32x16 pA0, pA1, pB0, pB1;
  int sl_prev = 0, sl_cur = 0, sl_next = SLOTB;
  #define ROT() do { sl_prev = sl_cur; sl_cur = sl_next; sl_next = (sl_next == (NSLOT - 1) * SLOTB) ? 0 : sl_next + SLOTB; } while (0)
  DMA_K(2, 2 * SLOTB);
  WAIT_BAR(3);
  qkt(pA0, pA1, Kbase, qr, negm, r32, hi); asm volatile("s_nop 15\n\ts_nop 7" : "+v"(pA0), "+v"(pA1)); HOOK(pA0, pA1, 0);
  START(pA0, pA1);
  _Pragma("unroll") for (int r = 0; r < 16; ++r) pA1[r] = __builtin_amdgcn_exp2f(pA1[r]);
  WAIT_BAR(0);
  DMA_K(3, 0); DMA_V(1, SLOTB);
  ROT();
  kload8(kf, kp0 + sl_cur);
  WAIT_BAR(2);
  s16x4 vlo[8], vhi[8]; u32x4 pw0, pw1, pw2, pw3;
  #define PKW(P, B) cvtpk_s(P[B], P[B + 1])
  #define PAF(k) __builtin_bit_cast(bf16x8, pw##k)
  #define VFR(i) (bf16x8){vlo[i][0], vlo[i][1], vlo[i][2], vlo[i][3], vhi[i][0], vhi[i][1], vhi[i][2], vhi[i][3]}
  #define PIN(x) asm volatile("" : "+v"(x))
  #define MX3(a, b, c) __builtin_fmaxf(__builtin_fmaxf((a), (b)), (c))
  #define GAPA(MF, A0, A1, A2, A3, W0, W1, PW) do { MF; sacc += A0; sacc += A1; sacc += A2; sacc += A3; PIN(sacc); W0; W1; PIN(PW); SBAR(); } while (0)
  #define EX(v) __builtin_amdgcn_exp2f(v)
  #define GAPB(MF, X, B) do { MF; X[B] = EX(X[B]); X[B + 1] = EX(X[B + 1]); X[B + 2] = EX(X[B + 2]); X[B + 3] = EX(X[B + 3]); PIN(X); SBAR(); } while (0)
  #define VRD(i) do { vlo[i] = vtr(vp_ + (((i) >> 2) * 4096 + ((i) & 3) * 1024)); vhi[i] = vtr(vp_ + (((i) >> 2) * 4096 + ((i) & 3) * 1024 + 512)); } while (0)
  #define KRD(G, j) do { if (G) { kload2(kf, kp0 + sl_next, j); SBAR(); } } while (0)
  #define STEP(C0, C1, P0, P1, t, GK, GV, GL) do { SBAR(); \
    const lds_cptr vp_ = vp0 + sl_prev; \
    VRD(0); SBAR(); float sacc = (P0[0] + P0[1]); \
    GAPA(C0 = __builtin_amdgcn_mfma_f32_32x32x16_bf16(kf[0], qr[0], negm, 0, 0, 0), P0[2], P0[3], P0[4], P0[5],     pw0[0] = PKW(P0, 0), pw0[1] = PKW(P0, 2), pw0); \
    VRD(4); SBAR(); GAPA(C1 = __builtin_amdgcn_mfma_f32_32x32x16_bf16(kf[1], qr[0], negm, 0, 0, 0), P0[6], P0[7], P0[8], P0[9],     pw0[2] = PKW(P0, 4), pw0[3] = PKW(P0, 6), pw0); \
    VRD(1); SBAR(); GAPA(C0 = __builtin_amdgcn_mfma_f32_32x32x16_bf16(kf[2], qr[1], C0, 0, 0, 0),   P0[10], P0[11], P0[12], P0[13], pw1[0] = PKW(P0, 8), pw1[1] = PKW(P0, 10), pw1); \
    VRD(5); SBAR(); GAPA(C1 = __builtin_amdgcn_mfma_f32_32x32x16_bf16(kf[3], qr[1], C1, 0, 0, 0),   P0[14], P0[15], P1[0], P1[1],   pw1[2] = PKW(P0, 12), pw1[3] = PKW(P0, 14), pw1); \
    VRD(2); SBAR(); GAPA(C0 = __builtin_amdgcn_mfma_f32_32x32x16_bf16(kf[4], qr[2], C0, 0, 0, 0),   P1[2], P1[3], P1[4], P1[5],     pw2[0] = PKW(P1, 0), pw2[1] = PKW(P1, 2), pw2); \
    VRD(6); SBAR(); GAPA(C1 = __builtin_amdgcn_mfma_f32_32x32x16_bf16(kf[5], qr[2], C1, 0, 0, 0),   P1[6], P1[7], P1[8], P1[9],     pw2[2] = PKW(P1, 4), pw2[3] = PKW(P1, 6), pw2); \
    VRD(3); SBAR(); GAPA(C0 = __builtin_amdgcn_mfma_f32_32x32x16_bf16(kf[6], qr[3], C0, 0, 0, 0),   P1[10], P1[11], P1[12], P1[13], pw3[0] = PKW(P1, 8), pw3[1] = PKW(P1, 10), pw3); \
    VRD(7); SBAR(); GAPA(C1 = __builtin_amdgcn_mfma_f32_32x32x16_bf16(kf[7], qr[3], C1, 0, 0, 0),   P1[14], P1[15], 0.f, 0.f,       pw3[2] = PKW(P1, 12), pw3[3] = PKW(P1, 14), pw3); \
    l_reg += sacc; \
    if (GK) { DMA_K((t) + 3, sl_cur); } if (GV) { DMA_V((t) + 1, sl_next); } \
    HOOK(C0, C1, t); \
    { float a = MX3(C0[0], C0[1], C1[0]), b = MX3(C0[2], C0[3], C1[1]); a = MX3(a, C1[2], C1[3]); \
      _Pragma("unroll") for (int r = 4; r < 16; r += 4) { a = MX3(a, C0[r], C0[r + 1]); b = MX3(b, C0[r + 2], C0[r + 3]); a = MX3(a, C1[r], C1[r + 1]); b = MX3(b, C1[r + 2], C1[r + 3]); } \
      float rm = __builtin_fmaxf(a, b); { auto rr = __builtin_amdgcn_permlane32_swap(__float_as_uint(rm), __float_as_uint(rm), false, false); rm = __builtin_fmaxf(__uint_as_float(rr[0]), __uint_as_float(rr[1])); } \
      resc = false; \
      if (__builtin_expect(__any(rm > (float)THRL), 0)) { const float dl = __builtin_fmaxf(rm, 0.f); mhat += dl; \
        _Pragma("unroll") for (int r = 0; r < 16; ++r) { C0[r] -= dl; C1[r] -= dl; } \
        _Pragma("unroll") for (int r = 0; r < 16; ++r) negm[r] = -mhat; asm volatile("" : "+v"(negm)); \
        const float f = __builtin_amdgcn_exp2f(-dl); l_reg *= f; if (hi == 0) wsf[r32] = f; resc = true; } } \
    SBAR(); \
    GAPB(o[0] = __builtin_amdgcn_mfma_f32_32x32x16_bf16(PAF(0), VFR(0), o[0], 0, 0, 0), C0, 0); \
    GAPB(o[1] = __builtin_amdgcn_mfma_f32_32x32x16_bf16(PAF(0), VFR(4), o[1], 0, 0, 0), C0, 4); \
    KRD(GL, 0); GAPB(o[0] = __builtin_amdgcn_mfma_f32_32x32x16_bf16(PAF(1), VFR(1), o[0], 0, 0, 0), C0, 8); \
    KRD(GL, 1); GAPB(o[1] = __builtin_amdgcn_mfma_f32_32x32x16_bf16(PAF(1), VFR(5), o[1], 0, 0, 0), C0, 12); \
    KRD(GL, 2); GAPB(o[0] = __builtin_amdgcn_mfma_f32_32x32x16_bf16(PAF(2), VFR(2), o[0], 0, 0, 0), C1, 0); \
    KRD(GL, 3); GAPB(o[1] = __builtin_amdgcn_mfma_f32_32x32x16_bf16(PAF(2), VFR(6), o[1], 0, 0, 0), C1, 4); \
    GAPB(o[0] = __builtin_amdgcn_mfma_f32_32x32x16_bf16(PAF(3), VFR(3), o[0], 0, 0, 0), C1, 8); \
    GAPB(o[1] = __builtin_amdgcn_mfma_f32_32x32x16_bf16(PAF(3), VFR(7), o[1], 0, 0, 0), C1, 12); \
    } while (0)
  int t = 1;
  for (; t + 5 < NT; t += 2) {
    STEP(pB0, pB1, pA0, pA1, t, true, true, true);     WAIT_BAR(2); RESC(); ROT();
    STEP(pA0, pA1, pB0, pB1, t + 1, true, true, true); WAIT_BAR(2); RESC(); ROT();
  }
  #define ENDW(tt) do { if ((tt) + 3 < NT) { WAIT_BAR(2); } else if ((tt) + 2 < NT) { WAIT_BAR(1); } else { WAIT_BAR(0); } } while (0)
  for (; t + 1 < NT; t += 2) {
    STEP(pB0, pB1, pA0, pA1, t, (t + 3 < NT), (t + 1 < NT), (t + 1 < NT));       ENDW(t);     RESC(); ROT();
    STEP(pA0, pA1, pB0, pB1, t + 1, (t + 4 < NT), (t + 2 < NT), (t + 2 < NT));   ENDW(t + 1); RESC(); ROT();
  }
  STEP(pB0, pB1, pA0, pA1, NT - 1, false, false, false); RESC();
  { float sacc = pB0[0] + pB0[1]; _Pragma("unroll") for (int r = 2; r < 16; ++r) sacc += pB0[r]; _Pragma("unroll") for (int r = 0; r < 16; ++r) sacc += pB1[r]; l_reg += sacc;
    pw0 = (u32x4){PKW(pB0, 0), PKW(pB0, 2), PKW(pB0, 4), PKW(pB0, 6)}; pw1 = (u32x4){PKW(pB0, 8), PKW(pB0, 10), PKW(pB0, 12), PKW(pB0, 14)}; pw2 = (u32x4){PKW(pB1, 0), PKW(pB1, 2), PKW(pB1, 4), PKW(pB1, 6)}; pw3 = (u32x4){PKW(pB1, 8), PKW(pB1, 10), PKW(pB1, 12), PKW(pB1, 14)};
    SBAR(); pv(o, vb0 + sl_cur, PAF(0), PAF(1), PAF(2), PAF(3)); }
  #undef PKW
  #undef PAF
  #undef VFR
  #undef PIN
  #undef MX3
  #undef GAPA
  #undef GAPB
  #undef EX
  #undef VRD
  #undef KRD
  #undef STEP
  #undef ENDW
  { auto rr = __builtin_amdgcn_permlane32_swap(__float_as_uint(l_reg), __float_as_uint(l_reg), false, false); l_reg = __uint_as_float(rr[0]) + __uint_as_float(rr[1]); }
  if (hi == 0) wsf[32 + r32] = l_reg; asm volatile("s_waitcnt lgkmcnt(0)" ::: "memory");
  float rli[16];
  #pragma unroll
  for (int r = 0; r < 16; ++r) rli[r] = __builtin_amdgcn_rcpf(wsf[32 + crow(r, hi)]);
  bf16_t* Ow = Ow0 + (long)wid * QBLK * OP;
  { bf16_t* stg = (bf16_t*)(shm + LDS_OST) + wid * 2048;
    #pragma unroll
    for (int r = 0; r < 16; ++r) { const int orow = crow(r, hi);
      #pragma unroll
      for (int d0 = 0; d0 < 2; ++d0) stg[orow * 64 + d0 * 32 + r32] = (bf16_t)f2bf(o[d0][r] * rli[r]); }
    asm volatile("s_waitcnt lgkmcnt(0)" ::: "memory");
    #pragma unroll
    for (int i = 0; i < 4; ++i) { const int row = i * 8 + (lane >> 3), ch = lane & 7; const u32x4 v = *(const u32x4*)(stg + row * 64 + ch * 8); *(u32x4*)(Ow + (long)row * OP + ch * 8) = v; } }
  asm volatile("s_waitcnt lgkmcnt(0)\n\ts_barrier" ::: "memory");
  #undef DMA_K
  #undef DMA_V
  #undef HOOK
  #undef START
  #undef RESC
  #undef ROT
}
#undef SBAR
#undef WAIT_BAR
}
template <int J> __device__ __forceinline__ void conv_step(const LAS float* glc, const float (&w)[31], float (&acc)[32]) {
    if constexpr (J < 62) {
        const float v = glc[J * 512];
        constexpr int PLO = J - 30 > 0 ? J - 30 : 0, PHI = J < 31 ? J : 31;
#pragma unroll
        for (int p = PLO; p <= PHI; ++p) acc[p] += w[J - p] * v;
        conv_step<J + 1>(glc, w, acc);
    }
}
__device__ __forceinline__ void phase_conv0(const Frame& F, const In& in, const bf16_t* Z  , bf16_t* CAT  ) {
    const int c = F.tid;
    LAS float* gl = (LAS float*)F.lds;
    constexpr int NITEMS = 8 * 64 + 8 * 8;
    for (int it = F.vcu; it < NITEMS; it += F.G) {
        int seqbase, t0, L;
        if (it < 512) { seqbase = (it / 64) * T; t0 = (it % 64) * 32; L = T; }
        else { const int j = it - 512; seqbase = NLAT + (j / 8) * NC; t0 = (j % 8) * 32; L = NC; }
        __syncthreads();
#pragma unroll 2
        for (int i = 0; i < 8; ++i) {
            const int j = (F.tid >> 6) + 8 * i;
            const int tt = t0 - 15 + j, ch = (F.tid & 63) * 8;
            if (j < 62) {
                u32x4 a = (u32x4){0u, 0u, 0u, 0u}, g = a;
                if (tt >= 0 && tt < L) { const bf16_t* zr = Z + (size_t)(seqbase + tt) * 1792 + ch; a = *(const u32x4*)zr; g = *(const u32x4*)(zr + 512); }
                const f32x4 o0 = (f32x4){bflo(a.x) * fast_sigmoid(bflo(g.x)), bfhi(a.x) * fast_sigmoid(bfhi(g.x)), bflo(a.y) * fast_sigmoid(bflo(g.y)), bfhi(a.y) * fast_sigmoid(bfhi(g.y))};
                const f32x4 o1 = (f32x4){bflo(a.z) * fast_sigmoid(bflo(g.z)), bfhi(a.z) * fast_sigmoid(bfhi(g.z)), bflo(a.w) * fast_sigmoid(bflo(g.w)), bfhi(a.w) * fast_sigmoid(bfhi(g.w))};
                *(LAS f32x4*)(gl + j * 512 + ch) = o0; *(LAS f32x4*)(gl + j * 512 + ch + 4) = o1;
            }
        }
        __syncthreads();
        float w[31];
#pragma unroll
        for (int k = 0; k < 31; ++k) w[k] = in.conv_w[k * 512 + c];
        const float cb = in.conv_b[c];
        float acc[32];
#pragma unroll
        for (int p = 0; p < 32; ++p) acc[p] = cb;
        conv_step<0>(gl + c, w, acc);
        __syncthreads();
#pragma unroll
        for (int p = 0; p < 32; ++p) gl[p * 512 + c] = acc[p];
        __syncthreads();
#pragma unroll
        for (int q = 0; q < 4; ++q) {
            const int p = F.wave * 4 + q;
            const f32x4 a = *(const LAS f32x4*)(gl + p * 512 + 8 * F.lane), b = *(const LAS f32x4*)(gl + p * 512 + 8 * F.lane + 4);
            const float mu = wave_sum((a[0] + a[1]) + (a[2] + a[3]) + (b[0] + b[1]) + (b[2] + b[3])) * (1.f / 512.f);
            const f32x4 da = a - mu, db = b - mu;
            const float var = wave_sum((da[0] * da[0] + da[1] * da[1]) + (da[2] * da[2] + da[3] * da[3]) + (db[0] * db[0] + db[1] * db[1]) + (db[2] * db[2] + db[3] * db[3])) * (1.f / 512.f);
            const float rstd = rsqrtf(var + EPS);
            const f32x4 g0 = *(const f32x4*)(in.conv_ln_g + 8 * F.lane), g1 = *(const f32x4*)(in.conv_ln_g + 8 * F.lane + 4);
            const f32x4 b0 = *(const f32x4*)(in.conv_ln_b + 8 * F.lane), b1 = *(const f32x4*)(in.conv_ln_b + 8 * F.lane + 4);
            const f32x4 o0 = da * rstd * g0 + b0, o1 = db * rstd * g1 + b1;
            u32x4 o; o.x = pk2(fast_silu(o0[0]), fast_silu(o0[1])); o.y = pk2(fast_silu(o0[2]), fast_silu(o0[3])); o.z = pk2(fast_silu(o1[0]), fast_silu(o1[1])); o.w = pk2(fast_silu(o1[2]), fast_silu(o1[3]));
            *(u32x4*)(CAT + (size_t)(seqbase + t0 + p) * D + 8 * F.lane) = o;
        }
    }
    __syncthreads();
}

__device__ __forceinline__ void phase_qkv0(const Frame& F, const In& in, const bf16_t* Z, bf16_t* Q, bf16_t* Kb, bf16_t* Vb) {
    const int gw = F.vcu * NWAVES + F.wave, NGW = F.G * NWAVES, lane = F.lane;
    const int d0 = 4 * (lane & 15);
    const f32x4 qg = *(const f32x4*)(in.qn_g + d0), kg = *(const f32x4*)(in.kn_g + d0);
    const int half = d0 >> 5, dd = d0 & 31; const bool first = dd < 16; const int f0 = dd & 15;
    float inv[4];
#pragma unroll
    for (int e = 0; e < 4; ++e) inv[e] = __builtin_amdgcn_exp2f(-(float)(f0 + e) * (13.287712379549449f / 16.f)) * 0.15915494309189535f;
    for (int row = gw; row < NR; row += NGW) {
        const bool lat = row < NLAT;
        int b, t;
        if (lat) { b = row / T; t = row % T; } else { const int r2 = row - NLAT; b = r2 / NC; t = T + r2 % NC; }
        const size_t kvrow = (size_t)b * KEYS + t;
        const float pos = half == 0 ? (float)(t >> 6) : (float)(t & 63);
        float cs[4], sn[4];
#pragma unroll
        for (int e = 0; e < 4; ++e) { const float rev = pos * inv[e]; cs[e] = __builtin_amdgcn_cosf(rev); sn[e] = __builtin_amdgcn_sinf(rev); }
        const bf16_t* zr = Z + (size_t)row * 1792 + 1024;
#pragma unroll
        for (int g = 0; g < 3; ++g) {
            const u32x2 raw = *(const u32x2*)(zr + g * 256 + 4 * lane);
            float x[4] = {bflo(raw.x), bfhi(raw.x), bflo(raw.y), bfhi(raw.y)};
            const bool isv = (g == 2) && lane >= 32;
            float ss = (x[0] * x[0] + x[1] * x[1]) + (x[2] * x[2] + x[3] * x[3]);
            ss += __shfl_xor(ss, 1); ss += __shfl_xor(ss, 2); ss += __shfl_xor(ss, 4); ss += __shfl_xor(ss, 8);
            const float rstd = rsqrtf(ss * (1.f / 64.f) + EPS);
            const f32x4 gn = (g == 2) ? kg : qg;
            float y[4];
#pragma unroll
            for (int e = 0; e < 4; ++e) y[e] = isv ? x[e] : x[e] * rstd * gn[e];
#pragma unroll
            for (int e = 0; e < 4; ++e) {
                const float yp = __shfl_xor(y[e], 4);
                const float r = first ? y[e] * cs[e] - yp * sn[e] : y[e] * cs[e] + yp * sn[e];
                if (lat && !isv) y[e] = r;
            }
            if (g < 2) { u32x2 o; o.x = pk2(y[0] * C2, y[1] * C2); o.y = pk2(y[2] * C2, y[3] * C2); *(u32x2*)(Q + (size_t)row * 512 + g * 256 + 4 * lane) = o; }
            else { u32x2 o; o.x = pk2(y[0], y[1]); o.y = pk2(y[2], y[3]);
                if (lane < 32) *(u32x2*)(Kb + kvrow * 128 + 4 * lane) = o; else *(u32x2*)(Vb + kvrow * 128 + 4 * (lane - 32)) = o; }
        }
    }
}

constexpr int ATTN_CVT_SCR = 86016;
__device__ __forceinline__ void phase_attn0(const Frame& F, const In& in, char* shm, const bf16_t* Q, const bf16_t* Kb, const bf16_t* Vb, bf16_t* CAT) {
    for (int u = F.vcu; u < 512 + 64; u += F.G) {
        if (u < 512) {
            const int bk = u >> 5, qb = (u >> 2) & 7, g = u & 3, b = bk >> 1, hkv = bk & 1, h = hkv * 4 + g;
            const size_t row0 = (size_t)b * T + qb * 256;
            ab::TileMap tm{36, 0, 0};
            ab::attn_unit<8, ab::NoHook>(Q + row0 * 512 + h * 64, 512, Kb + (size_t)b * KEYS * 128 + hkv * 64, Vb + (size_t)b * KEYS * 128 + hkv * 64, 128, tm, 36,
                                         CAT + row0 * D + 512 + h * 64, D, shm, ab::NoHook{});
        } else {
            const int j = u - 512, b = j >> 3, h = j & 7, hkv = h >> 2;
            const size_t row0 = (size_t)NLAT + b * NC;
            ab::TileMap tm{4, T, T};
            ab::attn_unit<8, ab::NoHook>(Q + row0 * 512 + h * 64, 512, Kb + (size_t)b * KEYS * 128 + hkv * 64, Vb + (size_t)b * KEYS * 128 + hkv * 64, 128, tm, 4,
                                         CAT + row0 * D + 512 + h * 64, D, shm, ab::NoHook{});
        }
    }
}
__device__ __forceinline__ unsigned grp8_umax(unsigned v) {
    v = max(v, (unsigned)__builtin_amdgcn_update_dpp((int)v, (int)v, 0xB1, 0xf, 0xf, true));
    v = max(v, (unsigned)__builtin_amdgcn_update_dpp((int)v, (int)v, 0x4E, 0xf, 0xf, true));
    v = max(v, (unsigned)__builtin_amdgcn_update_dpp((int)v, (int)v, 0x141, 0xf, 0xf, true));
    return v;
}
__device__ __forceinline__ float grp8_fmax(float x) {
    int v = __builtin_bit_cast(int, x);
    v = __builtin_bit_cast(int, fmaxf(__builtin_bit_cast(float, v), __builtin_bit_cast(float, __builtin_amdgcn_update_dpp(v, v, 0xB1, 0xf, 0xf, true))));
    v = __builtin_bit_cast(int, fmaxf(__builtin_bit_cast(float, v), __builtin_bit_cast(float, __builtin_amdgcn_update_dpp(v, v, 0x4E, 0xf, 0xf, true))));
    v = __builtin_bit_cast(int, fmaxf(__builtin_bit_cast(float, v), __builtin_bit_cast(float, __builtin_amdgcn_update_dpp(v, v, 0x141, 0xf, 0xf, true))));
    return __builtin_bit_cast(float, v);
}
__device__ __forceinline__ void phase_route(const Frame& F, const In& in, int l, int g0, int g1, const bf16_t* X, const float* MODl, bf16_t* A2, const bool dummy) {
    const int lane = F.lane, w = F.wave, r = lane & 15, q = lane >> 4;
    constexpr int MR = 48;
    LAS float* part = (LAS float*)F.lds;
    LAS float* plog = part + 8 * MR;
    LAS float* G = plog + 8 * MR * 64;
    LAS int* cntw = (LAS int*)(G + 80 * 64);
    LAS float* rk = (LAS float*)(cntw + 8 * 64) + w * 64;
    const bf16_t* WRH = (const bf16_t*)(F.ws + O_WR) + (size_t)l * 2 * 64 * D; const bf16_t* WRL = WRH + 64 * D;
    const float* ng = in.norm_g + (l * 2 + 1) * D + 128 * w + 8 * q;
    const float brl = in.b_router[l * 64 + lane];
    unsigned* cnt = (unsigned*)(F.ws + O_CTL) + CW_CNT + (dummy ? 2 : l) * 64;
    unsigned char* tb = F.ws + (dummy ? O_Y : O_ROUTE);
    int* dest = (int*)(tb + R_DEST); int* list = (int*)(tb + R_LIST); float* gtk = (float*)(tb + R_GTK);
    if (F.vcu == 0 && w == 0) { GAS u32x4* z = (GAS u32x4*)(A2 + (size_t)ZROW * D); z[lane] = (u32x4){0u, 0u, 0u, 0u}; z[lane + 64] = (u32x4){0u, 0u, 0u, 0u}; }
    const bf16_t* wl0 = WRL + (size_t)r * D + 128 * w + 8 * q;
    int mycnt = 0;
    const int myg = g1 - g0;
    for (int m0 = 0; m0 < myg; m0 += 3) {
        const int ng3 = min(3, myg - m0);
        int grp3[3];
#pragma unroll
        for (int gi = 0; gi < 3; ++gi) grp3[gi] = g0 + m0 + min(gi, ng3 - 1);
        {
            u32x4 xw[3][4];
#pragma unroll
            for (int gi = 0; gi < 3; ++gi) { const bf16_t* xr = X + (size_t)(grp3[gi] * 16 + r) * D + 128 * w + 8 * q;
#pragma unroll
                for (int ks = 0; ks < 4; ++ks) xw[gi][ks] = *(const u32x4*)(xr + 32 * ks); }
#pragma unroll
            for (int gi = 0; gi < 3; ++gi) { float ss = 0.f;
#pragma unroll
                for (int ks = 0; ks < 4; ++ks) { const u32x4 a = xw[gi][ks];
#pragma unroll
                    for (int j = 0; j < 4; ++j) { const float lo = bflo(a[j]), hi = bfhi(a[j]); ss += lo * lo + hi * hi; } }
                ss += __shfl_xor(ss, 16); ss += __shfl_xor(ss, 32);
                if (q == 0) part[w * MR + gi * 16 + r] = ss; }
        }
        __syncthreads();
        {
            bf16x8 bh[4][4];
            { const bf16_t* wh0 = WRH + (size_t)r * D + 128 * w + 8 * q; asm volatile("" : "+v"(wh0));
#pragma unroll
              for (int ks = 0; ks < 4; ++ks)
#pragma unroll
                for (int nf = 0; nf < 4; ++nf) bh[ks][nf] = *(const bf16x8*)(wh0 + (size_t)(16 * nf) * D + 32 * ks); }
            float rstd[3]; f32x4 acc[3][4];
#pragma unroll
            for (int gi = 0; gi < 3; ++gi) { float tot = 0.f;
#pragma unroll
                for (int j = 0; j < 8; ++j) tot += part[j * MR + gi * 16 + r];
                rstd[gi] = rsqrtf(tot * (1.f / D) + EPS);
#pragma unroll
                for (int nf = 0; nf < 4; ++nf) acc[gi][nf] = (f32x4){0.f, 0.f, 0.f, 0.f}; }
#pragma unroll
            for (int ks = 0; ks < 4; ++ks) {
                const int co = 32 * ks;
                const f32x4 g0 = *(const f32x4*)(ng + co), g1 = *(const f32x4*)(ng + co + 4);
                bf16x8 blf[4];
#pragma unroll
                for (int nf = 0; nf < 4; ++nf) blf[nf] = *(const bf16x8*)(wl0 + (size_t)(16 * nf) * D + co);
#pragma unroll
                for (int gi = 0; gi < 3; ++gi) {
                    const int row = grp3[gi] * 16 + r;
                    const bf16_t* xr = X + (size_t)row * D + 128 * w + 8 * q;
                    const float* sh = MODl + (size_t)ci_of_row(grp3[gi] * 16) * 6144 + 3 * D + 128 * w + 8 * q;
                    const u32x4 xwv = *(const u32x4*)(xr + co);
                    const f32x4 xa = (f32x4){bflo(xwv.x), bfhi(xwv.x), bflo(xwv.y), bfhi(xwv.y)}, xb = (f32x4){bflo(xwv.z), bfhi(xwv.z), bflo(xwv.w), bfhi(xwv.w)};
                    const f32x4 s0 = *(const f32x4*)(sh + co), s1 = *(const f32x4*)(sh + co + 4), c0 = *(const f32x4*)(sh + D + co), c1 = *(const f32x4*)(sh + D + co + 4);
                    const f32x4 h0 = xa * rstd[gi] * g0 * (1.f + c0) + s0, h1 = xb * rstd[gi] * g1 * (1.f + c1) + s1;
                    unsigned hb[8]; float hl[8];
#pragma unroll
                    for (int j = 0; j < 4; ++j) { hb[j] = f2bf(h0[j]); hl[j] = h0[j] - __builtin_bit_cast(float, hb[j] << 16); hb[j + 4] = f2bf(h1[j]); hl[j + 4] = h1[j] - __builtin_bit_cast(float, hb[j + 4] << 16); }
                    u32x4 hw; hw.x = hb[0] | (hb[1] << 16); hw.y = hb[2] | (hb[3] << 16); hw.z = hb[4] | (hb[5] << 16); hw.w = hb[6] | (hb[7] << 16);
                    u32x4 lw; lw.x = pk2(hl[0], hl[1]); lw.y = pk2(hl[2], hl[3]); lw.z = pk2(hl[4], hl[5]); lw.w = pk2(hl[6], hl[7]);
                    *(u32x4*)(A2 + (size_t)row * D + 128 * w + co + 8 * q) = hw;
                    const bf16x8 ah = __builtin_bit_cast(bf16x8, hw), al = __builtin_bit_cast(bf16x8, lw);
#pragma unroll
                    for (int nf = 0; nf < 4; ++nf) {
                        acc[gi][nf] = __builtin_amdgcn_mfma_f32_16x16x32_bf16(ah, bh[ks][nf], acc[gi][nf], 0, 0, 0);
                        acc[gi][nf] = __builtin_amdgcn_mfma_f32_16x16x32_bf16(ah, blf[nf], acc[gi][nf], 0, 0, 0);
                        acc[gi][nf] = __builtin_amdgcn_mfma_f32_16x16x32_bf16(al, bh[ks][nf], acc[gi][nf], 0, 0, 0);
                    }
                }
            }
#pragma unroll
            for (int gi = 0; gi < 3; ++gi)
#pragma unroll
                for (int nf = 0; nf < 4; ++nf)
#pragma unroll
                    for (int g = 0; g < 4; ++g) plog[(w * MR + gi * 16 + 4 * q + g) * 64 + 16 * nf + r] = acc[gi][nf][g];
        }
        __syncthreads();
        for (int rr = w; rr < ng3 * 16; rr += 8) {
            float lgt = 0.f;
#pragma unroll
            for (int j = 0; j < 8; ++j) lgt += plog[(j * MR + rr) * 64 + lane];
            const float s = 1.f / (1.f + __expf(-lgt));
            const float b = s + brl;
            const unsigned ub = __float_as_uint(b);
            const unsigned key0 = (((ub & 0x80000000u) ? ~ub : (ub | 0x80000000u)) & ~63u) | (unsigned)(63 - lane);
            const unsigned k1 = grp8_umax(key0);
            const float b1 = grp8_fmax(b);
            const float b2 = grp8_fmax(key0 == k1 ? -INFINITY : b);
            const float gs = b1 + b2; const int g = lane >> 3;
            int grank = 0;
#pragma unroll
            for (int g2 = 0; g2 < 8; ++g2) { const float v = __builtin_bit_cast(float, __builtin_amdgcn_readlane(__builtin_bit_cast(int, gs), g2 * 8)); grank += (v > gs || (v == gs && g2 < g)) ? 1 : 0; }
            unsigned cur = grank < 4 ? key0 : 0u; bool sel = false;
#pragma unroll 1
            for (int it8 = 0; it8 < 8; ++it8) {
                unsigned gm = grp8_umax(cur);
                gm = max(gm, (unsigned)__builtin_amdgcn_update_dpp((int)gm, (int)gm, 0x128  , 0xf, 0xf, true));
                const unsigned mx = max(max((unsigned)__builtin_amdgcn_readlane((int)gm, 0), (unsigned)__builtin_amdgcn_readlane((int)gm, 16)),
                                        max((unsigned)__builtin_amdgcn_readlane((int)gm, 32), (unsigned)__builtin_amdgcn_readlane((int)gm, 48)));
                if (cur == mx) { sel = true; cur = 0u; }
            }
            const float ssum = __ockl_wfred_add_f32(sel ? s : 0.f);
            G[(m0 * 16 + rr) * 64 + lane] = sel ? s / ssum * 2.5f : 0.f;
            mycnt += sel ? 1 : 0;
        }
    }
    cntw[w * 64 + lane] = mycnt;
    __syncthreads();
    if (w == 0) {
        int tot = 0;
#pragma unroll
        for (int j = 0; j < 8; ++j) tot += cntw[j * 64 + lane];
        int base = 0;
        if (tot > 0) base = (int)__hip_atomic_fetch_add(cnt + lane, (unsigned)tot, __ATOMIC_RELAXED, __HIP_MEMORY_SCOPE_AGENT);
#pragma unroll
        for (int j = 0; j < 8; ++j) { const int cj = cntw[j * 64 + lane]; cntw[j * 64 + lane] = base; base += cj; }
    }
    __syncthreads();
    {
        int pos = cntw[w * 64 + lane];
        for (int m0 = 0; m0 < myg; m0 += 3) {
            const int ng3 = min(3, myg - m0);
            for (int rr = w; rr < ng3 * 16; rr += 8) {
                const float gt = G[(m0 * 16 + rr) * 64 + lane];
                const bool sel = gt != 0.f;
                const unsigned long long m = __ballot(sel);
                const int k = __popcll(m & ((1ull << lane) - 1ull));
                if (sel) { const int tok = (g0 + m0 + (rr >> 4)) * 16 + (rr & 15);
                    list[(size_t)lane * ECAP + pos] = tok; gtk[tok * 8 + k] = gt; dest[tok * 8 + k] = (int)((unsigned)lane << 20 | (unsigned)pos); ++pos; }
            }
        }
    }
    __syncthreads();
}

struct MoeTables { LAS int* cnt; LAS int* tp; LAS int* off; };
__device__ __forceinline__ MoeTables moe_tables(const Frame& F, int l) {
    MoeTables mt; mt.cnt = (LAS int*)(F.lds + LDSX_OFF); mt.tp = mt.cnt + 64; mt.off = mt.tp + 80;
    const unsigned* cnt = (const unsigned*)(F.ws + O_CTL) + CW_CNT + l * 64;
    __syncthreads();
    if (F.tid < 64) {
        const int c = (int)__hip_atomic_load(cnt + F.tid, __ATOMIC_RELAXED, __HIP_MEMORY_SCOPE_AGENT);
        mt.cnt[F.tid] = c;
        int t = (c + 255) >> 8, o = c;
#pragma unroll
        for (int d = 1; d < 64; d <<= 1) { const int t2 = __shfl_up(t, d), o2 = __shfl_up(o, d); if (F.tid >= d) { t += t2; o += o2; } }
        mt.tp[F.tid + 1] = t; mt.off[F.tid + 1] = o;
        if (F.tid == 0) { mt.tp[0] = 0; mt.off[0] = 0; }
    }
    __syncthreads();
    return mt;
}
__device__ __forceinline__ int moe_find_expert(const MoeTables& mt, int tile) {
    int lo = 0, hi = 64;
#pragma unroll
    for (int it = 0; it < 6; ++it) { const int mid = (lo + hi) >> 1; if (mt.tp[mid] <= tile) lo = mid; else hi = mid; }
    return __builtin_amdgcn_readfirstlane(lo);
}
struct MoeUpSched {
    MoeTables mt; const char* WGU; const char* WSGU; const int* list; int G, vcu, nshared_pm;
    __device__ __forceinline__ bool next(int i, GUnit& u) const {
        int L = i * G + vcu;
        const int ntr = __builtin_amdgcn_readfirstlane(mt.tp[64]);
        if (L < 2 * ntr) {
            const int tile = L >> 1, pn = L & 1, e = moe_find_expert(mt, tile);
            const int j = tile - __builtin_amdgcn_readfirstlane(mt.tp[e]), c = __builtin_amdgcn_readfirstlane(mt.cnt[e]), o = __builtin_amdgcn_readfirstlane(mt.off[e]);
            u.Bp = WGU + ((size_t)e * 512 + pn * 256) * D * 2; u.rows = list + (size_t)e * ECAP + 256 * j; u.arow0 = 0; u.orow0 = o + 256 * j;
            u.nvalid = min(256, c - 256 * j); u.pn = pn; u.e = e; return true;
        }
        L -= 2 * ntr;
        const int pm = L >> 1, pn = L & 1;
        if (pm >= nshared_pm) return false;
        u.Bp = WSGU + (size_t)pn * 256 * D * 2; u.rows = nullptr; u.arow0 = pm * 256; u.orow0 = pm * 256; u.nvalid = 256; u.pn = pn; u.e = 64; return true;
    }
    __device__ __forceinline__ void done(const GUnit&, int) const {}
};
struct EpiSwigluMoe {
    static constexpr bool PERM = true;
    bf16_t* act; bf16_t* acts;
    __device__ __forceinline__ void operator()(const Acc& acc, const GUnit& u, int wr, int wc, int fr, int fq) const {
        EpiSwiglu E{u.e == 64 ? acts : act}; E(acc, u, wr, wc, fr, fq);
    }
};
constexpr int SH_SLOT0 = NR * 8;
struct MoeDownSched {
    MoeTables mt; const char* WD; const char* WSD; int G, vcu, nshared_pm;
    __device__ __forceinline__ bool next(int i, GUnit& u) const {
        int L = i * G + vcu;
        const int ntr = __builtin_amdgcn_readfirstlane(mt.tp[64]);
        if (L < 4 * ntr) {
            const int tile = L >> 2, pn = L & 3, e = moe_find_expert(mt, tile);
            const int j = tile - __builtin_amdgcn_readfirstlane(mt.tp[e]), c = __builtin_amdgcn_readfirstlane(mt.cnt[e]), o = __builtin_amdgcn_readfirstlane(mt.off[e]);
            u.Bp = WD + ((size_t)e * D + pn * 256) * 256 * 2; u.rows = nullptr; u.arow0 = o + 256 * j; u.orow0 = o + 256 * j;
            u.nvalid = min(256, c - 256 * j); u.pn = pn; u.e = e; return true;
        }
        L -= 4 * ntr;
        const int pm = L >> 2, pn = L & 3;
        if (pm >= nshared_pm) return false;
        u.Bp = WSD + (size_t)pn * 256 * 256 * 2; u.rows = nullptr; u.arow0 = (int)((O_ACTS - O_ACT) / 512) + pm * 256; u.orow0 = SH_SLOT0 + pm * 256; u.nvalid = 256; u.pn = pn; u.e = 64; return true;
    }
    __device__ __forceinline__ void done(const GUnit&, int) const {}
};
constexpr float YSCALE = 16.f, YINV = 1.f / 16.f;
struct EpiFp8 {
    static constexpr bool PERM = true;
    unsigned char* O;
    __device__ __forceinline__ void operator()(const Acc& acc, const GUnit& u, int wr, int wc, int fr, int fq) const {
        const int odd = fq & 1;
        const int col0 = u.pn * BM + wc * 32 + 16 * (fq >> 1);
#pragma unroll
        for (int ai = 0; ai < 2; ++ai)
#pragma unroll
            for (int mp = 0; mp < 2; ++mp) {
                const int r = ai * HALF + wr * 64 + (2 * mp + odd) * 16 + fr;
#pragma unroll
                for (int bj = 0; bj < 2; ++bj) {
                    int w[2][2];
#pragma unroll
                    for (int mm = 0; mm < 2; ++mm) { f32x4 v0 = acc[ai][bj][2 * mp + mm][0] * YSCALE, v1 = acc[ai][bj][2 * mp + mm][1] * YSCALE;
#pragma unroll
                        for (int c = 0; c < 4; ++c) { v0[c] = __builtin_amdgcn_fmed3f(v0[c], -448.f, 448.f); v1[c] = __builtin_amdgcn_fmed3f(v1[c], -448.f, 448.f); }
                        int a = __builtin_amdgcn_cvt_pk_fp8_f32(v0[0], v0[1], 0, false); a = __builtin_amdgcn_cvt_pk_fp8_f32(v0[2], v0[3], a, true);
                        int b = __builtin_amdgcn_cvt_pk_fp8_f32(v1[0], v1[1], 0, false); b = __builtin_amdgcn_cvt_pk_fp8_f32(v1[2], v1[3], b, true);
                        w[mm][0] = a; w[mm][1] = b; }
                    const int s0 = odd ? w[0][0] : w[1][0], s1 = odd ? w[0][1] : w[1][1];
                    const int g0 = __shfl_xor(s0, 16), g1 = __shfl_xor(s1, 16);
                    const int k0 = odd ? w[1][0] : w[0][0], k1 = odd ? w[1][1] : w[0][1];
                    const u32x4 o = odd ? (u32x4){(unsigned)g0, (unsigned)g1, (unsigned)k0, (unsigned)k1} : (u32x4){(unsigned)k0, (unsigned)k1, (unsigned)g0, (unsigned)g1};
                    if (r < u.nvalid) *(u32x4*)(O + (size_t)(u.orow0 + r) * D + col0 + bj * HALF) = o;
                }
            }
    }
};
__device__ __forceinline__ void phase_combine(const Frame& F, int l, int nrows, bf16_t* X, const float* MODl, const unsigned char* Y, float* out_final, const float* gfin,
                                              bf16_t* nxtA, const float* nxt_g, const float* nxt_MOD) {
    const MoeTables mt = moe_tables(F, l);
    const int gw = F.vcu * NWAVES + F.wave, NGW = F.G * NWAVES, lane = F.lane;
    if (nxtA && gw == 0) { GAS u32x4* z = (GAS u32x4*)(nxtA + (size_t)ZROW * D); z[lane] = (u32x4){0u, 0u, 0u, 0u}; z[lane + 64] = (u32x4){0u, 0u, 0u, 0u}; }
    const int* dest = (const int*)(F.ws + O_ROUTE + R_DEST); const float* gtk = (const float*)(F.ws + O_ROUTE + R_GTK);
    int dvn = 0; float gvn = 0.f;
    if (gw < nrows) { dvn = dest[gw * 8 + (lane & 7)]; gvn = gtk[gw * 8 + (lane & 7)]; }
    for (int row = gw; row < nrows; row += NGW) {
        const int dv = dvn; const float gv = gvn;
        if (row + NGW < nrows) { dvn = dest[(row + NGW) * 8 + (lane & 7)]; gvn = gtk[(row + NGW) * 8 + (lane & 7)]; }
        const int sl = mt.off[(dv >> 20) & 63] + (dv & 0xfffff);
        float s[16];
#pragma unroll
        for (int i = 0; i < 16; ++i) s[i] = 0.f;
#pragma unroll
        for (int k = 0; k < 8; ++k) {
            const int slot = __builtin_amdgcn_readlane(sl, k);
            const float gk = __builtin_bit_cast(float, __builtin_amdgcn_readlane(__builtin_bit_cast(int, gv), k));
            const u32x4 a = *(const u32x4*)(Y + (size_t)slot * D + 16 * lane);
            const float gs = gk * YINV;
#pragma unroll
            for (int j = 0; j < 4; ++j) { const f32x2 lo = __builtin_amdgcn_cvt_pk_f32_fp8((int)a[j], false), hi = __builtin_amdgcn_cvt_pk_f32_fp8((int)a[j], true);
                s[4 * j] += gs * lo.x; s[4 * j + 1] += gs * lo.y; s[4 * j + 2] += gs * hi.x; s[4 * j + 3] += gs * hi.y; }
        }
        {
            const u32x4 a = *(const u32x4*)(Y + (size_t)(SH_SLOT0 + row) * D + 16 * lane);
#pragma unroll
            for (int j = 0; j < 4; ++j) { const f32x2 lo = __builtin_amdgcn_cvt_pk_f32_fp8((int)a[j], false), hi = __builtin_amdgcn_cvt_pk_f32_fp8((int)a[j], true);
                s[4 * j] += YINV * lo.x; s[4 * j + 1] += YINV * lo.y; s[4 * j + 2] += YINV * hi.x; s[4 * j + 3] += YINV * hi.y; }
        }
        const float* g5 = MODl + (size_t)ci_of_row(row) * 6144 + 5 * D + 16 * lane;
        bf16_t* xp = X + (size_t)row * D + 16 * lane;
        const u32x4 xw0 = *(const u32x4*)xp, xw1 = *(const u32x4*)(xp + 8);
        const unsigned xwu[8] = {xw0.x, xw0.y, xw0.z, xw0.w, xw1.x, xw1.y, xw1.z, xw1.w};
        f32x4 xv[4]; float ss = 0.f;
#pragma unroll
        for (int j = 0; j < 4; ++j) { const f32x4 g = *(const f32x4*)(g5 + 4 * j);
            const unsigned wa = xwu[2 * j], wb = xwu[2 * j + 1];
            f32x4 x = (f32x4){bflo(wa), bfhi(wa), bflo(wb), bfhi(wb)};
            x[0] += g[0] * s[4 * j]; x[1] += g[1] * s[4 * j + 1]; x[2] += g[2] * s[4 * j + 2]; x[3] += g[3] * s[4 * j + 3]; xv[j] = x;
            ss += (x[0] * x[0] + x[1] * x[1]) + (x[2] * x[2] + x[3] * x[3]); }
        if (out_final) {
            const float rstd = rsqrtf(wave_sum(ss) * (1.f / D) + EPS);
#pragma unroll
            for (int j = 0; j < 4; ++j) { const f32x4 g = *(const f32x4*)(gfin + 16 * lane + 4 * j); *(f32x4*)(out_final + (size_t)row * D + 16 * lane + 4 * j) = xv[j] * rstd * g; }
        } else {
            { u32x4 o0, o1; o0.x = cvt_pk_bf16(xv[0][0], xv[0][1]); o0.y = cvt_pk_bf16(xv[0][2], xv[0][3]); o0.z = cvt_pk_bf16(xv[1][0], xv[1][1]); o0.w = cvt_pk_bf16(xv[1][2], xv[1][3]);
              o1.x = cvt_pk_bf16(xv[2][0], xv[2][1]); o1.y = cvt_pk_bf16(xv[2][2], xv[2][3]); o1.z = cvt_pk_bf16(xv[3][0], xv[3][1]); o1.w = cvt_pk_bf16(xv[3][2], xv[3][3]);
              *(u32x4*)xp = o0; *(u32x4*)(xp + 8) = o1; }
            if (nxtA) {
                const float rstd = rsqrtf(wave_sum(ss) * (1.f / D) + EPS);
                const float* sh = nxt_MOD + (size_t)ci_of_row(row) * 6144 + 16 * lane;
                u32x4 o[2];
#pragma unroll
                for (int j = 0; j < 4; ++j) { const f32x4 g = *(const f32x4*)(nxt_g + 16 * lane + 4 * j), s0 = *(const f32x4*)(sh + 4 * j), c0 = *(const f32x4*)(sh + D + 4 * j);
                    const f32x4 h = xv[j] * rstd * g * (1.f + c0) + s0;
                    o[j >> 1][(j & 1) * 2] = pk2(h[0], h[1]); o[j >> 1][(j & 1) * 2 + 1] = pk2(h[2], h[3]); }
                *(u32x4*)(nxtA + (size_t)row * D + 16 * lane) = o[0]; *(u32x4*)(nxtA + (size_t)row * D + 16 * lane + 8) = o[1];
            }
        }
    }
}
__device__ __forceinline__ void phase_moe_up(const Frame& F, const In& in, int l, int nrows) {
    const MoeTables mt = moe_tables(F, l);
    MoeUpSched S{mt, (const char*)(F.ws + O_WGU), (const char*)(F.ws + O_WSGU) + (size_t)l * 512 * D * 2, (const int*)(F.ws + O_ROUTE + R_LIST), F.G, F.vcu, nrows / 256};
    EpiSwigluMoe E{(bf16_t*)(F.ws + O_ACT), (bf16_t*)(F.ws + O_ACTS)};
    gemm_phase(F.lds, (const char*)(F.ws + O_A2), D, S, E);
    if (l == 0) {
        const int nu = 2 * __builtin_amdgcn_readfirstlane(mt.tp[64]) + 2 * (nrows / 256), rem = nu % F.G;
        __syncthreads();
        phase_cvt_down(F, in, 1, rem, F.G - rem);
    }
}
__device__ __forceinline__ void phase_moe_down(const Frame& F, const In& in, int l, int nrows) {
    const MoeTables mt = moe_tables(F, l);
    MoeDownSched S{mt, (const char*)(F.ws + (l == 0 ? O_WD : O_WD1)), (const char*)(F.ws + O_WSD) + (size_t)l * D * 256 * 2, F.G, F.vcu, nrows / 256};
    EpiFp8 E{F.ws + O_Y};
    gemm_phase(F.lds, (const char*)(F.ws + O_ACT), 256, S, E);
    if (l == 0) {
        const int nu = 4 * __builtin_amdgcn_readfirstlane(mt.tp[64]) + 4 * (nrows / 256), rem = nu % F.G;
        __syncthreads();
        cvt_wgu_part(F, in, 1, 0, CVT32_ITEMS / 3, rem, F.G - rem, 0);
    }
}
__device__ __forceinline__ f32x2 gelu_pk(f32x2 v) {
    const f32x2 av = __builtin_elementwise_abs(v), d = av * 0.2316418882f + 1.0f;
    f32x2 t; t.x = __builtin_amdgcn_rcpf(d.x); t.y = __builtin_amdgcn_rcpf(d.y);
    f32x2 q = t * 0.5307027145f + (-0.7265760135f); q = q * t + 0.7107068705f; q = q * t + (-0.142248368f); q = q * t + 0.127414796f; q = q * t;
    const f32x2 s = (v * v) * (-0.72134752044f);
    f32x2 e; e.x = __builtin_amdgcn_exp2f(s.x); e.y = __builtin_amdgcn_exp2f(s.y);
    const f32x2 m = v * (q * e), r = v - m;
    f32x2 o; o.x = v.x < 0.f ? m.x : r.x; o.y = v.y < 0.f ? m.y : r.y; return o;
}
struct EpiZ {
    static constexpr bool PERM = true;
    bf16_t* O; int ldc, n_gelu, s_lo, s_hi;
    __device__ __forceinline__ void operator()(const Acc& acc, const GUnit& u, int wr, int wc, int fr, int fq) const {
        const int col0 = u.pn * BM + wc * 32 + 8 * fq;
        const int mode = u.pn < n_gelu ? 1 : ((u.pn >= s_lo && u.pn < s_hi) ? 2 : 0);
#pragma unroll
        for (int ai = 0; ai < 2; ++ai)
#pragma unroll
            for (int m = 0; m < 4; ++m) {
                bf16_t* rowp = O + (size_t)(u.orow0 + ai * HALF + wr * 64 + m * 16 + fr) * ldc + col0;
#pragma unroll
                for (int bj = 0; bj < 2; ++bj) { f32x4 v0 = acc[ai][bj][m][0], v1 = acc[ai][bj][m][1];
                    if (mode == 1) { const f32x2 a = gelu_pk((f32x2){v0[0], v0[1]}), b = gelu_pk((f32x2){v0[2], v0[3]}), c = gelu_pk((f32x2){v1[0], v1[1]}), d = gelu_pk((f32x2){v1[2], v1[3]});
                        v0 = (f32x4){a.x, a.y, b.x, b.y}; v1 = (f32x4){c.x, c.y, d.x, d.y}; }
                    else if (mode == 2) { v0 = v0 * C2; v1 = v1 * C2; }
                    u32x4 w; w.x = cvt_pk_bf16(v0[0], v0[1]); w.y = cvt_pk_bf16(v0[2], v0[3]); w.z = cvt_pk_bf16(v1[0], v1[1]); w.w = cvt_pk_bf16(v1[2], v1[3]);
                    *(u32x4*)(rowp + bj * HALF) = w; }
            }
    }
};

__device__ __forceinline__ void phase_sg(const Frame& F, const In& in, const bf16_t* Z1, bf16_t* CAT) {
    constexpr int VTS = 272;
    LAS unsigned char* VT = F.lds;
    const bf16_t* SGW = (const bf16_t*)(F.ws + O_SGW);
    const int lane = F.lane, w = F.wave;
    for (int it = F.vcu; it < NB * 16 * 2; it += F.G) {
        const int half = it & 1, chunk = (it >> 1) & 15, b = it >> 5;
        const size_t row0 = (size_t)b * T + chunk * 128;
        const int p = 16 * w + (lane & 15), kq = lane >> 4;
        bf16x8 wf[4][4]; u32x2 uu[4][4]; float bs[4];
#pragma unroll
        for (int gl = 0; gl < 4; ++gl) { const int g = 4 * half + gl; bs[gl] = in.sg_b[g * 128 + p];
#pragma unroll
            for (int ks = 0; ks < 4; ++ks) wf[gl][ks] = *(const bf16x8*)(SGW + ((size_t)g * 128 + p) * 128 + 32 * ks + 8 * kq);
#pragma unroll
            for (int nf = 0; nf < 4; ++nf) uu[gl][nf] = *(const u32x2*)(Z1 + (row0 + p) * 2560 + g * 64 + nf * 16 + 4 * kq); }
        __syncthreads();
        float lg4[4], lb4[4];
#pragma unroll
        for (int e = 0; e < 4; ++e) { lg4[e] = in.sg_ln_g[lane + 64 * e + 256 * half]; lb4[e] = in.sg_ln_b[lane + 64 * e + 256 * half]; }
#pragma unroll 1
        for (int rb = 0; rb < 16; rb += 4) {
            float raw[4][8];
#pragma unroll
            for (int j = 0; j < 4; ++j) { const bf16_t* vr = Z1 + (row0 + 16 * w + rb + j) * 2560 + 512;
#pragma unroll
                for (int e = 0; e < 8; ++e) raw[j][e] = bf2f(vr[lane + 64 * e]); }
#pragma unroll
            for (int j = 0; j < 4; ++j) {
                const int q = 16 * w + rb + j;
                float v[8]; float s = 0.f;
#pragma unroll
                for (int e = 0; e < 8; e += 2) { const f32x2 gg = gelu_pk((f32x2){raw[j][e], raw[j][e + 1]}); v[e] = gg.x; v[e + 1] = gg.y; s += gg.x + gg.y; }
                const float mu = wave_sum(s) * (1.f / 512.f);
                float s2 = 0.f;
#pragma unroll
                for (int e = 0; e < 8; ++e) { v[e] -= mu; s2 += v[e] * v[e]; }
                const float rstd = rsqrtf(wave_sum(s2) * (1.f / 512.f) + EPS);
                if (half) {
#pragma unroll
                    for (int e = 0; e < 4; ++e) *(LAS bf16_t*)(VT + (lane + 64 * e) * VTS + q * 2) = (bf16_t)f2bf(v[e + 4] * rstd * lg4[e] + lb4[e]);
                } else {
#pragma unroll
                    for (int e = 0; e < 4; ++e) *(LAS bf16_t*)(VT + (lane + 64 * e) * VTS + q * 2) = (bf16_t)f2bf(v[e] * rstd * lg4[e] + lb4[e]);
                }
            }
        }
        __syncthreads();
#pragma unroll
        for (int gl = 0; gl < 4; ++gl) {
            const int g = 4 * half + gl;
            f32x4 acc[4];
#pragma unroll
            for (int nf = 0; nf < 4; ++nf) acc[nf] = (f32x4){0.f, 0.f, 0.f, 0.f};
#pragma unroll
            for (int ks = 0; ks < 4; ++ks)
#pragma unroll
                for (int nf = 0; nf < 4; ++nf) {
                    const bf16x8 vf = *(const LAS bf16x8*)(VT + (gl * 64 + nf * 16 + (lane & 15)) * VTS + (32 * ks + 8 * kq) * 2);
                    acc[nf] = __builtin_amdgcn_mfma_f32_16x16x32_bf16(vf, wf[gl][ks], acc[nf], 0, 0, 0);
                }
#pragma unroll
            for (int nf = 0; nf < 4; ++nf) {
                const int c = g * 64 + nf * 16 + 4 * kq;
                const f32x2 u01 = gelu_pk((f32x2){bflo(uu[gl][nf].x), bfhi(uu[gl][nf].x)}), u23 = gelu_pk((f32x2){bflo(uu[gl][nf].y), bfhi(uu[gl][nf].y)});
                u32x2 o; o.x = pk2(u01.x * (acc[nf][0] + bs[gl]), u01.y * (acc[nf][1] + bs[gl])); o.y = pk2(u23.x * (acc[nf][2] + bs[gl]), u23.y * (acc[nf][3] + bs[gl]));
                *(u32x2*)(CAT + (row0 + p) * D + c) = o;
            }
        }
    }
    __syncthreads();
}

struct NaHook {
    const LAS float* rpbl;
    int nA, rs_lo, r, c, hi; unsigned vmask;
    __device__ __forceinline__ void init() {
        const int cs = min(max(c - 8, 0), 48); unsigned m = 0u;
#pragma unroll
        for (int i = 0; i < 16; ++i) { const int kc = ab::crow(i, hi); if (kc >= cs && kc < cs + 16) m |= 1u << i; if (kc + 32 >= cs && kc + 32 < cs + 16) m |= 1u << (16 + i); }
        vmask = m;
    }
    __device__ __forceinline__ void operator()(ab::f32x16& p0, ab::f32x16& p1, int t) const {
        if (t < nA) return;
        const int R = rs_lo + (t - nA);
        const int rs = min(max(r - 4, 0), 24);
        if (R < rs || R >= rs + 8) {
#pragma unroll
            for (int i = 0; i < 16; ++i) { p0[i] = -INFINITY; p1[i] = -INFINITY; }
            return;
        }
        const LAS float* tb = rpbl + ((R - r + 7) * 31 - c + 15 + 4 * hi);
#pragma unroll
        for (int i0 = 0; i0 < 16; i0 += 8) {
            float b[8];
#pragma unroll
            for (int i = 0; i < 8; ++i) b[i] = tb[((i0 + i) & 3) + 8 * ((i0 + i) >> 2)];
#pragma unroll
            for (int i = 0; i < 8; ++i) p0[i0 + i] = ((vmask >> (i0 + i)) & 1u) ? p0[i0 + i] + b[i] : -INFINITY;
            asm volatile("" ::: "memory");
#pragma unroll
            for (int i = 0; i < 8; ++i) b[i] = tb[32 + ((i0 + i) & 3) + 8 * ((i0 + i) >> 2)];
#pragma unroll
            for (int i = 0; i < 8; ++i) p1[i0 + i] = ((vmask >> (16 + i0 + i)) & 1u) ? p1[i0 + i] + b[i] : -INFINITY;
            asm volatile("" ::: "memory");
        }
    }
};
__device__ __forceinline__ void phase_na(const Frame& F, const In& in, char* shm, const bf16_t* Z1, bf16_t* CAT) {
    LAS float* rpbl = (LAS float*)(F.lds + LDSX_OFF + 4096);
    constexpr int CV0 = (2 * CVT32_ITEMS) / 3;
    if ((F.vcu & 1) == 0) cvt_wgu_part(F, in, 1, CV0, CVT32_ITEMS, 0, F.G, ATTN_CVT_SCR);
    for (int u = F.vcu; u < 512; u += F.G) {
        const int rg = u & 7, h = (u >> 3) & 7, b = u >> 6, r0 = 4 * rg;
        const int rs_lo = min(max(r0 - 4, 0), 24);
        const int nnb = (rg == 0 || rg == 7) ? 8 : 12;
        __syncthreads();
        for (int i = F.tid; i < 15 * 31; i += NTHREADS) rpbl[i] = in.na_rpb[h * 465 + i] * 1.4426950408889634f;
        __syncthreads();
        const size_t row0 = (size_t)b * T + r0 * 64;
        ab::TileMap tm{4, NLAT + b * NC, b * T + rs_lo * 64};
        NaHook hook{rpbl, 4, rs_lo, r0 + (F.wave >> 1), (F.wave & 1) * 32 + (F.lane & 31), F.lane >> 5, 0u}; hook.init();
        ab::attn_unit<8, NaHook>(Z1 + row0 * 2560 + 1024 + h * 64, 2560, Z1 + 1536 + h * 64, Z1 + 2048 + h * 64, 2560, tm, 4 + nnb,
                                 CAT + row0 * D + 512 + h * 64, D, shm, hook);
    }
    if (F.vcu & 1) { __syncthreads(); cvt_wgu_part(F, in, 1, CV0, CVT32_ITEMS, 0, F.G, ATTN_CVT_SCR); }
}

__device__ __forceinline__ void phase_adaln(const Frame& F, const In& in, float* MOD) {
    LAS float* sc = (LAS float*)F.lds;
    LAS float* red = sc + 9 * 1024;
    for (int i = F.tid; i < 9 * 1024; i += NTHREADS) { const float x = i < 8 * 1024 ? in.c[i] : in.c_ctx[i - 8 * 1024]; sc[i] = x / (1.f + __expf(-x)); }
    __syncthreads();
    const int ks = F.tid >> 6, cl = F.tid & 63;
    for (int it = F.vcu; it < 2 * 96; it += F.G) {
        const int l = it / 96, c0 = (it % 96) * 64;
        const float* w = in.w_ada + (size_t)l * D * 6144 + c0 + cl;
        float acc[9];
#pragma unroll
        for (int j = 0; j < 9; ++j) acc[j] = 0.f;
#pragma unroll 8
        for (int k = ks * 128; k < ks * 128 + 128; ++k) { const float wv = w[(size_t)k * 6144];
#pragma unroll
            for (int j = 0; j < 9; ++j) acc[j] += sc[j * 1024 + k] * wv; }
        __syncthreads();
#pragma unroll
        for (int j = 0; j < 9; ++j) red[(ks * 9 + j) * 64 + cl] = acc[j];
        __syncthreads();
        for (int o = F.tid; o < 9 * 64; o += NTHREADS) { const int j = o >> 6, cc = o & 63; float s = in.b_ada[l * 6144 + c0 + cc];
#pragma unroll
            for (int q = 0; q < 8; ++q) s += red[(q * 9 + j) * 64 + cc];
            MOD[((size_t)l * 9 + j) * 6144 + c0 + cc] = s; }
    }
    __syncthreads();
}
enum Phase { PH_INIT = 0, PH_NORM0, PH_IN0, PH_PREP0, PH_ATTN0, PH_OUT0, PH_ROUTE0, PH_UP0, PH_DOWN0, PH_COMB0,
             PH_IN1, PH_MIX1, PH_OUT1, PH_ROUTE1, PH_UP1, PH_DOWN1, PH_COMB1, PH_COUNT };

__global__ void __launch_bounds__(NTHREADS, 2) mk_fwd(Args args) {
    extern __shared__ __attribute__((aligned(16))) unsigned char lds_raw[];
    Frame F;
    F.lds = (LAS unsigned char*)lds_raw; F.ws = args.ws;
    F.tid = threadIdx.x; F.lane = F.tid & 63; F.wave = __builtin_amdgcn_readfirstlane(F.tid >> 6);
    F.G = gridDim.x; { const int bx = blockIdx.x; F.vcu = (F.G % 8 == 0) ? (bx % 8) * (F.G / 8) + bx / 8 : bx; }
    volatile LAS unsigned* MISC = (volatile LAS unsigned*)(F.lds + MISC_OFF);
    for (int u = F.tid; u < (LDS_BYTES - MISC_OFF) / 4; u += NTHREADS) ((LAS unsigned*)(F.lds + MISC_OFF))[u] = 0u;
    __syncthreads();
    gu32* ctl = (gu32*)(args.ws + O_CTL);
    const bool multi = (args.ph_hi - args.ph_lo) > 1;
    XcdBarrier bar; bar.bar = (unsigned*)(ctl + CW_BAR) + args.li * XCD_BAR_WORDS; bar.x = 0; bar.st = nullptr;
    if (multi) bar = xcd_barrier_post((unsigned*)(ctl + CW_BAR) + args.li * XCD_BAR_WORDS, MISC + 8);
    typedef const __attribute__((address_space(4))) Args* ArgK;
    ArgK argp = (ArgK)__builtin_amdgcn_kernarg_segment_ptr();
    const int lo = args.ph_lo, hi = args.ph_hi;
    const bool dummy = args.pad != 0;
#define IN(k) (lo <= (k) && (k) < hi)
#define SEAM(k) do { if (IN((k) + 1)) xcd_barrier(bar); } while (0)

#if defined(__HIP_DEVICE_COMPILE__)
#define LOADARGS_() const Args al = *argp
#else
#define LOADARGS_() const Args al = args
#endif
#define LOADIN() LOADARGS_(); const In& inl = al.in; F.ws = al.ws; \
    float* const MOD = (float*)(al.ws + O_MOD); bf16_t* const X = (bf16_t*)(al.ws + O_X); \
    bf16_t* const A = (bf16_t*)(al.ws + O_A); bf16_t* const Z = (bf16_t*)(al.ws + O_Z); bf16_t* const CAT = (bf16_t*)(al.ws + O_CAT); \
    const float* const ZEROG = (const float*)(al.ws + O_CTL + 512 * 1024); (void)MOD; (void)X; (void)A; (void)Z; (void)CAT; (void)ZEROG
    if (IN(PH_INIT)) { LOADIN(); phase_adaln(F, inl, MOD); phase_cvt_mixer(F, inl); SEAM(PH_INIT); }
#define RELAUNDER() do { int t_ = threadIdx.x; asm volatile("" : "+v"(t_)); F.tid = t_; F.lane = t_ & 63; F.wave = __builtin_amdgcn_readfirstlane(t_ >> 6); int v_ = F.vcu; asm volatile("" : "+s"(v_)); F.vcu = v_; argp = (ArgK)__builtin_amdgcn_kernarg_segment_ptr(); asm volatile("" : "+s"(argp)); } while (0)
#define PH_IN(l, p1) \
    if (IN(p1)) { RELAUNDER(); LOADIN(); \
        DenseSched S{(const char*)(al.ws + (l == 0 ? O_WINAB : O_WINCD)), D, NR / 256, l == 0 ? 7 : 10, F.G, F.vcu, l == 0 ? NR / 256 : NLAT / 256, l == 0 ? 0 : 6}; \
        EpiZ E{Z, l == 0 ? 1792 : 2560, 0, 4, l == 0 ? 0 : 6}; \
        gemm_phase(F.lds, (const char*)A, D, S, E); \
        if (l == 1) { const int nu_ = 64 * 10 + 8 * 4, rem_ = nu_ % F.G; __syncthreads(); cvt_wgu_part(F, inl, 1, CVT32_ITEMS / 3, (2 * CVT32_ITEMS) / 3, rem_, F.G - rem_, 0); }     \
        SEAM(p1); }
#define PH_OUT_MOE(l, pb, nrows) \
    if (IN(pb)) { RELAUNDER(); LOADIN(); \
        DenseSched S{(const char*)(al.ws + (l == 0 ? O_WOUTAB : O_WOUTCD)), D, (nrows) / 256, D / 256, F.G, F.vcu, (nrows) / 256, 0}; \
        EpiResid E{inl.x, inl.ctx, l == 0 ? nullptr : X, X, ((dummy && l == 1) ? ZEROG : MOD + (size_t)l * 9 * 6144) + 2 * D}; \
        gemm_phase(F.lds, (const char*)CAT, D, S, E); \
        if (l == 0) { __syncthreads(); const int c0_ = F.G == 256 ? 32 : 0; phase_cvt_down(F, inl, 0, c0_, F.G - c0_); __syncthreads(); cvt_wgu_part(F, inl, 0, 0, CVT32_ITEMS, c0_, F.G - c0_, 0); }     \
        SEAM(pb); } \
    if (IN(pb + 1)) { RELAUNDER(); LOADIN(); \
        const int ng_ = (nrows) / 16; const int g0 = (int)(((long)F.vcu * ng_) / F.G), g1 = (int)(((long)(F.vcu + 1) * ng_) / F.G); \
        phase_route(F, inl, l, g0, g1, X, MOD + (size_t)l * 9 * 6144, (bf16_t*)(al.ws + O_A2), dummy);     \
        SEAM(pb + 1); } \
    if (IN(pb + 2)) { RELAUNDER(); LOADIN(); phase_moe_up(F, inl, l, nrows); SEAM(pb + 2); } \
    if (IN(pb + 3)) { RELAUNDER(); LOADIN(); phase_moe_down(F, inl, l, nrows); SEAM(pb + 3); } \
    if (IN(pb + 4)) { RELAUNDER(); LOADIN(); phase_combine(F, l, nrows, X, dummy ? ZEROG : MOD + (size_t)l * 9 * 6144, (const unsigned char*)(al.ws + O_Y), l == 1 ? al.out : nullptr, inl.g_final, l == 0 ? A : nullptr, inl.norm_g + 2 * D, MOD + (size_t)9 * 6144); \
        SEAM(pb + 4); }

    if (IN(PH_NORM0)) { RELAUNDER(); LOADIN(); phase_normmod(F, inl.x, inl.ctx, inl.norm_g, MOD, 0, A, NR); SEAM(PH_NORM0); }
    PH_IN(0, PH_IN0)
    if (IN(PH_PREP0)) { RELAUNDER(); LOADIN();
        phase_conv0(F, inl, Z, CAT);
        if (!dummy) phase_qkv0(F, inl, Z, (bf16_t*)(al.ws + O_Q), (bf16_t*)(al.ws + O_K), (bf16_t*)(al.ws + O_V));
        SEAM(PH_PREP0); }
    if (IN(PH_ATTN0)) { RELAUNDER(); LOADIN();
        phase_attn0(F, inl, (char*)lds_raw, (const bf16_t*)(al.ws + O_Q), (const bf16_t*)(al.ws + O_K), (const bf16_t*)(al.ws + O_V), CAT);
        SEAM(PH_ATTN0); }
    PH_OUT_MOE(0, PH_OUT0, NR)
    PH_IN(1, PH_IN1)
    if (IN(PH_MIX1)) { RELAUNDER(); LOADIN(); phase_sg(F, inl, Z, CAT); phase_na(F, inl, (char*)lds_raw, Z, CAT); SEAM(PH_MIX1); }
    PH_OUT_MOE(1, PH_OUT1, NLAT)
#undef IN
#undef SEAM
}

static int g_grid = 0;
inline bool mk_init() {
    if (g_grid != 0) return g_grid > 0;
    int dev = 0, cus = 0, per_cu = 0;
    if (hipGetDevice(&dev) != hipSuccess || hipDeviceGetAttribute(&cus, hipDeviceAttributeMultiprocessorCount, dev) != hipSuccess) { g_grid = -1; return false; }
    if (hipFuncSetAttribute((const void*)mk_fwd, hipFuncAttributeMaxDynamicSharedMemorySize, LDS_BYTES) != hipSuccess) { fprintf(stderr, "hipFuncSetAttribute failed\n"); g_grid = -1; return false; }
    if (hipOccupancyMaxActiveBlocksPerMultiprocessor(&per_cu, (const void*)mk_fwd, NTHREADS, LDS_BYTES) != hipSuccess || per_cu < 1) { fprintf(stderr, "occupancy query: %d\n", per_cu); (void)hipGetLastError(); per_cu = 1; }
    if (cus != 256) { fprintf(stderr, "kernel_launch: built for a 256-CU MI355X (one workgroup per CU); this device reports %d CUs; nothing launched\n", cus); g_grid = -1; return false; }
    g_grid = cus;
    return true;
}
inline void mk_launch(hipStream_t st, const In& in, float* out, unsigned char* ws, int lo, int hi, int li, int dummy = 0) {
    Args a{}; a.in = in; a.out = out; a.ws = ws; a.ph_lo = lo; a.ph_hi = hi; a.li = li; a.pad = dummy;
    hipLaunchKernelGGL(mk_fwd, dim3(g_grid), dim3(NTHREADS), LDS_BYTES, st, a);
}
}
extern "C" void kernel_launch(void* const* d_in, const int* in_sizes, int n_in, void* d_out, int out_size, void* d_ws, size_t ws_size, hipStream_t stream) {
    if (n_in != 31 || ws_size < mk::O_END) { fprintf(stderr, "kernel_launch: unexpected n_in %d / ws %zu\n", n_in, ws_size); return; }
    if (!mk::mk_init()) return;
    mk::In min; const float** q = (const float**)&min;
    for (int i = 0; i < 31; ++i) q[i] = (const float*)d_in[i];
    unsigned char* ws = (unsigned char*)d_ws;
    (void)hipMemsetAsync(ws + mk::O_CTL, 0, 1 << 20, stream);
    mk::mk_launch(stream, min, (float*)d_out, ws, 0, mk::PH_COUNT, 0);
}
```

```cpp
#include <hip/hip_runtime.h>
#include <hip/hip_bf16.h>
#include <cstdio>
#include <cstdint>
#include <cmath>
extern "C" __device__ float __ockl_wfred_max_f32(float);
extern "C" __device__ float __ockl_wfred_add_f32(float);
namespace mk {
#define LAS __attribute__((address_space(3)))
#define GAS __attribute__((address_space(1)))
typedef unsigned short bf16_t;
typedef short bf16x8 __attribute__((ext_vector_type(8)));
typedef float f32x4 __attribute__((ext_vector_type(4)));
typedef float f32x2 __attribute__((ext_vector_type(2)));
typedef unsigned u32x4 __attribute__((ext_vector_type(4)));
typedef unsigned u32x2 __attribute__((ext_vector_type(2)));
typedef GAS unsigned gu32;
#define RLX_AGENT __ATOMIC_RELAXED, __HIP_MEMORY_SCOPE_AGENT
#define LDS_WAIT() asm volatile("s_waitcnt lgkmcnt(0)" ::: "memory")
#define VM_WAIT() asm volatile("s_waitcnt vmcnt(0)" ::: "memory")

constexpr int D = 1024, NB = 8, T = 2048, NC = 256, NLAT = NB * T, NCTX = NB * NC, NR = NLAT + NCTX, KEYS = T + NC;
constexpr int ZROW = NR;
constexpr float EPS = 1e-6f;
constexpr int NWAVES = 8, NTHREADS = 512;
constexpr int ECAP = NR;
constexpr float C2 = 0.125f * 1.4426950408889634f;

constexpr size_t MiB = 1ull << 20;
constexpr size_t O_X = 0;
constexpr size_t O_ROUTE = 72 * MiB;
constexpr size_t O_WD = 82 * MiB;
constexpr size_t O_ACT = 114 * MiB;
constexpr size_t O_ACTS = 187 * MiB;
constexpr size_t O_Y = 196 * MiB;
constexpr size_t O_A = 120 * MiB;
constexpr size_t O_Z = 157 * MiB;
constexpr size_t O_CAT = 247 * MiB;
constexpr size_t O_Q = 283 * MiB;
constexpr size_t O_K = 301 * MiB;
constexpr size_t O_V = 319 * MiB;
constexpr size_t O_A2 = 340 * MiB;
constexpr size_t O_WD1 = 464 * MiB;
constexpr size_t O_WGU = 400 * MiB;
constexpr size_t O_MOD = 500 * MiB;
constexpr size_t O_CTL = 509 * MiB;
constexpr size_t O_WINAB = 510 * MiB;
constexpr size_t O_WOUTAB = 514 * MiB;
constexpr size_t O_WINCD = 516 * MiB;
constexpr size_t O_WOUTCD = 521 * MiB;
constexpr size_t O_WR = 523 * MiB;
constexpr size_t O_WSGU = 524 * MiB;
constexpr size_t O_WSD = 526 * MiB;
constexpr size_t O_SGW = 527 * MiB;
constexpr size_t O_END = 528 * MiB;
constexpr size_t R_DEST = 0;
constexpr size_t R_LIST = 1 * MiB;
constexpr size_t R_GTK = 5 * MiB + MiB / 2;
static_assert(R_LIST + (size_t)64 * ECAP * 4 <= R_GTK && R_GTK + (size_t)NR * 8 * 4 <= 10 * MiB, "route map");
constexpr int CW_TMO = 0;
constexpr int CW_CNT = 64;
constexpr int CW_BAR = 4096;

constexpr int RING_BYTES = 131072;
constexpr int LDSX_OFF = RING_BYTES;
constexpr int MISC_OFF = RING_BYTES + 12288;
constexpr int LDS_BYTES = 147456;

__device__ __forceinline__ unsigned f2bf(float f) { unsigned u = __builtin_bit_cast(unsigned, f); return (u + 0x7fffu + ((u >> 16) & 1u)) >> 16; }
__device__ __forceinline__ unsigned pk2(float lo, float hi) { return f2bf(lo) | (f2bf(hi) << 16); }
__device__ __forceinline__ float bf2f(unsigned short b) { return __builtin_bit_cast(float, (unsigned)b << 16); }
__device__ __forceinline__ float bflo(unsigned w) { return __builtin_bit_cast(float, w << 16); }
__device__ __forceinline__ float bfhi(unsigned w) { return __builtin_bit_cast(float, w & 0xffff0000u); }
__device__ __forceinline__ float wave_sum(float v) { return __ockl_wfred_add_f32(v); }
__device__ __forceinline__ float fast_sigmoid(float x) { return __builtin_amdgcn_rcpf(1.f + __builtin_amdgcn_exp2f(-1.4426950408889634f * x)); }
__device__ __forceinline__ float fast_silu(float x) { return x * fast_sigmoid(x); }
__device__ __forceinline__ int ci_of_row(int row) { return row < NLAT ? row / T : 8; }

#define XB_TMO      128
#define XB_XCNT(j)  (256  + 64 * (j))
#define XB_XSUB(j)  (1280 + 64 * (j))
#define XB_XGEN(j)  (2304 + 64 * (j))
#define XB_TOP      3328
#define XB_TOPGEN   3392
#define XCD_BAR_WORDS 3456
#define XB_SPIN_CAP (1u << 18)
__device__ __forceinline__ unsigned xb_ld(unsigned* p)              { return __hip_atomic_load(p, __ATOMIC_RELAXED, __HIP_MEMORY_SCOPE_AGENT); }
__device__ __forceinline__ unsigned xb_add(unsigned* p, unsigned v) { return __hip_atomic_fetch_add(p, v, __ATOMIC_RELAXED, __HIP_MEMORY_SCOPE_AGENT); }
__device__ __forceinline__ unsigned xb_xcc_id() { return (unsigned)__builtin_amdgcn_s_getreg((3 << 11) | 20) & 0xFu; }
#define XB_SPIN(cond, bar) do { unsigned _sp = 0; while (cond) { __builtin_amdgcn_s_sleep(1); \
    if ((++_sp & 255u) == 0u) { if (xb_ld(&(bar)[XB_TMO])) break; if (_sp > XB_SPIN_CAP) { atomicAdd(&(bar)[XB_TMO], 1u); break; } } } } while (0)
struct XcdBarrier { unsigned* bar; unsigned x; volatile LAS unsigned* st; };
__device__ __forceinline__ XcdBarrier xcd_barrier_post(unsigned* bar, volatile LAS unsigned* st) {
    XcdBarrier b; b.bar = bar; b.x = xb_xcc_id(); b.st = st;
    if (threadIdx.x == 0) (void)xb_add(&bar[XB_XCNT(b.x)], 1u);
    return b;
}
__device__ __forceinline__ void xcd_barrier_complete(unsigned* bar, unsigned x, unsigned& nloc, unsigned& nx) {
    const unsigned G = gridDim.x * gridDim.y * gridDim.z;
    unsigned sum, cnt, mine, sp = 0u;
    for (;;) {
        sum = 0u; cnt = 0u; mine = 0u;
#pragma unroll
        for (unsigned j = 0; j < 16; ++j) { const unsigned c = xb_ld(&bar[XB_XCNT(j)]); sum += c; cnt += (c > 0u) ? 1u : 0u; mine = (j == x) ? c : mine; }
        if (sum == G) break;
        __builtin_amdgcn_s_sleep(1);
        if ((++sp & 255u) == 0u) { if (xb_ld(&bar[XB_TMO])) break; if (sp > XB_SPIN_CAP) { atomicAdd(&bar[XB_TMO], 1u); break; } }
    }
    nloc = mine > 0u ? mine : 1u; nx = cnt > 0u ? cnt : 1u;
}
__device__ __forceinline__ void xcd_barrier(const XcdBarrier& b) {
    asm volatile("s_waitcnt vmcnt(0)" ::: "memory");
    __syncthreads();
    if (threadIdx.x == 0) {
        unsigned* bar = b.bar;
        __builtin_amdgcn_s_waitcnt(0);
        unsigned nloc = b.st[0], nx = b.st[1];
        if (nloc == 0u) { xcd_barrier_complete(bar, b.x, nloc, nx); b.st[0] = nloc; b.st[1] = nx; }
        const unsigned old = xb_add(&bar[XB_XSUB(b.x)], 1u);
        const unsigned gen = old / nloc;
        if (old + 1u == (gen + 1u) * nloc) {
            __builtin_amdgcn_fence(__ATOMIC_RELEASE, "agent");
            asm volatile("s_waitcnt vmcnt(0)" ::: "memory");
            const unsigned og = xb_add(&bar[XB_TOP], 1u);
            const unsigned tg = og / nx;
            if (og + 1u == (tg + 1u) * nx) xb_add(&bar[XB_TOPGEN], 1u);
            else XB_SPIN(xb_ld(&bar[XB_TOPGEN]) == tg, bar);
            __builtin_amdgcn_fence(__ATOMIC_ACQUIRE, "agent");
            xb_add(&bar[XB_XGEN(b.x)], 1u);
            asm volatile("s_waitcnt vmcnt(0)" ::: "memory");
        } else {
            XB_SPIN(xb_ld(&bar[XB_XGEN(b.x)]) == gen, bar);
            __builtin_amdgcn_fence(__ATOMIC_ACQUIRE, "agent");
            asm volatile("s_waitcnt vmcnt(0)" ::: "memory");
        }
    }
    __syncthreads();
}

struct In {
    const float *x, *c, *ctx, *c_ctx, *norm_g, *w_ada, *b_ada, *w_in_ab, *w_out_ab, *conv_w, *conv_b, *conv_ln_g, *conv_ln_b, *qn_g, *kn_g,
        *w_in_cd, *w_out_cd, *sg_ln_g, *sg_ln_b, *sg_w, *sg_b, *na_rpb, *w_router, *b_router, *w_gate, *w_up, *w_down, *ws_gate, *ws_up, *ws_down, *g_final;
};
struct Args { In in; float* out; unsigned char* ws; int ph_lo, ph_hi, li, pad; };
struct Frame {
    LAS unsigned char* lds;
    unsigned char* ws;
    int tid, lane, wave, vcu, G;
};

constexpr int BM = 256, BK = 64, HALF = 128, HTB = HALF * BK * 2, STAGE_BYTES = 8 * HTB;
__device__ __forceinline__ int lds_byte(int r, int c) { const int st = (r >> 4) * 2 + (c >> 5), rr = r & 15, cc = c & 31, ob = rr * 64 + cc * 2; return st * 1024 + (ob ^ (((ob >> 9) & 1) << 5)); }
__device__ __forceinline__ void stage_rc(int b, int& R, int& C) { const int st = b / 1024, sb = b % 1024, swz = sb ^ (((sb >> 9) & 1) << 5); R = (st >> 1) * 16 + swz / 64; C = (st & 1) * 32 + (swz % 64) / 2; }
__device__ __forceinline__ int perm32(int rho) { const int n = rho >> 4, i = rho & 15; return 8 * (i >> 2) + 4 * n + (i & 3); }
__device__ __forceinline__ unsigned cvt_pk_bf16(float lo, float hi) { unsigned r; asm volatile("v_cvt_pk_bf16_f32 %0, %1, %2" : "=v"(r) : "v"(lo), "v"(hi)); return r; }

struct GUnit {
    const char* Bp;
    const int* rows;
    int arow0;
    int orow0;
    int nvalid;
    int pn;
    int e;
};
typedef f32x4 Acc[2][2][4][2];

template <class Epi, class Sched>
__device__ __forceinline__ void gemm_phase(LAS unsigned char* lds, const char* Abase, const int K, const Sched& S, const Epi& E) {
    int tid = threadIdx.x; asm volatile("" : "+v"(tid));
    const int wid = __builtin_amdgcn_readfirstlane(tid >> 6), lane = tid & 63, wr = wid >> 2, wc = wid & 3, fr = lane & 15, fq = lane >> 4;
    const int nt = K / BK;
    int R0, C0; stage_rc(tid * 16, R0, C0);
    unsigned voffB[2];
#pragma unroll
    for (int i = 0; i < 2; ++i) { const int R = R0 + 64 * i; const int Rb = Epi::PERM ? ((R & ~31) + perm32(R & 31)) : R; voffB[i] = (unsigned)(Rb * K + C0) * 2u; }
    const size_t kstep = (size_t)(BK * 2);
    const size_t hstep = (size_t)HALF * K * 2;
    const unsigned ldsw = (unsigned)wid * 1024u;
    const int aoff = lds_byte(wr * 64 + fr, fq * 8), boff = lds_byte(wc * 32 + fr, fq * 8);
#define PG8_SA(b, h) (((b) * 2 + (h)) * HTB)
#define PG8_SB(b, h) ((4 + (b) * 2 + (h)) * HTB)
#define PG8_STAGE2(bufoff, gbase, v0, v1) do { \
        __builtin_amdgcn_global_load_lds((const unsigned*)((const char*)(gbase) + (v0)), (LAS unsigned*)(lds + (bufoff) + ldsw), 16, 0, 0); \
        __builtin_amdgcn_global_load_lds((const unsigned*)((const char*)(gbase) + (v1)), (LAS unsigned*)(lds + (bufoff) + ldsw + 8192), 16, 0, 0); } while (0)
#define PG8_STAGEB(bufoff, gbase) PG8_STAGE2(bufoff, gbase, voffB[0], voffB[1])
#define PG8_LDA(dst, b, h) do { _Pragma("unroll") for (int m = 0; m < 4; ++m) _Pragma("unroll") for (int k = 0; k < 2; ++k) dst[m][k] = *(const LAS bf16x8*)(lds + PG8_SA(b, h) + aoff + m * 2048 + k * 1024); } while (0)
#define PG8_LDB(dst, b, h) do { _Pragma("unroll") for (int n = 0; n < 2; ++n) _Pragma("unroll") for (int k = 0; k < 2; ++k) dst[n][k] = *(const LAS bf16x8*)(lds + PG8_SB(b, h) + boff + n * 2048 + k * 1024); } while (0)
#define PG8_MMA(ai, bj, At, Bt) do { __builtin_amdgcn_s_setprio(1); _Pragma("unroll") for (int m = 0; m < 4; ++m) _Pragma("unroll") for (int n = 0; n < 2; ++n) _Pragma("unroll") for (int k = 0; k < 2; ++k) \
        acc[ai][bj][m][n] = __builtin_amdgcn_mfma_f32_16x16x32_bf16(Bt[n][k], At[m][k], acc[ai][bj][m][n], 0, 0, 0); __builtin_amdgcn_s_setprio(0); } while (0)
#define PG8_WAIT_V(n) asm volatile("s_waitcnt vmcnt(" #n ")" ::: "memory")
#define PG8_WAIT_L(n) asm volatile("s_waitcnt lgkmcnt(" #n ")" ::: "memory")
#define PG8_BAR __builtin_amdgcn_s_barrier()
#define PG8_SCHED __builtin_amdgcn_sched_barrier(0)
#define PG8_VOFF(u, vo) do { _Pragma("unroll") for (int h_ = 0; h_ < 2; ++h_) _Pragma("unroll") for (int i_ = 0; i_ < 2; ++i_) { const int r_ = h_ * 128 + R0 + 64 * i_; \
        int row_; if ((u).rows) { row_ = ZROW; if (r_ < (u).nvalid) row_ = (u).rows[r_]; } else row_ = (u).arow0 + r_; vo[h_][i_] = (unsigned)(row_ * K + C0) * 2u; } } while (0)
    GUnit cur, nxt; int ui = 0;
    if (!S.next(0, cur)) return;
    Acc acc;
#pragma unroll
    for (int a = 0; a < 2; ++a)
#pragma unroll
        for (int b = 0; b < 2; ++b)
#pragma unroll
            for (int m = 0; m < 4; ++m)
#pragma unroll
                for (int n = 0; n < 2; ++n) acc[a][b][m][n] = (f32x4){0.f, 0.f, 0.f, 0.f};
    bf16x8 At[4][2], B0[2][2], B1[2][2];
    unsigned vA[2][2], vN[2][2];
    PG8_VOFF(cur, vA);
    const char* cB = cur.Bp;
    const char* const cA = Abase;
    PG8_STAGEB(PG8_SB(0, 0), cB); PG8_STAGEB(PG8_SB(0, 1), cB + hstep); PG8_STAGE2(PG8_SA(0, 0), cA, vA[0][0], vA[0][1]); PG8_STAGE2(PG8_SA(0, 1), cA, vA[1][0], vA[1][1]);
    if (wr == 1) PG8_BAR;
    PG8_WAIT_V(2); PG8_BAR;
    PG8_STAGEB(PG8_SB(1, 0), cB + kstep); PG8_STAGE2(PG8_SA(1, 0), cA + kstep, vA[0][0], vA[0][1]); PG8_STAGEB(PG8_SB(1, 1), cB + hstep + kstep);
    PG8_WAIT_V(6); PG8_BAR;
    for (;;) {
        const bool has_next = S.next(ui + 1, nxt);
        if (has_next) { PG8_VOFF(nxt, vN); }
        else {
#pragma unroll
            for (int h = 0; h < 2; ++h)
#pragma unroll
                for (int i = 0; i < 2; ++i) vN[h][i] = vA[h][i];
        }
        const char* nB = has_next ? nxt.Bp : cB;
#pragma nounroll
        for (int t = 0; t < nt; t += 2) {
            const bool last = (t == nt - 2);
            const char* a1 = cA + (size_t)(t + 1) * kstep;
            const char* a2 = last ? cA : cA + (size_t)(t + 2) * kstep; const char* b2 = last ? nB : cB + (size_t)(t + 2) * kstep;
            const char* a3 = a2 + kstep; const char* b3 = b2 + kstep;
            const unsigned w00 = last ? vN[0][0] : vA[0][0], w01 = last ? vN[0][1] : vA[0][1], w10 = last ? vN[1][0] : vA[1][0], w11 = last ? vN[1][1] : vA[1][1];
            PG8_LDB(B0, 0, 0); PG8_LDB(B1, 0, 1); PG8_SCHED; PG8_LDA(At, 0, 0); PG8_STAGE2(PG8_SA(1, 1), a1, vA[1][0], vA[1][1]);
            PG8_WAIT_V(8); PG8_WAIT_L(0); PG8_BAR; PG8_MMA(0, 0, At, B0); PG8_MMA(0, 1, At, B1); PG8_BAR; PG8_SCHED;
            PG8_LDA(At, 0, 1); PG8_STAGEB(PG8_SB(0, 0), b2); PG8_STAGEB(PG8_SB(0, 1), b2 + hstep); PG8_STAGE2(PG8_SA(0, 0), a2, w00, w01);
            PG8_WAIT_V(8); PG8_WAIT_L(0); PG8_BAR; PG8_MMA(1, 0, At, B0); PG8_MMA(1, 1, At, B1); PG8_BAR; PG8_SCHED;
            PG8_LDB(B0, 1, 0); PG8_LDB(B1, 1, 1); PG8_SCHED; PG8_LDA(At, 1, 0); PG8_STAGE2(PG8_SA(0, 1), a2, w10, w11);
            PG8_WAIT_V(8); PG8_WAIT_L(0); PG8_BAR; PG8_MMA(0, 0, At, B0); PG8_MMA(0, 1, At, B1); PG8_BAR; PG8_SCHED;
            PG8_LDA(At, 1, 1); PG8_STAGEB(PG8_SB(1, 0), b3); PG8_STAGEB(PG8_SB(1, 1), b3 + hstep); PG8_STAGE2(PG8_SA(1, 0), a3, w00, w01);
            PG8_WAIT_V(8); PG8_WAIT_L(0); PG8_BAR; PG8_MMA(1, 0, At, B0); PG8_MMA(1, 1, At, B1); PG8_BAR; PG8_SCHED;
        }
        if (wr == 0) PG8_BAR;
        E(acc, cur, wr, wc, fr, fq);
        S.done(cur, lane);
        if (!has_next) break;
#pragma unroll
        for (int a = 0; a < 2; ++a)
#pragma unroll
            for (int b = 0; b < 2; ++b)
#pragma unroll
                for (int m = 0; m < 4; ++m)
#pragma unroll
                    for (int n = 0; n < 2; ++n) acc[a][b][m][n] = (f32x4){0.f, 0.f, 0.f, 0.f};
        cur = nxt; cB = nB; ++ui;
#pragma unroll
        for (int h = 0; h < 2; ++h)
#pragma unroll
            for (int i = 0; i < 2; ++i) vA[h][i] = vN[h][i];
        if (wr == 1) PG8_BAR;
    }
    PG8_WAIT_V(0);
    PG8_BAR;
#undef PG8_SA
#undef PG8_SB
#undef PG8_STAGE2
#undef PG8_STAGEB
#undef PG8_LDA
#undef PG8_LDB
#undef PG8_MMA
#undef PG8_WAIT_V
#undef PG8_WAIT_L
#undef PG8_BAR
#undef PG8_SCHED
#undef PG8_VOFF
}

struct EpiBf16 {
    static constexpr bool PERM = true;
    bf16_t* O; int ldc;
    __device__ __forceinline__ void operator()(const Acc& acc, const GUnit& u, int wr, int wc, int fr, int fq) const {
        const int col0 = u.pn * BM + wc * 32 + 8 * fq;
#pragma unroll
        for (int ai = 0; ai < 2; ++ai)
#pragma unroll
            for (int m = 0; m < 4; ++m) {
                const int r = ai * HALF + wr * 64 + m * 16 + fr;
                if (r < u.nvalid) {
                    bf16_t* rowp = O + (size_t)(u.orow0 + r) * ldc + col0;
#pragma unroll
                    for (int bj = 0; bj < 2; ++bj) { const f32x4 v0 = acc[ai][bj][m][0], v1 = acc[ai][bj][m][1];
                        u32x4 w; w.x = cvt_pk_bf16(v0[0], v0[1]); w.y = cvt_pk_bf16(v0[2], v0[3]); w.z = cvt_pk_bf16(v1[0], v1[1]); w.w = cvt_pk_bf16(v1[2], v1[3]);
                        *(u32x4*)(rowp + bj * HALF) = w; }
                }
            }
    }
};
struct EpiResid {
    static constexpr bool PERM = true;
    const float* blat; const float* bctx; const bf16_t* bx; bf16_t* out; const float* gate;
    __device__ __forceinline__ void operator()(const Acc& acc, const GUnit& u, int wr, int wc, int fr, int fq) const {
        const int col0 = u.pn * BM + wc * 32 + 8 * fq;
        const int ci = ci_of_row(u.orow0);
        const float* basef = u.orow0 < NLAT ? blat + (size_t)u.orow0 * D : bctx + (size_t)(u.orow0 - NLAT) * D;
#pragma unroll
        for (int bj = 0; bj < 2; ++bj) {
            const f32x4 gv0 = *(const f32x4*)(gate + (size_t)ci * 6144 + col0 + bj * HALF), gv1 = *(const f32x4*)(gate + (size_t)ci * 6144 + col0 + bj * HALF + 4);
#pragma unroll
            for (int ai = 0; ai < 2; ++ai)
#pragma unroll
                for (int m = 0; m < 4; ++m) {
                    const int r = ai * HALF + wr * 64 + m * 16 + fr;
                    f32x4 b0, b1;
                    if (bx) { const u32x4 w = *(const u32x4*)(bx + (size_t)(u.orow0 + r) * D + col0 + bj * HALF);
                        b0 = (f32x4){bflo(w.x), bfhi(w.x), bflo(w.y), bfhi(w.y)}; b1 = (f32x4){bflo(w.z), bfhi(w.z), bflo(w.w), bfhi(w.w)}; }
                    else { b0 = *(const f32x4*)(basef + (size_t)r * D + col0 + bj * HALF); b1 = *(const f32x4*)(basef + (size_t)r * D + col0 + bj * HALF + 4); }
                    const f32x4 o0 = b0 + gv0 * acc[ai][bj][m][0], o1 = b1 + gv1 * acc[ai][bj][m][1];
                    u32x4 w; w.x = cvt_pk_bf16(o0[0], o0[1]); w.y = cvt_pk_bf16(o0[2], o0[3]); w.z = cvt_pk_bf16(o1[0], o1[1]); w.w = cvt_pk_bf16(o1[2], o1[3]);
                    *(u32x4*)(out + (size_t)(u.orow0 + r) * D + col0 + bj * HALF) = w;
                    if (m & 1) asm volatile("" ::: "memory");
                }
        }
    }
};
struct EpiSwiglu {
    static constexpr bool PERM = true;
    bf16_t* O;
    __device__ __forceinline__ void operator()(const Acc& acc, const GUnit& u, int wr, int wc, int fr, int fq) const {
        const int col0 = u.pn * HALF + wc * 32 + 8 * fq;
#pragma unroll
        for (int ai = 0; ai < 2; ++ai)
#pragma unroll
            for (int m = 0; m < 4; ++m) {
                const int r = ai * HALF + wr * 64 + m * 16 + fr;
                if (r < u.nvalid) {
                    const f32x4 g0 = acc[ai][0][m][0], g1 = acc[ai][0][m][1], u0 = acc[ai][1][m][0], u1 = acc[ai][1][m][1];
                    u32x4 w;
                    w.x = cvt_pk_bf16(fast_silu(g0[0]) * u0[0], fast_silu(g0[1]) * u0[1]); w.y = cvt_pk_bf16(fast_silu(g0[2]) * u0[2], fast_silu(g0[3]) * u0[3]);
                    w.z = cvt_pk_bf16(fast_silu(g1[0]) * u1[0], fast_silu(g1[1]) * u1[1]); w.w = cvt_pk_bf16(fast_silu(g1[2]) * u1[2], fast_silu(g1[3]) * u1[3]);
                    *(u32x4*)(O + (size_t)(u.orow0 + r) * 256 + col0) = w;
                }
            }
    }
};

struct DenseSched {
    const char* Bt; int K; int nM, nN; int G, vcu; int ctx_pm0, ctx_pn0;
    __device__ __forceinline__ bool next(int i, GUnit& u) const {
        if (vcu >= G) return false;
        int L = i * G + vcu;
        const int nfull = ctx_pm0 * nN;
        int pm, pn;
        if (L < nfull) { pm = L / nN; pn = L % nN; }
        else { L -= nfull; const int w = nN - ctx_pn0; pm = ctx_pm0 + L / w; pn = ctx_pn0 + L % w; if (pm >= nM) return false; }
        u.Bp = Bt + (size_t)pn * 256 * K * 2; u.rows = nullptr; u.arow0 = pm * 256; u.orow0 = pm * 256; u.nvalid = 256; u.pn = pn; u.e = 0;
        return true;
    }
    __device__ __forceinline__ void done(const GUnit&, int) const {}
};

__device__ __forceinline__ void cvt_item(const float* W, int N, int k0, int n0, bf16_t* WT, int K, int drow0, LAS float* scr, int lane) {
#pragma unroll 8
    for (int i = 0; i < 32; ++i) { const int kk = 2 * i + (lane >> 5); scr[kk * 33 + (lane & 31)] = W[(size_t)(k0 + kk) * N + n0 + (lane & 31)]; }
    LDS_WAIT(); asm volatile("" ::: "memory");
    const int c = lane & 7;
#pragma unroll
    for (int j = 0; j < 4; ++j) { const int n = (lane >> 3) + 8 * j; const LAS float* s = scr + (8 * c) * 33 + n;
        u32x4 o; o.x = pk2(s[0 * 33], s[1 * 33]); o.y = pk2(s[2 * 33], s[3 * 33]); o.z = pk2(s[4 * 33], s[5 * 33]); o.w = pk2(s[6 * 33], s[7 * 33]);
        *(GAS u32x4*)(WT + (size_t)(drow0 + n) * K + k0 + 8 * c) = o; }
    LDS_WAIT(); asm volatile("" ::: "memory");
}
__device__ __forceinline__ bool cvt_job(int& r, const float* W, int K, int N, bf16_t* WT, LAS float* scr, int lane) {
    const int nblk = N / 32, items = (K / 64) * nblk;
    if (r >= items) { r -= items; return false; }
    const int kb = r / nblk, nb = r % nblk;
    cvt_item(W, N, kb * 64, nb * 32, WT, K, nb * 32, scr, lane);
    return true;
}
__device__ __forceinline__ void phase_cvt_mixer(const Frame& F, const In& in) {
    LAS float* scr = (LAS float*)(F.lds + F.wave * 16384);
    const int gw = F.vcu * NWAVES + F.wave, NGW = F.G * NWAVES;
    constexpr int I_AB = 16 * 56, I_O = 16 * 32, I_CD = 16 * 80;
    constexpr int NITEMS = I_AB + I_O + I_CD + I_O;
    for (int it = gw; it < NITEMS; it += NGW) {
        int r = it;
        if (cvt_job(r, in.w_in_ab, D, 1792, (bf16_t*)(F.ws + O_WINAB), scr, F.lane)) continue;
        if (cvt_job(r, in.w_out_ab, D, D, (bf16_t*)(F.ws + O_WOUTAB), scr, F.lane)) continue;
        if (cvt_job(r, in.w_in_cd, D, 2560, (bf16_t*)(F.ws + O_WINCD), scr, F.lane)) continue;
        cvt_job(r, in.w_out_cd, D, D, (bf16_t*)(F.ws + O_WOUTCD), scr, F.lane);
    }
    bf16_t* sg = (bf16_t*)(F.ws + O_SGW);
    for (int i = (F.vcu * NTHREADS + F.tid) * 4; i < 8 * 128 * 128; i += F.G * NTHREADS * 4) {
        const f32x4 v = *(const f32x4*)(in.sg_w + i);
        u32x2 o; o.x = pk2(v[0], v[1]); o.y = pk2(v[2], v[3]);
        *(u32x2*)(sg + i) = o;
    }
}
__device__ __forceinline__ void phase_cvt_down(const Frame& F, const In& in, int l, int cu0, int ncu) {
    if (F.vcu < cu0 || F.vcu >= cu0 + ncu) return;
    LAS float* scr = (LAS float*)(F.lds + F.wave * 16384);
    const int gw = (F.vcu - cu0) * NWAVES + F.wave, NGW = ncu * NWAVES;
    constexpr int I_DN = 4 * 32, N_R = 64 * I_DN;
    bf16_t* WD = (bf16_t*)(F.ws + (l == 0 ? O_WD : O_WD1)); bf16_t* WSD = (bf16_t*)(F.ws + O_WSD) + (size_t)l * D * 256;
    for (int it = gw; it < N_R + 128; it += NGW) {
        int r = it;
        if (r < N_R) { const int e = r / I_DN, q = r % I_DN, kb = q / 32, nb = q % 32;
            cvt_item(in.w_down + ((size_t)l * 64 + e) * 256 * D, D, kb * 64, nb * 32, WD + (size_t)e * D * 256, 256, nb * 32, scr, F.lane); continue; }
        r -= N_R;
        { const int kb = r / 32, nb = r % 32; cvt_item(in.ws_down + (size_t)l * 256 * D, D, kb * 64, nb * 32, WSD, 256, nb * 32, scr, F.lane); }
    }
}

struct CvtDesc { const float* W; bf16_t* WT; bf16_t* WTL; int N, k0, n0, drow0, pitch; };
constexpr int CVT32_GU = 64 * 256;
constexpr int CVT32_ITEMS = 2 * CVT32_GU + 2 * 256 + 64;
__device__ __forceinline__ CvtDesc cvt32_desc(const In& in, unsigned char* ws, int l, int it) {
    CvtDesc d; d.WTL = nullptr; d.pitch = D;
    int r = it;
    if (r < 2 * CVT32_GU) {
        const int up = r >= CVT32_GU; if (up) r -= CVT32_GU;
        const int e = r >> 8, q = r & 255, kb = q >> 3, nb = q & 7;
        d.W = (up ? in.w_up : in.w_gate) + ((size_t)l * 64 + e) * D * 256; d.N = 256; d.k0 = kb * 32; d.n0 = nb * 32;
        d.WT = (bf16_t*)(ws + O_WGU); d.drow0 = e * 512 + (d.n0 / 128) * 256 + up * 128 + (d.n0 % 128);
        return d;
    }
    r -= 2 * CVT32_GU;
    if (r < 512) {
        const int up = r >= 256; if (up) r -= 256;
        const int kb = r >> 3, nb = r & 7;
        d.W = (up ? in.ws_up : in.ws_gate) + (size_t)l * D * 256; d.N = 256; d.k0 = kb * 32; d.n0 = nb * 32;
        d.WT = (bf16_t*)(ws + O_WSGU) + (size_t)l * 512 * D; d.drow0 = (d.n0 / 128) * 256 + up * 128 + (d.n0 % 128);
        return d;
    }
    r -= 512;
    d.W = in.w_router + (size_t)l * D * 64; d.N = 64; d.k0 = (r >> 1) * 32; d.n0 = (r & 1) * 32;
    d.WT = (bf16_t*)(ws + O_WR) + (size_t)l * 2 * 64 * D; d.WTL = d.WT + 64 * D; d.drow0 = d.n0;
    return d;
}
constexpr int CVB = 8;
__device__ __forceinline__ void cvt_range(const Frame& F, const In& in, int l, int it0, int it1, int scr_base) {
    LAS float* scr = (LAS float*)(F.lds + scr_base + F.wave * 4224);
    const int lane = F.lane, lk = lane >> 3, ln4 = (lane & 7) * 4;
    for (int ib = it0 + CVB * F.wave; ib < it1; ib += CVB * NWAVES) {
        CvtDesc d[CVB]; f32x4 v[CVB][4];
#pragma unroll
        for (int b = 0; b < CVB; ++b) { d[b] = cvt32_desc(in, F.ws, l, min(ib + b, it1 - 1));
#pragma unroll
            for (int i = 0; i < 4; ++i) v[b][i] = *(const f32x4*)(d[b].W + (size_t)(d[b].k0 + lk + 8 * i) * d[b].N + d[b].n0 + ln4); }
#pragma unroll
        for (int b = 0; b < CVB; ++b) {
            if (ib + b < it1) {
#pragma unroll
                for (int i = 0; i < 4; ++i) { LAS float* sp = scr + (lk + 8 * i) * 33 + ln4; sp[0] = v[b][i][0]; sp[1] = v[b][i][1]; sp[2] = v[b][i][2]; sp[3] = v[b][i][3]; }
                LDS_WAIT(); asm volatile("" ::: "memory");
#pragma unroll
                for (int j = 0; j < 2; ++j) { const int t = lane + 64 * j, n = t >> 2, c = t & 3; const LAS float* sp = scr + (8 * c) * 33 + n;
                    float x[8];
#pragma unroll
                    for (int q = 0; q < 8; ++q) x[q] = sp[q * 33];
                    u32x4 o; o.x = cvt_pk_bf16(x[0], x[1]); o.y = cvt_pk_bf16(x[2], x[3]); o.z = cvt_pk_bf16(x[4], x[5]); o.w = cvt_pk_bf16(x[6], x[7]);
                    *(GAS u32x4*)(d[b].WT + (size_t)(d[b].drow0 + n) * d[b].pitch + d[b].k0 + 8 * c) = o;
                    if (d[b].WTL) { u32x4 p; p.x = cvt_pk_bf16(x[0] - bflo(o.x), x[1] - bfhi(o.x)); p.y = cvt_pk_bf16(x[2] - bflo(o.y), x[3] - bfhi(o.y));
                        p.z = cvt_pk_bf16(x[4] - bflo(o.z), x[5] - bfhi(o.z)); p.w = cvt_pk_bf16(x[6] - bflo(o.w), x[7] - bfhi(o.w));
                        *(GAS u32x4*)(d[b].WTL + (size_t)(d[b].drow0 + n) * d[b].pitch + d[b].k0 + 8 * c) = p; } }
                LDS_WAIT(); asm volatile("" ::: "memory");
            }
        }
    }
}
__device__ __forceinline__ void cvt_wgu_part(const Frame& F, const In& in, int l, int lo, int hi, int cu0, int ncu, int scr_base) {
    if (F.vcu < cu0 || F.vcu >= cu0 + ncu) return;
    const int k = F.vcu - cu0, n = hi - lo;
    cvt_range(F, in, l, lo + (int)(((long)k * n) / ncu), lo + (int)(((long)(k + 1) * n) / ncu), scr_base);
}

__device__ __forceinline__ void normmod_row(const float* xrow, const float* g, const float* sh, const float* sc, bf16_t* orow, int lane) {
    const GAS f32x4* xr = (const GAS f32x4*)xrow + lane;
    f32x4 v[4]; float s = 0.f;
#pragma unroll
    for (int j = 0; j < 4; ++j) { v[j] = xr[64 * j]; s += (v[j].x * v[j].x + v[j].y * v[j].y) + (v[j].z * v[j].z + v[j].w * v[j].w); }
    const float rstd = rsqrtf(wave_sum(s) * (1.f / D) + EPS);
    GAS u32x2* o8 = (GAS u32x2*)orow + lane;
#pragma unroll
    for (int j = 0; j < 4; ++j) {
        const f32x4 gg = ((const GAS f32x4*)g)[lane + 64 * j], ss = ((const GAS f32x4*)sh)[lane + 64 * j], cc = ((const GAS f32x4*)sc)[lane + 64 * j];
        const f32x4 h = v[j] * rstd * gg * (1.f + cc) + ss;
        u32x2 o; o.x = pk2(h.x, h.y); o.y = pk2(h.z, h.w);
        o8[64 * j] = o;
    }
}
__device__ __forceinline__ void phase_normmod(const Frame& F, const float* xlat, const float* xctx, const float* g, const float* MODl, int jshift, bf16_t* A, int nrows) {
    const int gw = F.vcu * NWAVES + F.wave, NGW = F.G * NWAVES;
    for (int row = gw; row < nrows; row += NGW) {
        const float* xr = row < NLAT ? xlat + (size_t)row * D : xctx + (size_t)(row - NLAT) * D;
        const float* sh = MODl + (size_t)ci_of_row(row) * 6144 + jshift * D;
        normmod_row(xr, g, sh, sh + D, A + (size_t)row * D, F.lane);
    }
    if (gw == 0) { GAS u32x4* z = (GAS u32x4*)(A + (size_t)ZROW * D); z[F.lane] = (u32x4){0u, 0u, 0u, 0u}; z[F.lane + 64] = (u32x4){0u, 0u, 0u, 0u}; }
}
namespace ab {
typedef short s16x4 __attribute__((ext_vector_type(4)));
typedef float f32x16 __attribute__((ext_vector_type(16)));
constexpr int NW = 8, QBLK = 32, QB = QBLK * NW, KVBLK = 64;
__device__ __forceinline__ int crow(int r, int hi) { return (r & 3) + 8 * (r >> 2) + 4 * hi; }
#define SBAR() __builtin_amdgcn_sched_barrier(0)
constexpr int NSLOT = 3, SLOTB = 8192;
constexpr int LDS_K = 0, LDS_V = NSLOT * SLOTB, LDS_WS = 2 * NSLOT * SLOTB, LDS_OST = LDS_WS + NW * 64 * 4, ATTN_LDS_BYTES = LDS_OST + NW * 4096;
__device__ __forceinline__ void glds16(const void* gsrc, unsigned lds_dst) { unsigned keep;
  asm volatile("s_mov_b32 %0, m0\n\ts_mov_b32 m0, %2\n\ts_nop 0\n\tglobal_load_lds_dwordx4 %1, off\n\ts_mov_b32 m0, %0" : "=&s"(keep) : "v"(gsrc), "s"(lds_dst) : "memory"); }
__device__ __forceinline__ float max3f(float a, float b, float c) { float r; asm("v_max3_f32 %0, %1, %2, %3" : "=v"(r) : "v"(a), "v"(b), "v"(c)); return r; }
__device__ __forceinline__ float max2f(float a, float b) { float r; asm("v_max_f32_e32 %0, %1, %2" : "=v"(r) : "v"(a), "v"(b)); return r; }
__device__ __forceinline__ float fadd_s(float a, float b) { float r; asm("v_add_f32_e32 %0, %1, %2" : "=v"(r) : "v"(a), "v"(b)); return r; }
__device__ __forceinline__ float fsub_s(float a, float b) { float r; asm("v_sub_f32_e32 %0, %1, %2" : "=v"(r) : "v"(a), "v"(b)); return r; }
typedef float f32x2_t __attribute__((ext_vector_type(2))); typedef __bf16 bf16x2_t __attribute__((ext_vector_type(2)));
__device__ __forceinline__ unsigned cvtpk_s(float lo, float hi) { f32x2_t v = {lo, hi}; bf16x2_t b = __builtin_convertvector(v, bf16x2_t); return __builtin_bit_cast(unsigned, b); }
#define WAIT_BAR(N) asm volatile("s_waitcnt vmcnt(" #N ") lgkmcnt(0)\n\ts_barrier" ::: "memory")

__device__ __forceinline__ void qkt(f32x16& p0, f32x16& p1, const char* Kslot, const bf16x8* qr, const f32x16& negm, int r32, int hi) {
  const char* kb = Kslot + hi * 1024 + r32 * 16;
  #pragma unroll
  for (int d0 = 0; d0 < 4; ++d0) {
    const bf16x8 b0 = *reinterpret_cast<const bf16x8*>(kb + d0 * 2048);
    const bf16x8 b1 = *reinterpret_cast<const bf16x8*>(kb + d0 * 2048 + 512);
    if (d0 == 0) { p0 = __builtin_amdgcn_mfma_f32_32x32x16_bf16(b0, qr[0], negm, 0, 0, 0); p1 = __builtin_amdgcn_mfma_f32_32x32x16_bf16(b1, qr[0], negm, 0, 0, 0); }
    else { p0 = __builtin_amdgcn_mfma_f32_32x32x16_bf16(b0, qr[d0], p0, 0, 0, 0); p1 = __builtin_amdgcn_mfma_f32_32x32x16_bf16(b1, qr[d0], p1, 0, 0, 0); } }
}
typedef __attribute__((address_space(3))) const char* lds_cptr;
typedef short v4i16_t __attribute__((ext_vector_type(4)));
__device__ __forceinline__ void kload8(bf16x8* kf, lds_cptr kp) {
  kf[0] = *(const __attribute__((address_space(3))) bf16x8*)(kp);        kf[1] = *(const __attribute__((address_space(3))) bf16x8*)(kp + 512);
  kf[2] = *(const __attribute__((address_space(3))) bf16x8*)(kp + 2048); kf[3] = *(const __attribute__((address_space(3))) bf16x8*)(kp + 2560);
  kf[4] = *(const __attribute__((address_space(3))) bf16x8*)(kp + 4096); kf[5] = *(const __attribute__((address_space(3))) bf16x8*)(kp + 4608);
  kf[6] = *(const __attribute__((address_space(3))) bf16x8*)(kp + 6144); kf[7] = *(const __attribute__((address_space(3))) bf16x8*)(kp + 6656);
}
__device__ __forceinline__ void kload2(bf16x8* kf, lds_cptr kp, int j) { kf[2 * j] = *(const __attribute__((address_space(3))) bf16x8*)(kp + j * 2048); kf[2 * j + 1] = *(const __attribute__((address_space(3))) bf16x8*)(kp + j * 2048 + 512); }
__device__ __forceinline__ s16x4 vtr(lds_cptr p) { return __builtin_bit_cast(s16x4, __builtin_amdgcn_ds_read_tr16_b64_v4i16((__attribute__((address_space(3))) v4i16_t*)p)); }
__device__ __forceinline__ float rowmax(const f32x16& p0, const f32x16& p1) {
  float a = max3f(p0[0], p0[1], p1[0]), b = max3f(p0[2], p0[3], p1[1]); a = max3f(a, p1[2], p1[3]);
  #pragma unroll
  for (int r = 4; r < 16; r += 4) { a = max3f(a, p0[r], p0[r + 1]); b = max3f(b, p0[r + 2], p0[r + 3]); a = max3f(a, p1[r], p1[r + 1]); b = max3f(b, p1[r + 2], p1[r + 3]); }
  const float m = max2f(a, b);
  auto rr = __builtin_amdgcn_permlane32_swap(__float_as_uint(m), __float_as_uint(m), false, false);
  return max2f(__uint_as_float(rr[0]), __uint_as_float(rr[1]));
}
__device__ __forceinline__ void pv(f32x16* o, int vb, bf16x8 pa0, bf16x8 pa1, bf16x8 pa2, bf16x8 pa3) {
  #pragma unroll
  for (int d0 = 0; d0 < 2; ++d0) { s16x4 lo[4], hi[4];
    #pragma unroll
    for (int ks = 0; ks < 4; ++ks) {
      asm volatile("ds_read_b64_tr_b16 %0,%1 offset:%c2" : "=&v"(lo[ks]) : "v"(vb), "i"(d0 * 4096 + ks * 1024) : "memory");
      asm volatile("ds_read_b64_tr_b16 %0,%1 offset:%c2" : "=&v"(hi[ks]) : "v"(vb), "i"(d0 * 4096 + ks * 1024 + 512) : "memory"); }
    asm volatile("s_waitcnt lgkmcnt(0)" ::: "memory"); SBAR();
    #define PK(k) (bf16x8){lo[k][0], lo[k][1], lo[k][2], lo[k][3], hi[k][0], hi[k][1], hi[k][2], hi[k][3]}
    o[d0] = __builtin_amdgcn_mfma_f32_32x32x16_bf16(pa0, PK(0), o[d0], 0, 0, 0);
    o[d0] = __builtin_amdgcn_mfma_f32_32x32x16_bf16(pa1, PK(1), o[d0], 0, 0, 0);
    o[d0] = __builtin_amdgcn_mfma_f32_32x32x16_bf16(pa2, PK(2), o[d0], 0, 0, 0);
    o[d0] = __builtin_amdgcn_mfma_f32_32x32x16_bf16(pa3, PK(3), o[d0], 0, 0, 0);
    #undef PK
  }
}
struct TileMap { int nA, tokA, tokB; __device__ __forceinline__ long tok(int t) const { return t < nA ? tokA + 64 * t : tokB + 64 * (t - nA); } };
struct NoHook { __device__ __forceinline__ void operator()(f32x16&, f32x16&, int) const {} };

template <int THRL, class Hook>
__device__ __forceinline__ void attn_unit(const bf16_t* Qw0, int QP, const bf16_t* __restrict__ Kh, const bf16_t* __restrict__ Vh, int KP, const TileMap tm, const int NT,
                                          bf16_t* Ow0, int OP, char* shm, const Hook& hook) {
  int tid = threadIdx.x; asm volatile("" : "+v"(tid)); const int lane = tid & 63, r32 = lane & 31, hi = lane >> 5; const int wid = __builtin_amdgcn_readfirstlane(tid >> 6);
  const bf16_t* Qw = Qw0 + (long)wid * QBLK * QP;
  const unsigned lds0 = (unsigned)(uintptr_t)shm;
  float* wsf = (float*)(shm + LDS_WS) + wid * 64;
  const bf16_t* ksrc = Kh + (long)lane * KP + wid * 8;
  const bf16_t* vsrc = Vh + (long)(16 * (wid & 3) + (lane >> 2)) * KP + (wid >> 2) * 32 + (lane & 3) * 8;
  const unsigned kdst = lds0 + LDS_K + wid * 1024, vdst = lds0 + LDS_V + wid * 1024;
  #define DMA_K(t, slot) glds16(ksrc + tm.tok(t) * KP, (unsigned)__builtin_amdgcn_readfirstlane(kdst + (slot)))
  #define DMA_V(t, slot) glds16(vsrc + tm.tok(t) * KP, (unsigned)__builtin_amdgcn_readfirstlane(vdst + (slot)))
  const int vb0 = (int)(lds0 + LDS_V) + ((lane >> 4) & 1) * 32 + (lane & 3) * 8 + (4 * hi + ((lane & 15) >> 2)) * 64;
  const char* Kbase = shm + LDS_K; bf16x8 kf[8];
  const lds_cptr shm3 = (lds_cptr)shm; const lds_cptr kp0 = shm3 + LDS_K + hi * 1024 + r32 * 16; const lds_cptr vp0 = shm3 + LDS_V + ((lane >> 4) & 1) * 32 + (lane & 3) * 8 + (4 * hi + ((lane & 15) >> 2)) * 64;
  DMA_K(0, 0); DMA_V(0, 0); DMA_K(1, SLOTB);
  bf16x8 qr[4];
  #pragma unroll
  for (int d0 = 0; d0 < 4; ++d0) qr[d0] = *reinterpret_cast<const bf16x8*>(&Qw[(long)r32 * QP + d0 * 16 + hi * 8]);
  float mhat = 0.f, l_reg = 0.f; f32x16 o[2]; o[0] = f32x16{}; o[1] = f32x16{}; f32x16 negm = f32x16{}; asm volatile("" : "+v"(negm));
  #define HOOK(P0, P1, t) hook(P0, P1, t)
  bool resc = false;
  #define START(P0, P1) do { const float rm = rowmax(P0, P1); resc = false; \
    { const float dl = rm; mhat = fadd_s(mhat, dl); \
      _Pragma("unroll") for (int r = 0; r < 16; ++r) { P0[r] = fsub_s(P0[r], dl); P1[r] = fsub_s(P1[r], dl); } \
      _Pragma("unroll") for (int r = 0; r < 16; ++r) negm[r] = -mhat; asm volatile("" : "+v"(negm)); } \
    _Pragma("unroll") for (int r = 0; r < 16; ++r) P0[r] = __builtin_amdgcn_exp2f(P0[r]); } while (0)
  #define RESC() do { if (resc) { asm volatile("s_waitcnt lgkmcnt(0)" ::: "memory"); \
      _Pragma("unroll") for (int d_ = 0; d_ < 2; ++d_) _Pragma("unroll") for (int r = 0; r < 16; ++r) o[d_][r] *= wsf[crow(r, hi)]; } } while (0)
  f32x16 pA0, pA1, pB0, pB1;
  int sl_prev = 0, sl_cur = 0, sl_next = SLOTB;
  #define ROT() do { sl_prev = sl_cur; sl_cur = sl_next; sl_next = (sl_next == (NSLOT - 1) * SLOTB) ? 0 : sl_next + SLOTB; } while (0)
  DMA_K(2, 2 * SLOTB);
  WAIT_BAR(3);
  qkt(pA0, pA1, Kbase, qr, negm, r32, hi); asm volatile("s_nop 15\n\ts_nop 7" : "+v"(pA0), "+v"(pA1)); HOOK(pA0, pA1, 0);
  START(pA0, pA1);
  _Pragma("unroll") for (int r = 0; r < 16; ++r) pA1[r] = __builtin_amdgcn_exp2f(pA1[r]);
  WAIT_BAR(0);
  DMA_K(3, 0); DMA_V(1, SLOTB);
  ROT();
  kload8(kf, kp0 + sl_cur);
  WAIT_BAR(2);
  s16x4 vlo[8], vhi[8]; u32x4 pw0, pw1, pw2, pw3;
  #define PKW(P, B) cvtpk_s(P[B], P[B + 1])
  #define PAF(k) __builtin_bit_cast(bf16x8, pw##k)
  #define VFR(i) (bf16x8){vlo[i][0], vlo[i][1], vlo[i][2], vlo[i][3], vhi[i][0], vhi[i][1], vhi[i][2], vhi[i][3]}
  #define PIN(x) asm volatile("" : "+v"(x))
  #define MX3(a, b, c) __builtin_fmaxf(__builtin_fmaxf((a), (b)), (c))
  #define GAPA(MF, A0, A1, A2, A3, W0, W1, PW) do { MF; sacc += A0; sacc += A1; sacc += A2; sacc += A3; PIN(sacc); W0; W1; PIN(PW); SBAR(); } while (0)
  #define EX(v) __builtin_amdgcn_exp2f(v)
  #define GAPB(MF, X, B) do { MF; X[B] = EX(X[B]); X[B + 1] = EX(X[B + 1]); X[B + 2] = EX(X[B + 2]); X[B + 3] = EX(X[B + 3]); PIN(X); SBAR(); } while (0)
  #define VRD(i) do { vlo[i] = vtr(vp_ + (((i) >> 2) * 4096 + ((i) & 3) * 1024)); vhi[i] = vtr(vp_ + (((i) >> 2) * 4096 + ((i) & 3) * 1024 + 512)); } while (0)
  #define KRD(G, j) do { if (G) { kload2(kf, kp0 + sl_next, j); SBAR(); } } while (0)
  #define STEP(C0, C1, P0, P1, t, GK, GV, GL) do { SBAR(); \
    const lds_cptr vp_ = vp0 + sl_prev; \
    VRD(0); SBAR(); float sacc = (P0[0] + P0[1]); \
    GAPA(C0 = __builtin_amdgcn_mfma_f32_32x32x16_bf16(kf[0], qr[0], negm, 0, 0, 0), P0[2], P0[3], P0[4], P0[5],     pw0[0] = PKW(P0, 0), pw0[1] = PKW(P0, 2), pw0); \
    VRD(4); SBAR(); GAPA(C1 = __builtin_amdgcn_mfma_f32_32x32x16_bf16(kf[1], qr[0], negm, 0, 0, 0), P0[6], P0[7], P0[8], P0[9],     pw0[2] = PKW(P0, 4), pw0[3] = PKW(P0, 6), pw0); \
    VRD(1); SBAR(); GAPA(C0 = __builtin_amdgcn_mfma_f32_32x32x16_bf16(kf[2], qr[1], C0, 0, 0, 0),   P0[10], P0[11], P0[12], P0[13], pw1[0] = PKW(P0, 8), pw1[1] = PKW(P0, 10), pw1); \
    VRD(5); SBAR(); GAPA(C1 = __builtin_amdgcn_mfma_f32_32x32x16_bf16(kf[3], qr[1], C1, 0, 0, 0),   P0[14], P0[15], P1[0], P1[1],   pw1[2] = PKW(P0, 12), pw1[3] = PKW(P0, 14), pw1); \
    VRD(2); SBAR(); GAPA(C0 = __builtin_amdgcn_mfma_f32_32x32x16_bf16(kf[4], qr[2], C0, 0, 0, 0),   P1[2], P1[3], P1[4], P1[5],     pw2[0] = PKW(P1, 0), pw2[1] = PKW(P1, 2), pw2); \
    VRD(6); SBAR(); GAPA(C1 = __builtin_amdgcn_mfma_f32_32x32x16_bf16(kf[5], qr[2], C1, 0, 0, 0),   P1[6], P1[7], P1[8], P1[9],     pw2[2] = PKW(P1, 4), pw2[3] = PKW(P1, 6), pw2); \
    VRD(3); SBAR(); GAPA(C0 = __builtin_amdgcn_mfma_f32_32x32x16_bf16(kf[6], qr[3], C0, 0, 0, 0),   P1[10], P1[11], P1[12], P1[13], pw3[0] = PKW(P1, 8), pw3[1] = PKW(P1, 10), pw3); \
    VRD(7); SBAR(); GAPA(C1 = __builtin_amdgcn_mfma_f32_32x32x16_bf16(kf[7], qr[3], C1, 0, 0, 0),   P1[14], P1[15], 0.f, 0.f,       pw3[2] = PKW(P1, 12), pw3[3] = PKW(P1, 14), pw3); \
    l_reg += sacc; \
    if (GK) { DMA_K((t) + 3, sl_cur); } if (GV) { DMA_V((t) + 1, sl_next); } \
    HOOK(C0, C1, t); \
    { float a = MX3(C0[0], C0[1], C1[0]), b = MX3(C0[2], C0[3], C1[1]); a = MX3(a, C1[2], C1[3]); \
      _Pragma("unroll") for (int r = 4; r < 16; r += 4) { a = MX3(a, C0[r], C0[r + 1]); b = MX3(b, C0[r + 2], C0[r + 3]); a = MX3(a, C1[r], C1[r + 1]); b = MX3(b, C1[r + 2], C1[r + 3]); } \
      float rm = __builtin_fmaxf(a, b); { auto rr = __builtin_amdgcn_permlane32_swap(__float_as_uint(rm), __float_as_uint(rm), false, false); rm = __builtin_fmaxf(__uint_as_float(rr[0]), __uint_as_float(rr[1])); } \
      resc = false; \
      if (__builtin_expect(__any(rm > (float)THRL), 0)) { const float dl = __builtin_fmaxf(rm, 0.f); mhat += dl; \
        _Pragma("unroll") for (int r = 0; r < 16; ++r) { C0[r] -= dl; C1[r] -= dl; } \
        _Pragma("unroll") for (int r = 0; r < 16; ++r) negm[r] = -mhat; asm volatile("" : "+v"(negm)); \
        const float f = __builtin_amdgcn_exp2f(-dl); l_reg *= f; if (hi == 0) wsf[r32] = f; resc = true; } } \
    SBAR(); \
    GAPB(o[0] = __builtin_amdgcn_mfma_f32_32x32x16_bf16(PAF(0), VFR(0), o[0], 0, 0, 0), C0, 0); \
    GAPB(o[1] = __builtin_amdgcn_mfma_f32_32x32x16_bf16(PAF(0), VFR(4), o[1], 0, 0, 0), C0, 4); \
    KRD(GL, 0); GAPB(o[0] = __builtin_amdgcn_mfma_f32_32x32x16_bf16(PAF(1), VFR(1), o[0], 0, 0, 0), C0, 8); \
    KRD(GL, 1); GAPB(o[1] = __builtin_amdgcn_mfma_f32_32x32x16_bf16(PAF(1), VFR(5), o[1], 0, 0, 0), C0, 12); \
    KRD(GL, 2); GAPB(o[0] = __builtin_amdgcn_mfma_f32_32x32x16_bf16(PAF(2), VFR(2), o[0], 0, 0, 0), C1, 0); \
    KRD(GL, 3); GAPB(o[1] = __builtin_amdgcn_mfma_f32_32x32x16_bf16(PAF(2), VFR(6), o[1], 0, 0, 0), C1, 4); \
    GAPB(o[0] = __builtin_amdgcn_mfma_f32_32x32x16_bf16(PAF(3), VFR(3), o[0], 0, 0, 0), C1, 8); \
    GAPB(o[1] = __builtin_amdgcn_mfma_f32_32x32x16_bf16(PAF(3), VFR(7), o[1], 0, 0, 0), C1, 12); \
    } while (0)
  int t = 1;
  for (; t + 5 < NT; t += 2) {
    STEP(pB0, pB1, pA0, pA1, t, true, true, true);     WAIT_BAR(2); RESC(); ROT();
    STEP(pA0, pA1, pB0, pB1, t + 1, true, true, true); WAIT_BAR(2); RESC(); ROT();
  }
  #define ENDW(tt) do { if ((tt) + 3 < NT) { WAIT_BAR(2); } else if ((tt) + 2 < NT) { WAIT_BAR(1); } else { WAIT_BAR(0); } } while (0)
  for (; t + 1 < NT; t += 2) {
    STEP(pB0, pB1, pA0, pA1, t, (t + 3 < NT), (t + 1 < NT), (t + 1 < NT));       ENDW(t);     RESC(); ROT();
    STEP(pA0, pA1, pB0, pB1, t + 1, (t + 4 < NT), (t + 2 < NT), (t + 2 < NT));   ENDW(t + 1); RESC(); ROT();
  }
  STEP(pB0, pB1, pA0, pA1, NT - 1, false, false, false); RESC();
  { float sacc = pB0[0] + pB0[1]; _Pragma("unroll") for (int r = 2; r < 16; ++r) sacc += pB0[r]; _Pragma("unroll") for (int r = 0; r < 16; ++r) sacc += pB1[r]; l_reg += sacc;
    pw0 = (u32x4){PKW(pB0, 0), PKW(pB0, 2), PKW(pB0, 4), PKW(pB0, 6)}; pw1 = (u32x4){PKW(pB0, 8), PKW(pB0, 10), PKW(pB0, 12), PKW(pB0, 14)}; pw2 = (u32x4){PKW(pB1, 0), PKW(pB1, 2), PKW(pB1, 4), PKW(pB1, 6)}; pw3 = (u32x4){PKW(pB1, 8), PKW(pB1, 10), PKW(pB1, 12), PKW(pB1, 14)};
    SBAR(); pv(o, vb0 + sl_cur, PAF(0), PAF(1), PAF(2), PAF(3)); }
  #undef PKW
  #undef PAF
  #undef VFR
  #undef PIN
  #undef MX3
  #undef GAPA
  #undef GAPB
  #undef EX
  #undef VRD
  #undef KRD
  #undef STEP
  #undef ENDW
  { auto rr = __builtin_amdgcn_permlane32_swap(__float_as_uint(l_reg), __float_as_uint(l_reg), false, false); l_reg = __uint_as_float(rr[0]) + __uint_as_float(rr[1]); }
  if (hi == 0) wsf[32 + r32] = l_reg; asm volatile("s_waitcnt lgkmcnt(0)" ::: "memory");
  float rli[16];
  #pragma unroll
  for (int r = 0; r < 16; ++r) rli[r] = __builtin_amdgcn_rcpf(wsf[32 + crow(r, hi)]);
  bf16_t* Ow = Ow0 + (long)wid * QBLK * OP;
  { bf16_t* stg = (bf16_t*)(shm + LDS_OST) + wid * 2048;
    #pragma unroll
    for (int r = 0; r < 16; ++r) { const int orow = crow(r, hi);
      #pragma unroll
      for (int d0 = 0; d0 < 2; ++d0) stg[orow * 64 + d0 * 32 + r32] = (bf16_t)f2bf(o[d0][r] * rli[r]); }
    asm volatile("s_waitcnt lgkmcnt(0)" ::: "memory");
    #pragma unroll
    for (int i = 0; i < 4; ++i) { const int row = i * 8 + (lane >> 3), ch = lane & 7; const u32x4 v = *(const u32x4*)(stg + row * 64 + ch * 8); *(u32x4*)(Ow + (long)row * OP + ch * 8) = v; } }
  asm volatile("s_waitcnt lgkmcnt(0)\n\ts_barrier" ::: "memory");
  #undef DMA_K
  #undef DMA_V
  #undef HOOK
  #undef START
  #undef RESC
  #undef ROT
}
#undef SBAR
#undef WAIT_BAR
}
template <int J> __device__ __forceinline__ void conv_step(const LAS float* glc, const float (&w)[31], float (&acc)[32]) {
    if constexpr (J < 62) {
        const float v = glc[J * 512];
        constexpr int PLO = J - 30 > 0 ? J - 30 : 0, PHI = J < 31 ? J : 31;
#pragma unroll
        for (int p = PLO; p <= PHI; ++p) acc[p] += w[J - p] * v;
        conv_step<J + 1>(glc, w, acc);
    }
}
__device__ __forceinline__ void phase_conv0(const Frame& F, const In& in, const bf16_t* Z  , bf16_t* CAT  ) {
    const int c = F.tid;
    LAS float* gl = (LAS float*)F.lds;
    constexpr int NITEMS = 8 * 64 + 8 * 8;
    for (int it = F.vcu; it < NITEMS; it += F.G) {
        int seqbase, t0, L;
        if (it < 512) { seqbase = (it / 64) * T; t0 = (it % 64) * 32; L = T; }
        else { const int j = it - 512; seqbase = NLAT + (j / 8) * NC; t0 = (j % 8) * 32; L = NC; }
        __syncthreads();
#pragma unroll 2
        for (int i = 0; i < 8; ++i) {
            const int j = (F.tid >> 6) + 8 * i;
            const int tt = t0 - 15 + j, ch = (F.tid & 63) * 8;
            if (j < 62) {
                u32x4 a = (u32x4){0u, 0u, 0u, 0u}, g = a;
                if (tt >= 0 && tt < L) { const bf16_t* zr = Z + (size_t)(seqbase + tt) * 1792 + ch; a = *(const u32x4*)zr; g = *(const u32x4*)(zr + 512); }
                const f32x4 o0 = (f32x4){bflo(a.x) * fast_sigmoid(bflo(g.x)), bfhi(a.x) * fast_sigmoid(bfhi(g.x)), bflo(a.y) * fast_sigmoid(bflo(g.y)), bfhi(a.y) * fast_sigmoid(bfhi(g.y))};
                const f32x4 o1 = (f32x4){bflo(a.z) * fast_sigmoid(bflo(g.z)), bfhi(a.z) * fast_sigmoid(bfhi(g.z)), bflo(a.w) * fast_sigmoid(bflo(g.w)), bfhi(a.w) * fast_sigmoid(bfhi(g.w))};
                *(LAS f32x4*)(gl + j * 512 + ch) = o0; *(LAS f32x4*)(gl + j * 512 + ch + 4) = o1;
            }
        }
        __syncthreads();
        float w[31];
#pragma unroll
        for (int k = 0; k < 31; ++k) w[k] = in.conv_w[k * 512 + c];
        const float cb = in.conv_b[c];
        float acc[32];
#pragma unroll
        for (int p = 0; p < 32; ++p) acc[p] = cb;
        conv_step<0>(gl + c, w, acc);
        __syncthreads();
#pragma unroll
        for (int p = 0; p < 32; ++p) gl[p * 512 + c] = acc[p];
        __syncthreads();
#pragma unroll
        for (int q = 0; q < 4; ++q) {
            const int p = F.wave * 4 + q;
            const f32x4 a = *(const LAS f32x4*)(gl + p * 512 + 8 * F.lane), b = *(const LAS f32x4*)(gl + p * 512 + 8 * F.lane + 4);
            const float mu = wave_sum((a[0] + a[1]) + (a[2] + a[3]) + (b[0] + b[1]) + (b[2] + b[3])) * (1.f / 512.f);
            const f32x4 da = a - mu, db = b - mu;
            const float var = wave_sum((da[0] * da[0] + da[1] * da[1]) + (da[2] * da[2] + da[3] * da[3]) + (db[0] * db[0] + db[1] * db[1]) + (db[2] * db[2] + db[3] * db[3])) * (1.f / 512.f);
            const float rstd = rsqrtf(var + EPS);
            const f32x4 g0 = *(const f32x4*)(in.conv_ln_g + 8 * F.lane), g1 = *(const f32x4*)(in.conv_ln_g + 8 * F.lane + 4);
            const f32x4 b0 = *(const f32x4*)(in.conv_ln_b + 8 * F.lane), b1 = *(const f32x4*)(in.conv_ln_b + 8 * F.lane + 4);
            const f32x4 o0 = da * rstd * g0 + b0, o1 = db * rstd * g1 + b1;
            u32x4 o; o.x = pk2(fast_silu(o0[0]), fast_silu(o0[1])); o.y = pk2(fast_silu(o0[2]), fast_silu(o0[3])); o.z = pk2(fast_silu(o1[0]), fast_silu(o1[1])); o.w = pk2(fast_silu(o1[2]), fast_silu(o1[3]));
            *(u32x4*)(CAT + (size_t)(seqbase + t0 + p) * D + 8 * F.lane) = o;
        }
    }
    __syncthreads();
}

__device__ __forceinline__ void phase_qkv0(const Frame& F, const In& in, const bf16_t* Z, bf16_t* Q, bf16_t* Kb, bf16_t* Vb) {
    const int gw = F.vcu * NWAVES + F.wave, NGW = F.G * NWAVES, lane = F.lane;
    const int d0 = 4 * (lane & 15);
    const f32x4 qg = *(const f32x4*)(in.qn_g + d0), kg = *(const f32x4*)(in.kn_g + d0);
    const int half = d0 >> 5, dd = d0 & 31; const bool first = dd < 16; const int f0 = dd & 15;
    float inv[4];
#pragma unroll
    for (int e = 0; e < 4; ++e) inv[e] = __builtin_amdgcn_exp2f(-(float)(f0 + e) * (13.287712379549449f / 16.f)) * 0.15915494309189535f;
    for (int row = gw; row < NR; row += NGW) {
        const bool lat = row < NLAT;
        int b, t;
        if (lat) { b = row / T; t = row % T; } else { const int r2 = row - NLAT; b = r2 / NC; t = T + r2 % NC; }
        const size_t kvrow = (size_t)b * KEYS + t;
        const float pos = half == 0 ? (float)(t >> 6) : (float)(t & 63);
        float cs[4], sn[4];
#pragma unroll
        for (int e = 0; e < 4; ++e) { const float rev = pos * inv[e]; cs[e] = __builtin_amdgcn_cosf(rev); sn[e] = __builtin_amdgcn_sinf(rev); }
        const bf16_t* zr = Z + (size_t)row * 1792 + 1024;
#pragma unroll
        for (int g = 0; g < 3; ++g) {
            const u32x2 raw = *(const u32x2*)(zr + g * 256 + 4 * lane);
            float x[4] = {bflo(raw.x), bfhi(raw.x), bflo(raw.y), bfhi(raw.y)};
            const bool isv = (g == 2) && lane >= 32;
            float ss = (x[0] * x[0] + x[1] * x[1]) + (x[2] * x[2] + x[3] * x[3]);
            ss += __shfl_xor(ss, 1); ss += __shfl_xor(ss, 2); ss += __shfl_xor(ss, 4); ss += __shfl_xor(ss, 8);
            const float rstd = rsqrtf(ss * (1.f / 64.f) + EPS);
            const f32x4 gn = (g == 2) ? kg : qg;
            float y[4];
#pragma unroll
            for (int e = 0; e < 4; ++e) y[e] = isv ? x[e] : x[e] * rstd * gn[e];
#pragma unroll
            for (int e = 0; e < 4; ++e) {
                const float yp = __shfl_xor(y[e], 4);
                const float r = first ? y[e] * cs[e] - yp * sn[e] : y[e] * cs[e] + yp * sn[e];
                if (lat && !isv) y[e] = r;
            }
            if (g < 2) { u32x2 o; o.x = pk2(y[0] * C2, y[1] * C2); o.y = pk2(y[2] * C2, y[3] * C2); *(u32x2*)(Q + (size_t)row * 512 + g * 256 + 4 * lane) = o; }
            else { u32x2 o; o.x = pk2(y[0], y[1]); o.y = pk2(y[2], y[3]);
                if (lane < 32) *(u32x2*)(Kb + kvrow * 128 + 4 * lane) = o; else *(u32x2*)(Vb + kvrow * 128 + 4 * (lane - 32)) = o; }
        }
    }
}

constexpr int ATTN_CVT_SCR = 86016;
__device__ __forceinline__ void phase_attn0(const Frame& F, const In& in, char* shm, const bf16_t* Q, const bf16_t* Kb, const bf16_t* Vb, bf16_t* CAT) {
    for (int u = F.vcu; u < 512 + 64; u += F.G) {
        if (u < 512) {
            const int bk = u >> 5, qb = (u >> 2) & 7, g = u & 3, b = bk >> 1, hkv = bk & 1, h = hkv * 4 + g;
            const size_t row0 = (size_t)b * T + qb * 256;
            ab::TileMap tm{36, 0, 0};
            ab::attn_unit<8, ab::NoHook>(Q + row0 * 512 + h * 64, 512, Kb + (size_t)b * KEYS * 128 + hkv * 64, Vb + (size_t)b * KEYS * 128 + hkv * 64, 128, tm, 36,
                                         CAT + row0 * D + 512 + h * 64, D, shm, ab::NoHook{});
        } else {
            const int j = u - 512, b = j >> 3, h = j & 7, hkv = h >> 2;
            const size_t row0 = (size_t)NLAT + b * NC;
            ab::TileMap tm{4, T, T};
            ab::attn_unit<8, ab::NoHook>(Q + row0 * 512 + h * 64, 512, Kb + (size_t)b * KEYS * 128 + hkv * 64, Vb + (size_t)b * KEYS * 128 + hkv * 64, 128, tm, 4,
                                         CAT + row0 * D + 512 + h * 64, D, shm, ab::NoHook{});
        }
    }
}
__device__ __forceinline__ unsigned grp8_umax(unsigned v) {
    v = max(v, (unsigned)__builtin_amdgcn_update_dpp((int)v, (int)v, 0xB1, 0xf, 0xf, true));
    v = max(v, (unsigned)__builtin_amdgcn_update_dpp((int)v, (int)v, 0x4E, 0xf, 0xf, true));
    v = max(v, (unsigned)__builtin_amdgcn_update_dpp((int)v, (int)v, 0x141, 0xf, 0xf, true));
    return v;
}
__device__ __forceinline__ float grp8_fmax(float x) {
    int v = __builtin_bit_cast(int, x);
    v = __builtin_bit_cast(int, fmaxf(__builtin_bit_cast(float, v), __builtin_bit_cast(float, __builtin_amdgcn_update_dpp(v, v, 0xB1, 0xf, 0xf, true))));
    v = __builtin_bit_cast(int, fmaxf(__builtin_bit_cast(float, v), __builtin_bit_cast(float, __builtin_amdgcn_update_dpp(v, v, 0x4E, 0xf, 0xf, true))));
    v = __builtin_bit_cast(int, fmaxf(__builtin_bit_cast(float, v), __builtin_bit_cast(float, __builtin_amdgcn_update_dpp(v, v, 0x141, 0xf, 0xf, true))));
    return __builtin_bit_cast(float, v);
}
__device__ __forceinline__ void phase_route(const Frame& F, const In& in, int l, int g0, int g1, const bf16_t* X, const float* MODl, bf16_t* A2, const bool dummy) {
    const int lane = F.lane, w = F.wave, r = lane & 15, q = lane >> 4;
    constexpr int MR = 48;
    LAS float* part = (LAS float*)F.lds;
    LAS float* plog = part + 8 * MR;
    LAS float* G = plog + 8 * MR * 64;
    LAS int* cntw = (LAS int*)(G + 80 * 64);
    LAS float* rk = (LAS float*)(cntw + 8 * 64) + w * 64;
    const bf16_t* WRH = (const bf16_t*)(F.ws + O_WR) + (size_t)l * 2 * 64 * D; const bf16_t* WRL = WRH + 64 * D;
    const float* ng = in.norm_g + (l * 2 + 1) * D + 128 * w + 8 * q;
    const float brl = in.b_router[l * 64 + lane];
    unsigned* cnt = (unsigned*)(F.ws + O_CTL) + CW_CNT + (dummy ? 2 : l) * 64;
    unsigned char* tb = F.ws + (dummy ? O_Y : O_ROUTE);
    int* dest = (int*)(tb + R_DEST); int* list = (int*)(tb + R_LIST); float* gtk = (float*)(tb + R_GTK);
    if (F.vcu == 0 && w == 0) { GAS u32x4* z = (GAS u32x4*)(A2 + (size_t)ZROW * D); z[lane] = (u32x4){0u, 0u, 0u, 0u}; z[lane + 64] = (u32x4){0u, 0u, 0u, 0u}; }
    const bf16_t* wl0 = WRL + (size_t)r * D + 128 * w + 8 * q;
    int mycnt = 0;
    const int myg = g1 - g0;
    for (int m0 = 0; m0 < myg; m0 += 3) {
        const int ng3 = min(3, myg - m0);
        int grp3[3];
#pragma unroll
        for (int gi = 0; gi < 3; ++gi) grp3[gi] = g0 + m0 + min(gi, ng3 - 1);
        {
            u32x4 xw[3][4];
#pragma unroll
            for (int gi = 0; gi < 3; ++gi) { const bf16_t* xr = X + (size_t)(grp3[gi] * 16 + r) * D + 128 * w + 8 * q;
#pragma unroll
                for (int ks = 0; ks < 4; ++ks) xw[gi][ks] = *(const u32x4*)(xr + 32 * ks); }
#pragma unroll
            for (int gi = 0; gi < 3; ++gi) { float ss = 0.f;
#pragma unroll
                for (int ks = 0; ks < 4; ++ks) { const u32x4 a = xw[gi][ks];
#pragma unroll
                    for (int j = 0; j < 4; ++j) { const float lo = bflo(a[j]), hi = bfhi(a[j]); ss += lo * lo + hi * hi; } }
                ss += __shfl_xor(ss, 16); ss += __shfl_xor(ss, 32);
                if (q == 0) part[w * MR + gi * 16 + r] = ss; }
        }
        __syncthreads();
        {
            bf16x8 bh[4][4];
            { const bf16_t* wh0 = WRH + (size_t)r * D + 128 * w + 8 * q; asm volatile("" : "+v"(wh0));
#pragma unroll
              for (int ks = 0; ks < 4; ++ks)
#pragma unroll
                for (int nf = 0; nf < 4; ++nf) bh[ks][nf] = *(const bf16x8*)(wh0 + (size_t)(16 * nf) * D + 32 * ks); }
            float rstd[3]; f32x4 acc[3][4];
#pragma unroll
            for (int gi = 0; gi < 3; ++gi) { float tot = 0.f;
#pragma unroll
                for (int j = 0; j < 8; ++j) tot += part[j * MR + gi * 16 + r];
                rstd[gi] = rsqrtf(tot * (1.f / D) + EPS);
#pragma unroll
                for (int nf = 0; nf < 4; ++nf) acc[gi][nf] = (f32x4){0.f, 0.f, 0.f, 0.f}; }
#pragma unroll
            for (int ks = 0; ks < 4; ++ks) {
                const int co = 32 * ks;
                const f32x4 g0 = *(const f32x4*)(ng + co), g1 = *(const f32x4*)(ng + co + 4);
                bf16x8 blf[4];
#pragma unroll
                for (int nf = 0; nf < 4; ++nf) blf[nf] = *(const bf16x8*)(wl0 + (size_t)(16 * nf) * D + co);
#pragma unroll
                for (int gi = 0; gi < 3; ++gi) {
                    const int row = grp3[gi] * 16 + r;
                    const bf16_t* xr = X + (size_t)row * D + 128 * w + 8 * q;
                    const float* sh = MODl + (size_t)ci_of_row(grp3[gi] * 16) * 6144 + 3 * D + 128 * w + 8 * q;
                    const u32x4 xwv = *(const u32x4*)(xr + co);
                    const f32x4 xa = (f32x4){bflo(xwv.x), bfhi(xwv.x), bflo(xwv.y), bfhi(xwv.y)}, xb = (f32x4){bflo(xwv.z), bfhi(xwv.z), bflo(xwv.w), bfhi(xwv.w)};
                    const f32x4 s0 = *(const f32x4*)(sh + co), s1 = *(const f32x4*)(sh + co + 4), c0 = *(const f32x4*)(sh + D + co), c1 = *(const f32x4*)(sh + D + co + 4);
                    const f32x4 h0 = xa * rstd[gi] * g0 * (1.f + c0) + s0, h1 = xb * rstd[gi] * g1 * (1.f + c1) + s1;
                    unsigned hb[8]; float hl[8];
#pragma unroll
                    for (int j = 0; j < 4; ++j) { hb[j] = f2bf(h0[j]); hl[j] = h0[j] - __builtin_bit_cast(float, hb[j] << 16); hb[j + 4] = f2bf(h1[j]); hl[j + 4] = h1[j] - __builtin_bit_cast(float, hb[j + 4] << 16); }
                    u32x4 hw; hw.x = hb[0] | (hb[1] << 16); hw.y = hb[2] | (hb[3] << 16); hw.z = hb[4] | (hb[5] << 16); hw.w = hb[6] | (hb[7] << 16);
                    u32x4 lw; lw.x = pk2(hl[0], hl[1]); lw.y = pk2(hl[2], hl[3]); lw.z = pk2(hl[4], hl[5]); lw.w = pk2(hl[6], hl[7]);
                    *(u32x4*)(A2 + (size_t)row * D + 128 * w + co + 8 * q) = hw;
                    const bf16x8 ah = __builtin_bit_cast(bf16x8, hw), al = __builtin_bit_cast(bf16x8, lw);
#pragma unroll
                    for (int nf = 0; nf < 4; ++nf) {
                        acc[gi][nf] = __builtin_amdgcn_mfma_f32_16x16x32_bf16(ah, bh[ks][nf], acc[gi][nf], 0, 0, 0);
                        acc[gi][nf] = __builtin_amdgcn_mfma_f32_16x16x32_bf16(ah, blf[nf], acc[gi][nf], 0, 0, 0);
                        acc[gi][nf] = __builtin_amdgcn_mfma_f32_16x16x32_bf16(al, bh[ks][nf], acc[gi][nf], 0, 0, 0);
                    }
                }
            }
#pragma unroll
            for (int gi = 0; gi < 3; ++gi)
#pragma unroll
                for (int nf = 0; nf < 4; ++nf)
#pragma unroll
                    for (int g = 0; g < 4; ++g) plog[(w * MR + gi * 16 + 4 * q + g) * 64 + 16 * nf + r] = acc[gi][nf][g];
        }
        __syncthreads();
        for (int rr = w; rr < ng3 * 16; rr += 8) {
            float lgt = 0.f;
#pragma unroll
            for (int j = 0; j < 8; ++j) lgt += plog[(j * MR + rr) * 64 + lane];
            const float s = 1.f / (1.f + __expf(-lgt));
            const float b = s + brl;
            const unsigned ub = __float_as_uint(b);
            const unsigned key0 = (((ub & 0x80000000u) ? ~ub : (ub | 0x80000000u)) & ~63u) | (unsigned)(63 - lane);
            const unsigned k1 = grp8_umax(key0);
            const float b1 = grp8_fmax(b);
            const float b2 = grp8_fmax(key0 == k1 ? -INFINITY : b);
            const float gs = b1 + b2; const int g = lane >> 3;
            int grank = 0;
#pragma unroll
            for (int g2 = 0; g2 < 8; ++g2) { const float v = __builtin_bit_cast(float, __builtin_amdgcn_readlane(__builtin_bit_cast(int, gs), g2 * 8)); grank += (v > gs || (v == gs && g2 < g)) ? 1 : 0; }
            unsigned cur = grank < 4 ? key0 : 0u; bool sel = false;
#pragma unroll 1
            for (int it8 = 0; it8 < 8; ++it8) {
                unsigned gm = grp8_umax(cur);
                gm = max(gm, (unsigned)__builtin_amdgcn_update_dpp((int)gm, (int)gm, 0x128  , 0xf, 0xf, true));
                const unsigned mx = max(max((unsigned)__builtin_amdgcn_readlane((int)gm, 0), (unsigned)__builtin_amdgcn_readlane((int)gm, 16)),
                                        max((unsigned)__builtin_amdgcn_readlane((int)gm, 32), (unsigned)__builtin_amdgcn_readlane((int)gm, 48)));
                if (cur == mx) { sel = true; cur = 0u; }
            }
            const float ssum = __ockl_wfred_add_f32(sel ? s : 0.f);
            G[(m0 * 16 + rr) * 64 + lane] = sel ? s / ssum * 2.5f : 0.f;
            mycnt += sel ? 1 : 0;
        }
    }
    cntw[w * 64 + lane] = mycnt;
    __syncthreads();
    if (w == 0) {
        int tot = 0;
#pragma unroll
        for (int j = 0; j < 8; ++j) tot += cntw[j * 64 + lane];
        int base = 0;
        if (tot > 0) base = (int)__hip_atomic_fetch_add(cnt + lane, (unsigned)tot, __ATOMIC_RELAXED, __HIP_MEMORY_SCOPE_AGENT);
#pragma unroll
        for (int j = 0; j < 8; ++j) { const int cj = cntw[j * 64 + lane]; cntw[j * 64 + lane] = base; base += cj; }
    }
    __syncthreads();
    {
        int pos = cntw[w * 64 + lane];
        for (int m0 = 0; m0 < myg; m0 += 3) {
            const int ng3 = min(3, myg - m0);
            for (int rr = w; rr < ng3 * 16; rr += 8) {
                const float gt = G[(m0 * 16 + rr) * 64 + lane];
                const bool sel = gt != 0.f;
                const unsigned long long m = __ballot(sel);
                const int k = __popcll(m & ((1ull << lane) - 1ull));
                if (sel) { const int tok = (g0 + m0 + (rr >> 4)) * 16 + (rr & 15);
                    list[(size_t)lane * ECAP + pos] = tok; gtk[tok * 8 + k] = gt; dest[tok * 8 + k] = (int)((unsigned)lane << 20 | (unsigned)pos); ++pos; }
            }
        }
    }
    __syncthreads();
}

struct MoeTables { LAS int* cnt; LAS int* tp; LAS int* off; };
__device__ __forceinline__ MoeTables moe_tables(const Frame& F, int l) {
    MoeTables mt; mt.cnt = (LAS int*)(F.lds + LDSX_OFF); mt.tp = mt.cnt + 64; mt.off = mt.tp + 80;
    const unsigned* cnt = (const unsigned*)(F.ws + O_CTL) + CW_CNT + l * 64;
    __syncthreads();
    if (F.tid < 64) {
        const int c = (int)__hip_atomic_load(cnt + F.tid, __ATOMIC_RELAXED, __HIP_MEMORY_SCOPE_AGENT);
        mt.cnt[F.tid] = c;
        int t = (c + 255) >> 8, o = c;
#pragma unroll
        for (int d = 1; d < 64; d <<= 1) { const int t2 = __shfl_up(t, d), o2 = __shfl_up(o, d); if (F.tid >= d) { t += t2; o += o2; } }
        mt.tp[F.tid + 1] = t; mt.off[F.tid + 1] = o;
        if (F.tid == 0) { mt.tp[0] = 0; mt.off[0] = 0; }
    }
    __syncthreads();
    return mt;
}
__device__ __forceinline__ int moe_find_expert(const MoeTables& mt, int tile) {
    int lo = 0, hi = 64;
#pragma unroll
    for (int it = 0; it < 6; ++it) { const int mid = (lo + hi) >> 1; if (mt.tp[mid] <= tile) lo = mid; else hi = mid; }
    return __builtin_amdgcn_readfirstlane(lo);
}
struct MoeUpSched {
    MoeTables mt; const char* WGU; const char* WSGU; const int* list; int G, vcu, nshared_pm;
    __device__ __forceinline__ bool next(int i, GUnit& u) const {
        int L = i * G + vcu;
        const int ntr = __builtin_amdgcn_readfirstlane(mt.tp[64]);
        if (L < 2 * ntr) {
            const int tile = L >> 1, pn = L & 1, e = moe_find_expert(mt, tile);
            const int j = tile - __builtin_amdgcn_readfirstlane(mt.tp[e]), c = __builtin_amdgcn_readfirstlane(mt.cnt[e]), o = __builtin_amdgcn_readfirstlane(mt.off[e]);
            u.Bp = WGU + ((size_t)e * 512 + pn * 256) * D * 2; u.rows = list + (size_t)e * ECAP + 256 * j; u.arow0 = 0; u.orow0 = o + 256 * j;
            u.nvalid = min(256, c - 256 * j); u.pn = pn; u.e = e; return true;
        }
        L -= 2 * ntr;
        const int pm = L >> 1, pn = L & 1;
        if (pm >= nshared_pm) return false;
        u.Bp = WSGU + (size_t)pn * 256 * D * 2; u.rows = nullptr; u.arow0 = pm * 256; u.orow0 = pm * 256; u.nvalid = 256; u.pn = pn; u.e = 64; return true;
    }
    __device__ __forceinline__ void done(const GUnit&, int) const {}
};
struct EpiSwigluMoe {
    static constexpr bool PERM = true;
    bf16_t* act; bf16_t* acts;
    __device__ __forceinline__ void operator()(const Acc& acc, const GUnit& u, int wr, int wc, int fr, int fq) const {
        EpiSwiglu E{u.e == 64 ? acts : act}; E(acc, u, wr, wc, fr, fq);
    }
};
constexpr int SH_SLOT0 = NR * 8;
struct MoeDownSched {
    MoeTables mt; const char* WD; const char* WSD; int G, vcu, nshared_pm;
    __device__ __forceinline__ bool next(int i, GUnit& u) const {
        int L = i * G + vcu;
        const int ntr = __builtin_amdgcn_readfirstlane(mt.tp[64]);
        if (L < 4 * ntr) {
            const int tile = L >> 2, pn = L & 3, e = moe_find_expert(mt, tile);
            const int j = tile - __builtin_amdgcn_readfirstlane(mt.tp[e]), c = __builtin_amdgcn_readfirstlane(mt.cnt[e]), o = __builtin_amdgcn_readfirstlane(mt.off[e]);
            u.Bp = WD + ((size_t)e * D + pn * 256) * 256 * 2; u.rows = nullptr; u.arow0 = o + 256 * j; u.orow0 = o + 256 * j;
            u.nvalid = min(256, c - 256 * j); u.pn = pn; u.e = e; return true;
        }
        L -= 4 * ntr;
        const int pm = L >> 2, pn = L & 3;
        if (pm >= nshared_pm) return false;
        u.Bp = WSD + (size_t)pn * 256 * 256 * 2; u.rows = nullptr; u.arow0 = (int)((O_ACTS - O_ACT) / 512) + pm * 256; u.orow0 = SH_SLOT0 + pm * 256; u.nvalid = 256; u.pn = pn; u.e = 64; return true;
    }
    __device__ __forceinline__ void done(const GUnit&, int) const {}
};
constexpr float YSCALE = 16.f, YINV = 1.f / 16.f;
struct EpiFp8 {
    static constexpr bool PERM = true;
    unsigned char* O;
    __device__ __forceinline__ void operator()(const Acc& acc, const GUnit& u, int wr, int wc, int fr, int fq) const {
        const int odd = fq & 1;
        const int col0 = u.pn * BM + wc * 32 + 16 * (fq >> 1);
#pragma unroll
        for (int ai = 0; ai < 2; ++ai)
#pragma unroll
            for (int mp = 0; mp < 2; ++mp) {
                const int r = ai * HALF + wr * 64 + (2 * mp + odd) * 16 + fr;
#pragma unroll
                for (int bj = 0; bj < 2; ++bj) {
                    int w[2][2];
#pragma unroll
                    for (int mm = 0; mm < 2; ++mm) { f32x4 v0 = acc[ai][bj][2 * mp + mm][0] * YSCALE, v1 = acc[ai][bj][2 * mp + mm][1] * YSCALE;
#pragma unroll
                        for (int c = 0; c < 4; ++c) { v0[c] = __builtin_amdgcn_fmed3f(v0[c], -448.f, 448.f); v1[c] = __builtin_amdgcn_fmed3f(v1[c], -448.f, 448.f); }
                        int a = __builtin_amdgcn_cvt_pk_fp8_f32(v0[0], v0[1], 0, false); a = __builtin_amdgcn_cvt_pk_fp8_f32(v0[2], v0[3], a, true);
                        int b = __builtin_amdgcn_cvt_pk_fp8_f32(v1[0], v1[1], 0, false); b = __builtin_amdgcn_cvt_pk_fp8_f32(v1[2], v1[3], b, true);
                        w[mm][0] = a; w[mm][1] = b; }
                    const int s0 = odd ? w[0][0] : w[1][0], s1 = odd ? w[0][1] : w[1][1];
                    const int g0 = __shfl_xor(s0, 16), g1 = __shfl_xor(s1, 16);
                    const int k0 = odd ? w[1][0] : w[0][0], k1 = odd ? w[1][1] : w[0][1];
                    const u32x4 o = odd ? (u32x4){(unsigned)g0, (unsigned)g1, (unsigned)k0, (unsigned)k1} : (u32x4){(unsigned)k0, (unsigned)k1, (unsigned)g0, (unsigned)g1};
                    if (r < u.nvalid) *(u32x4*)(O + (size_t)(u.orow0 + r) * D + col0 + bj * HALF) = o;
                }
            }
    }
};
__device__ __forceinline__ void phase_combine(const Frame& F, int l, int nrows, bf16_t* X, const float* MODl, const unsigned char* Y, float* out_final, const float* gfin,
                                              bf16_t* nxtA, const float* nxt_g, const float* nxt_MOD) {
    const MoeTables mt = moe_tables(F, l);
    const int gw = F.vcu * NWAVES + F.wave, NGW = F.G * NWAVES, lane = F.lane;
    if (nxtA && gw == 0) { GAS u32x4* z = (GAS u32x4*)(nxtA + (size_t)ZROW * D); z[lane] = (u32x4){0u, 0u, 0u, 0u}; z[lane + 64] = (u32x4){0u, 0u, 0u, 0u}; }
    const int* dest = (const int*)(F.ws + O_ROUTE + R_DEST); const float* gtk = (const float*)(F.ws + O_ROUTE + R_GTK);
    int dvn = 0; float gvn = 0.f;
    if (gw < nrows) { dvn = dest[gw * 8 + (lane & 7)]; gvn = gtk[gw * 8 + (lane & 7)]; }
    for (int row = gw; row < nrows; row += NGW) {
        const int dv = dvn; const float gv = gvn;
        if (row + NGW < nrows) { dvn = dest[(row + NGW) * 8 + (lane & 7)]; gvn = gtk[(row + NGW) * 8 + (lane & 7)]; }
        const int sl = mt.off[(dv >> 20) & 63] + (dv & 0xfffff);
        float s[16];
#pragma unroll
        for (int i = 0; i < 16; ++i) s[i] = 0.f;
#pragma unroll
        for (int k = 0; k < 8; ++k) {
            const int slot = __builtin_amdgcn_readlane(sl, k);
            const float gk = __builtin_bit_cast(float, __builtin_amdgcn_readlane(__builtin_bit_cast(int, gv), k));
            const u32x4 a = *(const u32x4*)(Y + (size_t)slot * D + 16 * lane);
            const float gs = gk * YINV;
#pragma unroll
            for (int j = 0; j < 4; ++j) { const f32x2 lo = __builtin_amdgcn_cvt_pk_f32_fp8((int)a[j], false), hi = __builtin_amdgcn_cvt_pk_f32_fp8((int)a[j], true);
                s[4 * j] += gs * lo.x; s[4 * j + 1] += gs * lo.y; s[4 * j + 2] += gs * hi.x; s[4 * j + 3] += gs * hi.y; }
        }
        {
            const u32x4 a = *(const u32x4*)(Y + (size_t)(SH_SLOT0 + row) * D + 16 * lane);
#pragma unroll
            for (int j = 0; j < 4; ++j) { const f32x2 lo = __builtin_amdgcn_cvt_pk_f32_fp8((int)a[j], false), hi = __builtin_amdgcn_cvt_pk_f32_fp8((int)a[j], true);
                s[4 * j] += YINV * lo.x; s[4 * j + 1] += YINV * lo.y; s[4 * j + 2] += YINV * hi.x; s[4 * j + 3] += YINV * hi.y; }
        }
        const float* g5 = MODl + (size_t)ci_of_row(row) * 6144 + 5 * D + 16 * lane;
        bf16_t* xp = X + (size_t)row * D + 16 * lane;
        const u32x4 xw0 = *(const u32x4*)xp, xw1 = *(const u32x4*)(xp + 8);
        const unsigned xwu[8] = {xw0.x, xw0.y, xw0.z, xw0.w, xw1.x, xw1.y, xw1.z, xw1.w};
        f32x4 xv[4]; float ss = 0.f;
#pragma unroll
        for (int j = 0; j < 4; ++j) { const f32x4 g = *(const f32x4*)(g5 + 4 * j);
            const unsigned wa = xwu[2 * j], wb = xwu[2 * j + 1];
            f32x4 x = (f32x4){bflo(wa), bfhi(wa), bflo(wb), bfhi(wb)};
            x[0] += g[0] * s[4 * j]; x[1] += g[1] * s[4 * j + 1]; x[2] += g[2] * s[4 * j + 2]; x[3] += g[3] * s[4 * j + 3]; xv[j] = x;
            ss += (x[0] * x[0] + x[1] * x[1]) + (x[2] * x[2] + x[3] * x[3]); }
        if (out_final) {
            const float rstd = rsqrtf(wave_sum(ss) * (1.f / D) + EPS);
#pragma unroll
            for (int j = 0; j < 4; ++j) { const f32x4 g = *(const f32x4*)(gfin + 16 * lane + 4 * j); *(f32x4*)(out_final + (size_t)row * D + 16 * lane + 4 * j) = xv[j] * rstd * g; }
        } else {
            { u32x4 o0, o1; o0.x = cvt_pk_bf16(xv[0][0], xv[0][1]); o0.y = cvt_pk_bf16(xv[0][2], xv[0][3]); o0.z = cvt_pk_bf16(xv[1][0], xv[1][1]); o0.w = cvt_pk_bf16(xv[1][2], xv[1][3]);
              o1.x = cvt_pk_bf16(xv[2][0], xv[2][1]); o1.y = cvt_pk_bf16(xv[2][2], xv[2][3]); o1.z = cvt_pk_bf16(xv[3][0], xv[3][1]); o1.w = cvt_pk_bf16(xv[3][2], xv[3][3]);
              *(u32x4*)xp = o0; *(u32x4*)(xp + 8) = o1; }
            if (nxtA) {
                const float rstd = rsqrtf(wave_sum(ss) * (1.f / D) + EPS);
                const float* sh = nxt_MOD + (size_t)ci_of_row(row) * 6144 + 16 * lane;
                u32x4 o[2];
#pragma unroll
                for (int j = 0; j < 4; ++j) { const f32x4 g = *(const f32x4*)(nxt_g + 16 * lane + 4 * j), s0 = *(const f32x4*)(sh + 4 * j), c0 = *(const f32x4*)(sh + D + 4 * j);
                    const f32x4 h = xv[j] * rstd * g * (1.f + c0) + s0;
                    o[j >> 1][(j & 1) * 2] = pk2(h[0], h[1]); o[j >> 1][(j & 1) * 2 + 1] = pk2(h[2], h[3]); }
                *(u32x4*)(nxtA + (size_t)row * D + 16 * lane) = o[0]; *(u32x4*)(nxtA + (size_t)row * D + 16 * lane + 8) = o[1];
            }
        }
    }
}
__device__ __forceinline__ void phase_moe_up(const Frame& F, const In& in, int l, int nrows) {
    const MoeTables mt = moe_tables(F, l);
    MoeUpSched S{mt, (const char*)(F.ws + O_WGU), (const char*)(F.ws + O_WSGU) + (size_t)l * 512 * D * 2, (const int*)(F.ws + O_ROUTE + R_LIST), F.G, F.vcu, nrows / 256};
    EpiSwigluMoe E{(bf16_t*)(F.ws + O_ACT), (bf16_t*)(F.ws + O_ACTS)};
    gemm_phase(F.lds, (const char*)(F.ws + O_A2), D, S, E);
    if (l == 0) {
        const int nu = 2 * __builtin_amdgcn_readfirstlane(mt.tp[64]) + 2 * (nrows / 256), rem = nu % F.G;
        __syncthreads();
        phase_cvt_down(F, in, 1, rem, F.G - rem);
    }
}
__device__ __forceinline__ void phase_moe_down(const Frame& F, const In& in, int l, int nrows) {
    const MoeTables mt = moe_tables(F, l);
    MoeDownSched S{mt, (const char*)(F.ws + (l == 0 ? O_WD : O_WD1)), (const char*)(F.ws + O_WSD) + (size_t)l * D * 256 * 2, F.G, F.vcu, nrows / 256};
    EpiFp8 E{F.ws + O_Y};
    gemm_phase(F.lds, (const char*)(F.ws + O_ACT), 256, S, E);
    if (l == 0) {
        const int nu = 4 * __builtin_amdgcn_readfirstlane(mt.tp[64]) + 4 * (nrows / 256), rem = nu % F.G;
        __syncthreads();
        cvt_wgu_part(F, in, 1, 0, CVT32_ITEMS / 3, rem, F.G - rem, 0);
    }
}
__device__ __forceinline__ f32x2 gelu_pk(f32x2 v) {
    const f32x2 av = __builtin_elementwise_abs(v), d = av * 0.2316418882f + 1.0f;
    f32x2 t; t.x = __builtin_amdgcn_rcpf(d.x); t.y = __builtin_amdgcn_rcpf(d.y);
    f32x2 q = t * 0.5307027145f + (-0.7265760135f); q = q * t + 0.7107068705f; q = q * t + (-0.142248368f); q = q * t + 0.127414796f; q = q * t;
    const f32x2 s = (v * v) * (-0.72134752044f);
    f32x2 e; e.x = __builtin_amdgcn_exp2f(s.x); e.y = __builtin_amdgcn_exp2f(s.y);
    const f32x2 m = v * (q * e), r = v - m;
    f32x2 o; o.x = v.x < 0.f ? m.x : r.x; o.y = v.y < 0.f ? m.y : r.y; return o;
}
struct EpiZ {
    static constexpr bool PERM = true;
    bf16_t* O; int ldc, n_gelu, s_lo, s_hi;
    __device__ __forceinline__ void operator()(const Acc& acc, const GUnit& u, int wr, int wc, int fr, int fq) const {
        const int col0 = u.pn * BM + wc * 32 + 8 * fq;
        const int mode = u.pn < n_gelu ? 1 : ((u.pn >= s_lo && u.pn < s_hi) ? 2 : 0);
#pragma unroll
        for (int ai = 0; ai < 2; ++ai)
#pragma unroll
            for (int m = 0; m < 4; ++m) {
                bf16_t* rowp = O + (size_t)(u.orow0 + ai * HALF + wr * 64 + m * 16 + fr) * ldc + col0;
#pragma unroll
                for (int bj = 0; bj < 2; ++bj) { f32x4 v0 = acc[ai][bj][m][0], v1 = acc[ai][bj][m][1];
                    if (mode == 1) { const f32x2 a = gelu_pk((f32x2){v0[0], v0[1]}), b = gelu_pk((f32x2){v0[2], v0[3]}), c = gelu_pk((f32x2){v1[0], v1[1]}), d = gelu_pk((f32x2){v1[2], v1[3]});
                        v0 = (f32x4){a.x, a.y, b.x, b.y}; v1 = (f32x4){c.x, c.y, d.x, d.y}; }
                    else if (mode == 2) { v0 = v0 * C2; v1 = v1 * C2; }
                    u32x4 w; w.x = cvt_pk_bf16(v0[0], v0[1]); w.y = cvt_pk_bf16(v0[2], v0[3]); w.z = cvt_pk_bf16(v1[0], v1[1]); w.w = cvt_pk_bf16(v1[2], v1[3]);
                    *(u32x4*)(rowp + bj * HALF) = w; }
            }
    }
};

__device__ __forceinline__ void phase_sg(const Frame& F, const In& in, const bf16_t* Z1, bf16_t* CAT) {
    constexpr int VTS = 272;
    LAS unsigned char* VT = F.lds;
    const bf16_t* SGW = (const bf16_t*)(F.ws + O_SGW);
    const int lane = F.lane, w = F.wave;
    for (int it = F.vcu; it < NB * 16 * 2; it += F.G) {
        const int half = it & 1, chunk = (it >> 1) & 15, b = it >> 5;
        const size_t row0 = (size_t)b * T + chunk * 128;
        const int p = 16 * w + (lane & 15), kq = lane >> 4;
        bf16x8 wf[4][4]; u32x2 uu[4][4]; float bs[4];
#pragma unroll
        for (int gl = 0; gl < 4; ++gl) { const int g = 4 * half + gl; bs[gl] = in.sg_b[g * 128 + p];
#pragma unroll
            for (int ks = 0; ks < 4; ++ks) wf[gl][ks] = *(const bf16x8*)(SGW + ((size_t)g * 128 + p) * 128 + 32 * ks + 8 * kq);
#pragma unroll
            for (int nf = 0; nf < 4; ++nf) uu[gl][nf] = *(const u32x2*)(Z1 + (row0 + p) * 2560 + g * 64 + nf * 16 + 4 * kq); }
        __syncthreads();
        float lg4[4], lb4[4];
#pragma unroll
        for (int e = 0; e < 4; ++e) { lg4[e] = in.sg_ln_g[lane + 64 * e + 256 * half]; lb4[e] = in.sg_ln_b[lane + 64 * e + 256 * half]; }
#pragma unroll 1
        for (int rb = 0; rb < 16; rb += 4) {
            float raw[4][8];
#pragma unroll
            for (int j = 0; j < 4; ++j) { const bf16_t* vr = Z1 + (row0 + 16 * w + rb + j) * 2560 + 512;
#pragma unroll
                for (int e = 0; e < 8; ++e) raw[j][e] = bf2f(vr[lane + 64 * e]); }
#pragma unroll
            for (int j = 0; j < 4; ++j) {
                const int q = 16 * w + rb + j;
                float v[8]; float s = 0.f;
#pragma unroll
                for (int e = 0; e < 8; e += 2) { const f32x2 gg = gelu_pk((f32x2){raw[j][e], raw[j][e + 1]}); v[e] = gg.x; v[e + 1] = gg.y; s += gg.x + gg.y; }
                const float mu = wave_sum(s) * (1.f / 512.f);
                float s2 = 0.f;
#pragma unroll
                for (int e = 0; e < 8; ++e) { v[e] -= mu; s2 += v[e] * v[e]; }
                const float rstd = rsqrtf(wave_sum(s2) * (1.f / 512.f) + EPS);
                if (half) {
#pragma unroll
                    for (int e = 0; e < 4; ++e) *(LAS bf16_t*)(VT + (lane + 64 * e) * VTS + q * 2) = (bf16_t)f2bf(v[e + 4] * rstd * lg4[e] + lb4[e]);
                } else {
#pragma unroll
                    for (int e = 0; e < 4; ++e) *(LAS bf16_t*)(VT + (lane + 64 * e) * VTS + q * 2) = (bf16_t)f2bf(v[e] * rstd * lg4[e] + lb4[e]);
                }
            }
        }
        __syncthreads();
#pragma unroll
        for (int gl = 0; gl < 4; ++gl) {
            const int g = 4 * half + gl;
            f32x4 acc[4];
#pragma unroll
            for (int nf = 0; nf < 4; ++nf) acc[nf] = (f32x4){0.f, 0.f, 0.f, 0.f};
#pragma unroll
            for (int ks = 0; ks < 4; ++ks)
#pragma unroll
                for (int nf = 0; nf < 4; ++nf) {
                    const bf16x8 vf = *(const LAS bf16x8*)(VT + (gl * 64 + nf * 16 + (lane & 15)) * VTS + (32 * ks + 8 * kq) * 2);
                    acc[nf] = __builtin_amdgcn_mfma_f32_16x16x32_bf16(vf, wf[gl][ks], acc[nf], 0, 0, 0);
                }
#pragma unroll
            for (int nf = 0; nf < 4; ++nf) {
                const int c = g * 64 + nf * 16 + 4 * kq;
                const f32x2 u01 = gelu_pk((f32x2){bflo(uu[gl][nf].x), bfhi(uu[gl][nf].x)}), u23 = gelu_pk((f32x2){bflo(uu[gl][nf].y), bfhi(uu[gl][nf].y)});
                u32x2 o; o.x = pk2(u01.x * (acc[nf][0] + bs[gl]), u01.y * (acc[nf][1] + bs[gl])); o.y = pk2(u23.x * (acc[nf][2] + bs[gl]), u23.y * (acc[nf][3] + bs[gl]));
                *(u32x2*)(CAT + (row0 + p) * D + c) = o;
            }
        }
    }
    __syncthreads();
}

struct NaHook {
    const LAS float* rpbl;
    int nA, rs_lo, r, c, hi; unsigned vmask;
    __device__ __forceinline__ void init() {
        const int cs = min(max(c - 8, 0), 48); unsigned m = 0u;
#pragma unroll
        for (int i = 0; i < 16; ++i) { const int kc = ab::crow(i, hi); if (kc >= cs && kc < cs + 16) m |= 1u << i; if (kc + 32 >= cs && kc + 32 < cs + 16) m |= 1u << (16 + i); }
        vmask = m;
    }
    __device__ __forceinline__ void operator()(ab::f32x16& p0, ab::f32x16& p1, int t) const {
        if (t < nA) return;
        const int R = rs_lo + (t - nA);
        const int rs = min(max(r - 4, 0), 24);
        if (R < rs || R >= rs + 8) {
#pragma unroll
            for (int i = 0; i < 16; ++i) { p0[i] = -INFINITY; p1[i] = -INFINITY; }
            return;
        }
        const LAS float* tb = rpbl + ((R - r + 7) * 31 - c + 15 + 4 * hi);
#pragma unroll
        for (int i0 = 0; i0 < 16; i0 += 8) {
            float b[8];
#pragma unroll
            for (int i = 0; i < 8; ++i) b[i] = tb[((i0 + i) & 3) + 8 * ((i0 + i) >> 2)];
#pragma unroll
            for (int i = 0; i < 8; ++i) p0[i0 + i] = ((vmask >> (i0 + i)) & 1u) ? p0[i0 + i] + b[i] : -INFINITY;
            asm volatile("" ::: "memory");
#pragma unroll
            for (int i = 0; i < 8; ++i) b[i] = tb[32 + ((i0 + i) & 3) + 8 * ((i0 + i) >> 2)];
#pragma unroll
            for (int i = 0; i < 8; ++i) p1[i0 + i] = ((vmask >> (16 + i0 + i)) & 1u) ? p1[i0 + i] + b[i] : -INFINITY;
            asm volatile("" ::: "memory");
        }
    }
};
__device__ __forceinline__ void phase_na(const Frame& F, const In& in, char* shm, const bf16_t* Z1, bf16_t* CAT) {
    LAS float* rpbl = (LAS float*)(F.lds + LDSX_OFF + 4096);
    constexpr int CV0 = (2 * CVT32_ITEMS) / 3;
    if ((F.vcu & 1) == 0) cvt_wgu_part(F, in, 1, CV0, CVT32_ITEMS, 0, F.G, ATTN_CVT_SCR);
    for (int u = F.vcu; u < 512; u += F.G) {
        const int rg = u & 7, h = (u >> 3) & 7, b = u >> 6, r0 = 4 * rg;
        const int rs_lo = min(max(r0 - 4, 0), 24);
        const int nnb = (rg == 0 || rg == 7) ? 8 : 12;
        __syncthreads();
        for (int i = F.tid; i < 15 * 31; i += NTHREADS) rpbl[i] = in.na_rpb[h * 465 + i] * 1.4426950408889634f;
        __syncthreads();
        const size_t row0 = (size_t)b * T + r0 * 64;
        ab::TileMap tm{4, NLAT + b * NC, b * T + rs_lo * 64};
        NaHook hook{rpbl, 4, rs_lo, r0 + (F.wave >> 1), (F.wave & 1) * 32 + (F.lane & 31), F.lane >> 5, 0u}; hook.init();
        ab::attn_unit<8, NaHook>(Z1 + row0 * 2560 + 1024 + h * 64, 2560, Z1 + 1536 + h * 64, Z1 + 2048 + h * 64, 2560, tm, 4 + nnb,
                                 CAT + row0 * D + 512 + h * 64, D, shm, hook);
    }
    if (F.vcu & 1) { __syncthreads(); cvt_wgu_part(F, in, 1, CV0, CVT32_ITEMS, 0, F.G, ATTN_CVT_SCR); }
}

__device__ __forceinline__ void phase_adaln(const Frame& F, const In& in, float* MOD) {
    LAS float* sc = (LAS float*)F.lds;
    LAS float* red = sc + 9 * 1024;
    for (int i = F.tid; i < 9 * 1024; i += NTHREADS) { const float x = i < 8 * 1024 ? in.c[i] : in.c_ctx[i - 8 * 1024]; sc[i] = x / (1.f + __expf(-x)); }
    __syncthreads();
    const int ks = F.tid >> 6, cl = F.tid & 63;
    for (int it = F.vcu; it < 2 * 96; it += F.G) {
        const int l = it / 96, c0 = (it % 96) * 64;
        const float* w = in.w_ada + (size_t)l * D * 6144 + c0 + cl;
        float acc[9];
#pragma unroll
        for (int j = 0; j < 9; ++j) acc[j] = 0.f;
#pragma unroll 8
        for (int k = ks * 128; k < ks * 128 + 128; ++k) { const float wv = w[(size_t)k * 6144];
#pragma unroll
            for (int j = 0; j < 9; ++j) acc[j] += sc[j * 1024 + k] * wv; }
        __syncthreads();
#pragma unroll
        for (int j = 0; j < 9; ++j) red[(ks * 9 + j) * 64 + cl] = acc[j];
        __syncthreads();
        for (int o = F.tid; o < 9 * 64; o += NTHREADS) { const int j = o >> 6, cc = o & 63; float s = in.b_ada[l * 6144 + c0 + cc];
#pragma unroll
            for (int q = 0; q < 8; ++q) s += red[(q * 9 + j) * 64 + cc];
            MOD[((size_t)l * 9 + j) * 6144 + c0 + cc] = s; }
    }
    __syncthreads();
}
enum Phase { PH_INIT = 0, PH_NORM0, PH_IN0, PH_PREP0, PH_ATTN0, PH_OUT0, PH_ROUTE0, PH_UP0, PH_DOWN0, PH_COMB0,
             PH_IN1, PH_MIX1, PH_OUT1, PH_ROUTE1, PH_UP1, PH_DOWN1, PH_COMB1, PH_COUNT };

__global__ void __launch_bounds__(NTHREADS, 2) mk_fwd(Args args) {
    extern __shared__ __attribute__((aligned(16))) unsigned char lds_raw[];
    Frame F;
    F.lds = (LAS unsigned char*)lds_raw; F.ws = args.ws;
    F.tid = threadIdx.x; F.lane = F.tid & 63; F.wave = __builtin_amdgcn_readfirstlane(F.tid >> 6);
    F.G = gridDim.x; { const int bx = blockIdx.x; F.vcu = (F.G % 8 == 0) ? (bx % 8) * (F.G / 8) + bx / 8 : bx; }
    volatile LAS unsigned* MISC = (volatile LAS unsigned*)(F.lds + MISC_OFF);
    for (int u = F.tid; u < (LDS_BYTES - MISC_OFF) / 4; u += NTHREADS) ((LAS unsigned*)(F.lds + MISC_OFF))[u] = 0u;
    __syncthreads();
    gu32* ctl = (gu32*)(args.ws + O_CTL);
    const bool multi = (args.ph_hi - args.ph_lo) > 1;
    XcdBarrier bar; bar.bar = (unsigned*)(ctl + CW_BAR) + args.li * XCD_BAR_WORDS; bar.x = 0; bar.st = nullptr;
    if (multi) bar = xcd_barrier_post((unsigned*)(ctl + CW_BAR) + args.li * XCD_BAR_WORDS, MISC + 8);
    typedef const __attribute__((address_space(4))) Args* ArgK;
    ArgK argp = (ArgK)__builtin_amdgcn_kernarg_segment_ptr();
    const int lo = args.ph_lo, hi = args.ph_hi;
    const bool dummy = args.pad != 0;
#define IN(k) (lo <= (k) && (k) < hi)
#define SEAM(k) do { if (IN((k) + 1)) xcd_barrier(bar); } while (0)

#if defined(__HIP_DEVICE_COMPILE__)
#define LOADARGS_() const Args al = *argp
#else
#define LOADARGS_() const Args al = args
#endif
#define LOADIN() LOADARGS_(); const In& inl = al.in; F.ws = al.ws; \
    float* const MOD = (float*)(al.ws + O_MOD); bf16_t* const X = (bf16_t*)(al.ws + O_X); \
    bf16_t* const A = (bf16_t*)(al.ws + O_A); bf16_t* const Z = (bf16_t*)(al.ws + O_Z); bf16_t* const CAT = (bf16_t*)(al.ws + O_CAT); \
    const float* const ZEROG = (const float*)(al.ws + O_CTL + 512 * 1024); (void)MOD; (void)X; (void)A; (void)Z; (void)CAT; (void)ZEROG
    if (IN(PH_INIT)) { LOADIN(); phase_adaln(F, inl, MOD); phase_cvt_mixer(F, inl); SEAM(PH_INIT); }
#define RELAUNDER() do { int t_ = threadIdx.x; asm volatile("" : "+v"(t_)); F.tid = t_; F.lane = t_ & 63; F.wave = __builtin_amdgcn_readfirstlane(t_ >> 6); int v_ = F.vcu; asm volatile("" : "+s"(v_)); F.vcu = v_; argp = (ArgK)__builtin_amdgcn_kernarg_segment_ptr(); asm volatile("" : "+s"(argp)); } while (0)
#define PH_IN(l, p1) \
    if (IN(p1)) { RELAUNDER(); LOADIN(); \
        DenseSched S{(const char*)(al.ws + (l == 0 ? O_WINAB : O_WINCD)), D, NR / 256, l == 0 ? 7 : 10, F.G, F.vcu, l == 0 ? NR / 256 : NLAT / 256, l == 0 ? 0 : 6}; \
        EpiZ E{Z, l == 0 ? 1792 : 2560, 0, 4, l == 0 ? 0 : 6}; \
        gemm_phase(F.lds, (const char*)A, D, S, E); \
        if (l == 1) { const int nu_ = 64 * 10 + 8 * 4, rem_ = nu_ % F.G; __syncthreads(); cvt_wgu_part(F, inl, 1, CVT32_ITEMS / 3, (2 * CVT32_ITEMS) / 3, rem_, F.G - rem_, 0); }     \
        SEAM(p1); }
#define PH_OUT_MOE(l, pb, nrows) \
    if (IN(pb)) { RELAUNDER(); LOADIN(); \
        const int gg_ = (l == 0 && F.G == 256) ? 144 : F.G;     \
        DenseSched S{(const char*)(al.ws + (l == 0 ? O_WOUTAB : O_WOUTCD)), D, (nrows) / 256, D / 256, gg_, F.vcu, (nrows) / 256, 0}; \
        EpiResid E{inl.x, inl.ctx, l == 0 ? nullptr : X, X, ((dummy && l == 1) ? ZEROG : MOD + (size_t)l * 9 * 6144) + 2 * D}; \
        gemm_phase(F.lds, (const char*)CAT, D, S, E); \
        if (l == 0) { __syncthreads(); const int c0_ = F.G == 256 ? 144 : 0; phase_cvt_down(F, inl, 0, c0_, F.G - c0_); __syncthreads(); cvt_wgu_part(F, inl, 0, 0, CVT32_ITEMS, c0_, F.G - c0_, 0); }     \
        SEAM(pb); } \
    if (IN(pb + 1)) { RELAUNDER(); LOADIN(); \
        const int ng_ = (nrows) / 16; const int g0 = (int)(((long)F.vcu * ng_) / F.G), g1 = (int)(((long)(F.vcu + 1) * ng_) / F.G); \
        phase_route(F, inl, l, g0, g1, X, MOD + (size_t)l * 9 * 6144, (bf16_t*)(al.ws + O_A2), dummy);     \
        SEAM(pb + 1); } \
    if (IN(pb + 2)) { RELAUNDER(); LOADIN(); phase_moe_up(F, inl, l, nrows); SEAM(pb + 2); } \
    if (IN(pb + 3)) { RELAUNDER(); LOADIN(); phase_moe_down(F, inl, l, nrows); SEAM(pb + 3); } \
    if (IN(pb + 4)) { RELAUNDER(); LOADIN(); phase_combine(F, l, nrows, X, dummy ? ZEROG : MOD + (size_t)l * 9 * 6144, (const unsigned char*)(al.ws + O_Y), l == 1 ? al.out : nullptr, inl.g_final, l == 0 ? A : nullptr, inl.norm_g + 2 * D, MOD + (size_t)9 * 6144); \
        SEAM(pb + 4); }

    if (IN(PH_NORM0)) { RELAUNDER(); LOADIN(); phase_normmod(F, inl.x, inl.ctx, inl.norm_g, MOD, 0, A, NR); SEAM(PH_NORM0); }
    PH_IN(0, PH_IN0)
    if (IN(PH_PREP0)) { RELAUNDER(); LOADIN();
        phase_conv0(F, inl, Z, CAT);
        if (!dummy) phase_qkv0(F, inl, Z, (bf16_t*)(al.ws + O_Q), (bf16_t*)(al.ws + O_K), (bf16_t*)(al.ws + O_V));
        SEAM(PH_PREP0); }
    if (IN(PH_ATTN0)) { RELAUNDER(); LOADIN();
        phase_attn0(F, inl, (char*)lds_raw, (const bf16_t*)(al.ws + O_Q), (const bf16_t*)(al.ws + O_K), (const bf16_t*)(al.ws + O_V), CAT);
        SEAM(PH_ATTN0); }
    PH_OUT_MOE(0, PH_OUT0, NR)
    PH_IN(1, PH_IN1)
    if (IN(PH_MIX1)) { RELAUNDER(); LOADIN(); phase_sg(F, inl, Z, CAT); phase_na(F, inl, (char*)lds_raw, Z, CAT); SEAM(PH_MIX1); }
    PH_OUT_MOE(1, PH_OUT1, NLAT)
#undef IN
#undef SEAM
}

static int g_grid = 0;
inline bool mk_init() {
    if (g_grid != 0) return g_grid > 0;
    int dev = 0, cus = 0, per_cu = 0;
    if (hipGetDevice(&dev) != hipSuccess || hipDeviceGetAttribute(&cus, hipDeviceAttributeMultiprocessorCount, dev) != hipSuccess) { g_grid = -1; return false; }
    if (hipFuncSetAttribute((const void*)mk_fwd, hipFuncAttributeMaxDynamicSharedMemorySize, LDS_BYTES) != hipSuccess) { fprintf(stderr, "hipFuncSetAttribute failed\n"); g_grid = -1; return false; }
    if (hipOccupancyMaxActiveBlocksPerMultiprocessor(&per_cu, (const void*)mk_fwd, NTHREADS, LDS_BYTES) != hipSuccess || per_cu < 1) { fprintf(stderr, "occupancy query: %d\n", per_cu); (void)hipGetLastError(); per_cu = 1; }
    if (cus != 256) { fprintf(stderr, "kernel_launch: built for a 256-CU MI355X (one workgroup per CU); this device reports %d CUs; nothing launched\n", cus); g_grid = -1; return false; }
    g_grid = cus;
    return true;
}
inline void mk_launch(hipStream_t st, const In& in, float* out, unsigned char* ws, int lo, int hi, int li, int dummy = 0) {
    Args a{}; a.in = in; a.out = out; a.ws = ws; a.ph_lo = lo; a.ph_hi = hi; a.li = li; a.pad = dummy;
    hipLaunchKernelGGL(mk_fwd, dim3(g_grid), dim3(NTHREADS), LDS_BYTES, st, a);
}
}
extern "C" void kernel_launch(void* const* d_in, const int* in_sizes, int n_in, void* d_out, int out_size, void* d_ws, size_t ws_size, hipStream_t stream) {
    if (n_in != 31 || ws_size < mk::O_END) { fprintf(stderr, "kernel_launch: unexpected n_in %d / ws %zu\n", n_in, ws_size); return; }
    if (!mk::mk_init()) return;
    mk::In min; const float** q = (const float**)&min;
    for (int i = 0; i < 31; ++i) q[i] = (const float*)d_in[i];
    unsigned char* ws = (unsigned char*)d_ws;
    (void)hipMemsetAsync(ws + mk::O_CTL, 0, 1 << 20, stream);
    mk::mk_launch(stream, min, (float*)d_out, ws, 0, mk::PH_COUNT, 0);
}
```

```cpp
#include <hip/hip_runtime.h>
#include <hip/hip_bf16.h>
#include <cstdio>
#include <cstdint>
#include <cmath>
extern "C" __device__ float __ockl_wfred_max_f32(float);
extern "C" __device__ float __ockl_wfred_add_f32(float);
namespace mk {
#define LAS __attribute__((address_space(3)))
#define GAS __attribute__((address_space(1)))
typedef unsigned short bf16_t;
typedef short bf16x8 __attribute__((ext_vector_type(8)));
typedef float f32x4 __attribute__((ext_vector_type(4)));
typedef float f32x2 __attribute__((ext_vector_type(2)));
typedef unsigned u32x4 __attribute__((ext_vector_type(4)));
typedef unsigned u32x2 __attribute__((ext_vector_type(2)));
typedef GAS unsigned gu32;
#define RLX_AGENT __ATOMIC_RELAXED, __HIP_MEMORY_SCOPE_AGENT
#define LDS_WAIT() asm volatile("s_waitcnt lgkmcnt(0)" ::: "memory")
#define VM_WAIT() asm volatile("s_waitcnt vmcnt(0)" ::: "memory")

constexpr int D = 1024, NB = 8, T = 2048, NC = 256, NLAT = NB * T, NCTX = NB * NC, NR = NLAT + NCTX, KEYS = T + NC;
constexpr int ZROW = NR;
constexpr float EPS = 1e-6f;
constexpr int NWAVES = 8, NTHREADS = 512;
constexpr int ECAP = NR;
constexpr float C2 = 0.125f * 1.4426950408889634f;

constexpr size_t MiB = 1ull << 20;
constexpr size_t O_X = 0;
constexpr size_t O_ROUTE = 72 * MiB;
constexpr size_t O_WD = 82 * MiB;
constexpr size_t O_ACT = 114 * MiB;
constexpr size_t O_ACTS = 187 * MiB;
constexpr size_t O_Y = 196 * MiB;
constexpr size_t O_A = 120 * MiB;
constexpr size_t O_Z = 157 * MiB;
constexpr size_t O_CAT = 247 * MiB;
constexpr size_t O_Q = 283 * MiB;
constexpr size_t O_K = 301 * MiB;
constexpr size_t O_V = 319 * MiB;
constexpr size_t O_A2 = 340 * MiB;
constexpr size_t O_WD1 = 464 * MiB;
constexpr size_t O_WGU = 400 * MiB;
constexpr size_t O_MOD = 500 * MiB;
constexpr size_t O_CTL = 509 * MiB;
constexpr size_t O_WINAB = 510 * MiB;
constexpr size_t O_WOUTAB = 514 * MiB;
constexpr size_t O_WINCD = 516 * MiB;
constexpr size_t O_WOUTCD = 521 * MiB;
constexpr size_t O_WR = 523 * MiB;
constexpr size_t O_WSGU = 524 * MiB;
constexpr size_t O_WSD = 526 * MiB;
constexpr size_t O_SGW = 527 * MiB;
constexpr size_t O_END = 528 * MiB;
constexpr size_t R_DEST = 0;
constexpr size_t R_LIST = 1 * MiB;
constexpr size_t R_GTK = 5 * MiB + MiB / 2;
static_assert(R_LIST + (size_t)64 * ECAP * 4 <= R_GTK && R_GTK + (size_t)NR * 8 * 4 <= 10 * MiB, "route map");
constexpr int CW_TMO = 0;
constexpr int CW_CNT = 64;
constexpr int CW_BAR = 4096;

constexpr int RING_BYTES = 131072;
constexpr int LDSX_OFF = RING_BYTES;
constexpr int MISC_OFF = RING_BYTES + 12288;
constexpr int LDS_BYTES = 147456;

__device__ __forceinline__ unsigned f2bf(float f) { unsigned u = __builtin_bit_cast(unsigned, f); return (u + 0x7fffu + ((u >> 16) & 1u)) >> 16; }
__device__ __forceinline__ unsigned pk2(float lo, float hi) { return f2bf(lo) | (f2bf(hi) << 16); }
__device__ __forceinline__ float bf2f(unsigned short b) { return __builtin_bit_cast(float, (unsigned)b << 16); }
__device__ __forceinline__ float bflo(unsigned w) { return __builtin_bit_cast(float, w << 16); }
__device__ __forceinline__ float bfhi(unsigned w) { return __builtin_bit_cast(float, w & 0xffff0000u); }
__device__ __forceinline__ float wave_sum(float v) { return __ockl_wfred_add_f32(v); }
__device__ __forceinline__ float fast_sigmoid(float x) { return __builtin_amdgcn_rcpf(1.f + __builtin_amdgcn_exp2f(-1.4426950408889634f * x)); }
__device__ __forceinline__ float fast_silu(float x) { return x * fast_sigmoid(x); }
__device__ __forceinline__ int ci_of_row(int row) { return row < NLAT ? row / T : 8; }

#define XB_TMO      128
#define XB_XCNT(j)  (256  + 64 * (j))
#define XB_XSUB(j)  (1280 + 64 * (j))
#define XB_XGEN(j)  (2304 + 64 * (j))
#define XB_TOP      3328
#define XB_TOPGEN   3392
#define XCD_BAR_WORDS 3456
#define XB_SPIN_CAP (1u << 18)
__device__ __forceinline__ unsigned xb_ld(unsigned* p)              { return __hip_atomic_load(p, __ATOMIC_RELAXED, __HIP_MEMORY_SCOPE_AGENT); }
__device__ __forceinline__ unsigned xb_add(unsigned* p, unsigned v) { return __hip_atomic_fetch_add(p, v, __ATOMIC_RELAXED, __HIP_MEMORY_SCOPE_AGENT); }
__device__ __forceinline__ unsigned xb_xcc_id() { return (unsigned)__builtin_amdgcn_s_getreg((3 << 11) | 20) & 0xFu; }
#define XB_SPIN(cond, bar) do { unsigned _sp = 0; while (cond) { __builtin_amdgcn_s_sleep(1); \
    if ((++_sp & 255u) == 0u) { if (xb_ld(&(bar)[XB_TMO])) break; if (_sp > XB_SPIN_CAP) { atomicAdd(&(bar)[XB_TMO], 1u); break; } } } } while (0)
struct XcdBarrier { unsigned* bar; unsigned x; volatile LAS unsigned* st; };
__device__ __forceinline__ XcdBarrier xcd_barrier_post(unsigned* bar, volatile LAS unsigned* st) {
    XcdBarrier b; b.bar = bar; b.x = xb_xcc_id(); b.st = st;
    if (threadIdx.x == 0) (void)xb_add(&bar[XB_XCNT(b.x)], 1u);
    return b;
}
__device__ __forceinline__ void xcd_barrier_complete(unsigned* bar, unsigned x, unsigned& nloc, unsigned& nx) {
    const unsigned G = gridDim.x * gridDim.y * gridDim.z;
    unsigned sum, cnt, mine, sp = 0u;
    for (;;) {
        sum = 0u; cnt = 0u; mine = 0u;
#pragma unroll
        for (unsigned j = 0; j < 16; ++j) { const unsigned c = xb_ld(&bar[XB_XCNT(j)]); sum += c; cnt += (c > 0u) ? 1u : 0u; mine = (j == x) ? c : mine; }
        if (sum == G) break;
        __builtin_amdgcn_s_sleep(1);
        if ((++sp & 255u) == 0u) { if (xb_ld(&bar[XB_TMO])) break; if (sp > XB_SPIN_CAP) { atomicAdd(&bar[XB_TMO], 1u); break; } }
    }
    nloc = mine > 0u ? mine : 1u; nx = cnt > 0u ? cnt : 1u;
}
__device__ __forceinline__ void xcd_barrier(const XcdBarrier& b) {
    asm volatile("s_waitcnt vmcnt(0)" ::: "memory");
    __syncthreads();
    if (threadIdx.x == 0) {
        unsigned* bar = b.bar;
        __builtin_amdgcn_s_waitcnt(0);
        unsigned nloc = b.st[0], nx = b.st[1];
        if (nloc == 0u) { xcd_barrier_complete(bar, b.x, nloc, nx); b.st[0] = nloc; b.st[1] = nx; }
        const unsigned old = xb_add(&bar[XB_XSUB(b.x)], 1u);
        const unsigned gen = old / nloc;
        if (old + 1u == (gen + 1u) * nloc) {
            __builtin_amdgcn_fence(__ATOMIC_RELEASE, "agent");
            asm volatile("s_waitcnt vmcnt(0)" ::: "memory");
            const unsigned og = xb_add(&bar[XB_TOP], 1u);
            const unsigned tg = og / nx;
            if (og + 1u == (tg + 1u) * nx) xb_add(&bar[XB_TOPGEN], 1u);
            else XB_SPIN(xb_ld(&bar[XB_TOPGEN]) == tg, bar);
            __builtin_amdgcn_fence(__ATOMIC_ACQUIRE, "agent");
            xb_add(&bar[XB_XGEN(b.x)], 1u);
            asm volatile("s_waitcnt vmcnt(0)" ::: "memory");
        } else {
            XB_SPIN(xb_ld(&bar[XB_XGEN(b.x)]) == gen, bar);
            __builtin_amdgcn_fence(__ATOMIC_ACQUIRE, "agent");
            asm volatile("s_waitcnt vmcnt(0)" ::: "memory");
        }
    }
    __syncthreads();
}

struct In {
    const float *x, *c, *ctx, *c_ctx, *norm_g, *w_ada, *b_ada, *w_in_ab, *w_out_ab, *conv_w, *conv_b, *conv_ln_g, *conv_ln_b, *qn_g, *kn_g,
        *w_in_cd, *w_out_cd, *sg_ln_g, *sg_ln_b, *sg_w, *sg_b, *na_rpb, *w_router, *b_router, *w_gate, *w_up, *w_down, *ws_gate, *ws_up, *ws_down, *g_final;
};
struct Args { In in; float* out; unsigned char* ws; int ph_lo, ph_hi, li, pad; };
struct Frame {
    LAS unsigned char* lds;
    unsigned char* ws;
    int tid, lane, wave, vcu, G;
};

typedef int i32x8 __attribute__((ext_vector_type(8)));
typedef int i32x4 __attribute__((ext_vector_type(4)));
__device__ __forceinline__ i32x8 cat8(bf16x8 a, bf16x8 b) { return __builtin_shufflevector(__builtin_bit_cast(i32x4, a), __builtin_bit_cast(i32x4, b), 0, 1, 2, 3, 4, 5, 6, 7); }
constexpr int BM = 256, BK = 64, HALF = 128, HTB = HALF * BK * 2, STAGE_BYTES = 8 * HTB;
__device__ __forceinline__ int lds_byte(int r, int c) { const int st = (r >> 4) * 2 + (c >> 5), rr = r & 15, cc = c & 31, ob = rr * 64 + cc * 2; return st * 1024 + (ob ^ (((ob >> 9) & 1) << 5)); }
__device__ __forceinline__ void stage_rc(int b, int& R, int& C) { const int st = b / 1024, sb = b % 1024, swz = sb ^ (((sb >> 9) & 1) << 5); R = (st >> 1) * 16 + swz / 64; C = (st & 1) * 32 + (swz % 64) / 2; }
__device__ __forceinline__ int perm32(int rho) { const int n = rho >> 4, i = rho & 15; return 8 * (i >> 2) + 4 * n + (i & 3); }
__device__ __forceinline__ unsigned cvt_pk_bf16(float lo, float hi) { unsigned r; asm volatile("v_cvt_pk_bf16_f32 %0, %1, %2" : "=v"(r) : "v"(lo), "v"(hi)); return r; }

struct GUnit {
    const char* Bp;
    const int* rows;
    int arow0;
    int orow0;
    int nvalid;
    int pn;
    int e;
};
typedef f32x4 Acc[2][2][4][2];

template <class Epi, class Sched, int ES = 2, int SCB = 127>
__device__ __forceinline__ void gemm_phase(LAS unsigned char* lds, const char* Abase, const int K, const Sched& S, const Epi& E) {
    int tid = threadIdx.x; asm volatile("" : "+v"(tid));
    const int wid = __builtin_amdgcn_readfirstlane(tid >> 6), lane = tid & 63, wr = wid >> 2, wc = wid & 3, fr = lane & 15, fq = lane >> 4;
    const int nt = K * ES / (BK * 2);
    int R0, C0; stage_rc(tid * 16, R0, C0);
    unsigned voffB[2];
#pragma unroll
    for (int i = 0; i < 2; ++i) { const int R = R0 + 64 * i; const int Rb = Epi::PERM ? ((R & ~31) + perm32(R & 31)) : R; voffB[i] = (unsigned)(Rb * K * ES + C0 * 2); }
    const size_t kstep = (size_t)(BK * 2);
    const size_t hstep = (size_t)HALF * K * ES;
    const unsigned ldsw = (unsigned)wid * 1024u;
    const unsigned ldsbase = (unsigned)(size_t)lds + ldsw;
    const int aoff = lds_byte(wr * 64 + fr, fq * 8), boff = lds_byte(wc * 32 + fr, fq * 8);
#define PG8_SA(b, h) (((b) * 2 + (h)) * HTB)
#define PG8_SB(b, h) ((4 + (b) * 2 + (h)) * HTB)
#define PG8_STAGE2(bufoff, gbase, v0, v1) do { if constexpr (ES == 2) { \
        __builtin_amdgcn_global_load_lds((const unsigned*)((const char*)(gbase) + (v0)), (LAS unsigned*)(lds + (bufoff) + ldsw), 16, 0, 0); \
        __builtin_amdgcn_global_load_lds((const unsigned*)((const char*)(gbase) + (v1)), (LAS unsigned*)(lds + (bufoff) + ldsw + 8192), 16, 0, 0); } else { \
          \
        const unsigned m0a_ = ldsbase + (unsigned)(bufoff); const char* gb_ = (const char*)(gbase); \
        asm volatile("s_mov_b32 m0, %0\n\ts_nop 0\n\tglobal_load_lds_dwordx4 %2, %4\n\ts_mov_b32 m0, %1\n\ts_nop 0\n\tglobal_load_lds_dwordx4 %3, %4" \
                     :: "s"(m0a_), "s"(m0a_ + 8192u), "v"(v0), "v"(v1), "s"(gb_) : "memory"); } } while (0)
#define PG8_STAGEB(bufoff, gbase) PG8_STAGE2(bufoff, gbase, voffB[0], voffB[1])
#define PG8_LDA(dst, b, h) do { _Pragma("unroll") for (int m = 0; m < 4; ++m) _Pragma("unroll") for (int k = 0; k < 2; ++k) dst[m][k] = *(const LAS bf16x8*)(lds + PG8_SA(b, h) + aoff + m * 2048 + k * 1024); } while (0)
#define PG8_LDB(dst, b, h) do { _Pragma("unroll") for (int n = 0; n < 2; ++n) _Pragma("unroll") for (int k = 0; k < 2; ++k) dst[n][k] = *(const LAS bf16x8*)(lds + PG8_SB(b, h) + boff + n * 2048 + k * 1024); } while (0)
#define PG8_MMA(ai, bj, At, Bt) do { __builtin_amdgcn_s_setprio(1); _Pragma("unroll") for (int m = 0; m < 4; ++m) _Pragma("unroll") for (int n = 0; n < 2; ++n) { \
        if constexpr (ES == 2) { _Pragma("unroll") for (int k = 0; k < 2; ++k) acc[ai][bj][m][n] = __builtin_amdgcn_mfma_f32_16x16x32_bf16(Bt[n][k], At[m][k], acc[ai][bj][m][n], 0, 0, 0); } \
        else {   \
            asm volatile("v_mfma_scale_f32_16x16x128_f8f6f4 %0, %1, %2, %0, %3, %3 op_sel_hi:[0,0,0]" : "+v"(acc[ai][bj][m][n]) : "v"(cat8(Bt[n][0], Bt[n][1])), "v"(cat8(At[m][0], At[m][1])), "v"(SCB * 0x01010101)); } } \
        __builtin_amdgcn_s_setprio(0); } while (0)
#define PG8_WAIT_V(n) asm volatile("s_waitcnt vmcnt(" #n ")" ::: "memory")
#define PG8_WAIT_L(n) asm volatile("s_waitcnt lgkmcnt(" #n ")" ::: "memory")
#define PG8_BAR __builtin_amdgcn_s_barrier()
#define PG8_SCHED __builtin_amdgcn_sched_barrier(0)
#define PG8_VOFF(u, vo) do { int R0l_ = R0; asm volatile("" : "+v"(R0l_));   \
        _Pragma("unroll") for (int h_ = 0; h_ < 2; ++h_) _Pragma("unroll") for (int i_ = 0; i_ < 2; ++i_) { const int r_ = h_ * 128 + R0l_ + 64 * i_; \
        int row_; if ((u).rows) { row_ = ZROW; if (r_ < (u).nvalid) row_ = (u).rows[r_]; } else row_ = (u).arow0 + r_; vo[h_][i_] = (unsigned)(row_ * K * ES + C0 * 2); } } while (0)
    GUnit cur, nxt; int ui = 0;
    if (!S.next(0, cur)) return;
    Acc acc;
#pragma unroll
    for (int a = 0; a < 2; ++a)
#pragma unroll
        for (int b = 0; b < 2; ++b)
#pragma unroll
            for (int m = 0; m < 4; ++m)
#pragma unroll
                for (int n = 0; n < 2; ++n) acc[a][b][m][n] = (f32x4){0.f, 0.f, 0.f, 0.f};
    bf16x8 At[4][2], B0[2][2], B1[2][2];
    unsigned vA[2][2], vN[2][2];
    PG8_VOFF(cur, vA);
    const char* cB = cur.Bp;
    const char* const cA = Abase;
    PG8_STAGEB(PG8_SB(0, 0), cB); PG8_STAGEB(PG8_SB(0, 1), cB + hstep); PG8_STAGE2(PG8_SA(0, 0), cA, vA[0][0], vA[0][1]); PG8_STAGE2(PG8_SA(0, 1), cA, vA[1][0], vA[1][1]);
    if (wr == 1) PG8_BAR;
    PG8_WAIT_V(2); PG8_BAR;
    PG8_STAGEB(PG8_SB(1, 0), cB + kstep); PG8_STAGE2(PG8_SA(1, 0), cA + kstep, vA[0][0], vA[0][1]); PG8_STAGEB(PG8_SB(1, 1), cB + hstep + kstep);
    PG8_WAIT_V(6); PG8_BAR;
    for (;;) {
        const bool has_next = S.next(ui + 1, nxt);
        if (has_next) { PG8_VOFF(nxt, vN); }
        else {
#pragma unroll
            for (int h = 0; h < 2; ++h)
#pragma unroll
                for (int i = 0; i < 2; ++i) vN[h][i] = vA[h][i];
        }
        const char* nB = has_next ? nxt.Bp : cB;
#pragma nounroll
        for (int t = 0; t < nt; t += 2) {
            const bool last = (t == nt - 2);
            const char* a1 = cA + (size_t)(t + 1) * kstep;
            const char* a2 = last ? cA : cA + (size_t)(t + 2) * kstep; const char* b2 = last ? nB : cB + (size_t)(t + 2) * kstep;
            const char* a3 = a2 + kstep; const char* b3 = b2 + kstep;
            const unsigned w00 = last ? vN[0][0] : vA[0][0], w01 = last ? vN[0][1] : vA[0][1], w10 = last ? vN[1][0] : vA[1][0], w11 = last ? vN[1][1] : vA[1][1];
            PG8_LDB(B0, 0, 0); PG8_LDB(B1, 0, 1); PG8_SCHED; PG8_LDA(At, 0, 0); PG8_STAGE2(PG8_SA(1, 1), a1, vA[1][0], vA[1][1]);
            PG8_WAIT_V(8); PG8_WAIT_L(0); PG8_BAR; PG8_MMA(0, 0, At, B0); PG8_MMA(0, 1, At, B1); PG8_BAR; PG8_SCHED;
            PG8_LDA(At, 0, 1); PG8_STAGEB(PG8_SB(0, 0), b2); PG8_STAGEB(PG8_SB(0, 1), b2 + hstep); PG8_STAGE2(PG8_SA(0, 0), a2, w00, w01);
            PG8_WAIT_V(8); PG8_WAIT_L(0); PG8_BAR; PG8_MMA(1, 0, At, B0); PG8_MMA(1, 1, At, B1); PG8_BAR; PG8_SCHED;
            PG8_LDB(B0, 1, 0); PG8_LDB(B1, 1, 1); PG8_SCHED; PG8_LDA(At, 1, 0); PG8_STAGE2(PG8_SA(0, 1), a2, w10, w11);
            PG8_WAIT_V(8); PG8_WAIT_L(0); PG8_BAR; PG8_MMA(0, 0, At, B0); PG8_MMA(0, 1, At, B1); PG8_BAR; PG8_SCHED;
            PG8_LDA(At, 1, 1); PG8_STAGEB(PG8_SB(1, 0), b3); PG8_STAGEB(PG8_SB(1, 1), b3 + hstep); PG8_STAGE2(PG8_SA(1, 0), a3, w00, w01);
            PG8_WAIT_V(8); PG8_WAIT_L(0); PG8_BAR; PG8_MMA(1, 0, At, B0); PG8_MMA(1, 1, At, B1); PG8_BAR; PG8_SCHED;
        }
        if constexpr (ES == 1) asm volatile("s_nop 15\n\ts_nop 15" ::: "memory");
        if (wr == 0) PG8_BAR;
        { int tl = tid; asm volatile("" : "+v"(tl));
          E(acc, cur, wr, wc, tl & 15, (tl >> 4) & 3); }
        S.done(cur, lane);
        if (!has_next) break;
#pragma unroll
        for (int a = 0; a < 2; ++a)
#pragma unroll
            for (int b = 0; b < 2; ++b)
#pragma unroll
                for (int m = 0; m < 4; ++m)
#pragma unroll
                    for (int n = 0; n < 2; ++n) acc[a][b][m][n] = (f32x4){0.f, 0.f, 0.f, 0.f};
        cur = nxt; cB = nB; ++ui;
#pragma unroll
        for (int h = 0; h < 2; ++h)
#pragma unroll
            for (int i = 0; i < 2; ++i) vA[h][i] = vN[h][i];
        if (wr == 1) PG8_BAR;
    }
    PG8_WAIT_V(0);
    PG8_BAR;
#undef PG8_SA
#undef PG8_SB
#undef PG8_STAGE2
#undef PG8_STAGEB
#undef PG8_LDA
#undef PG8_LDB
#undef PG8_MMA
#undef PG8_WAIT_V
#undef PG8_WAIT_L
#undef PG8_BAR
#undef PG8_SCHED
#undef PG8_VOFF
}

struct EpiBf16 {
    static constexpr bool PERM = true;
    bf16_t* O; int ldc;
    __device__ __forceinline__ void operator()(const Acc& acc, const GUnit& u, int wr, int wc, int fr, int fq) const {
        const int col0 = u.pn * BM + wc * 32 + 8 * fq;
#pragma unroll
        for (int ai = 0; ai < 2; ++ai)
#pragma unroll
            for (int m = 0; m < 4; ++m) {
                const int r = ai * HALF + wr * 64 + m * 16 + fr;
                if (r < u.nvalid) {
                    bf16_t* rowp = O + (size_t)(u.orow0 + r) * ldc + col0;
#pragma unroll
                    for (int bj = 0; bj < 2; ++bj) { const f32x4 v0 = acc[ai][bj][m][0], v1 = acc[ai][bj][m][1];
                        u32x4 w; w.x = cvt_pk_bf16(v0[0], v0[1]); w.y = cvt_pk_bf16(v0[2], v0[3]); w.z = cvt_pk_bf16(v1[0], v1[1]); w.w = cvt_pk_bf16(v1[2], v1[3]);
                        *(u32x4*)(rowp + bj * HALF) = w; }
                }
            }
    }
};
struct EpiResid {
    static constexpr bool PERM = true;
    const float* blat; const float* bctx; const bf16_t* bx; bf16_t* out; const float* gate;
    __device__ __forceinline__ void operator()(const Acc& acc, const GUnit& u, int wr, int wc, int fr, int fq) const {
        const int col0 = u.pn * BM + wc * 32 + 8 * fq;
        const int ci = ci_of_row(u.orow0);
        const float* basef = u.orow0 < NLAT ? blat + (size_t)u.orow0 * D : bctx + (size_t)(u.orow0 - NLAT) * D;
#pragma unroll
        for (int bj = 0; bj < 2; ++bj) {
            const f32x4 gv0 = *(const f32x4*)(gate + (size_t)ci * 6144 + col0 + bj * HALF), gv1 = *(const f32x4*)(gate + (size_t)ci * 6144 + col0 + bj * HALF + 4);
#pragma unroll
            for (int ai = 0; ai < 2; ++ai)
#pragma unroll
                for (int m = 0; m < 4; ++m) {
                    const int r = ai * HALF + wr * 64 + m * 16 + fr;
                    f32x4 b0, b1;
                    if (bx) { const u32x4 w = *(const u32x4*)(bx + (size_t)(u.orow0 + r) * D + col0 + bj * HALF);
                        b0 = (f32x4){bflo(w.x), bfhi(w.x), bflo(w.y), bfhi(w.y)}; b1 = (f32x4){bflo(w.z), bfhi(w.z), bflo(w.w), bfhi(w.w)}; }
                    else { b0 = *(const f32x4*)(basef + (size_t)r * D + col0 + bj * HALF); b1 = *(const f32x4*)(basef + (size_t)r * D + col0 + bj * HALF + 4); }
                    const f32x4 o0 = b0 + gv0 * acc[ai][bj][m][0], o1 = b1 + gv1 * acc[ai][bj][m][1];
                    u32x4 w; w.x = cvt_pk_bf16(o0[0], o0[1]); w.y = cvt_pk_bf16(o0[2], o0[3]); w.z = cvt_pk_bf16(o1[0], o1[1]); w.w = cvt_pk_bf16(o1[2], o1[3]);
                    *(u32x4*)(out + (size_t)(u.orow0 + r) * D + col0 + bj * HALF) = w;
                    if (m & 1) asm volatile("" ::: "memory");
                }
        }
    }
};
struct EpiSwiglu {
    static constexpr bool PERM = true;
    bf16_t* O;
    __device__ __forceinline__ void operator()(const Acc& acc, const GUnit& u, int wr, int wc, int fr, int fq) const {
        const int col0 = u.pn * HALF + wc * 32 + 8 * fq;
#pragma unroll
        for (int ai = 0; ai < 2; ++ai)
#pragma unroll
            for (int m = 0; m < 4; ++m) {
                const int r = ai * HALF + wr * 64 + m * 16 + fr;
                if (r < u.nvalid) {
                    const f32x4 g0 = acc[ai][0][m][0], g1 = acc[ai][0][m][1], u0 = acc[ai][1][m][0], u1 = acc[ai][1][m][1];
                    u32x4 w;
                    w.x = cvt_pk_bf16(fast_silu(g0[0]) * u0[0], fast_silu(g0[1]) * u0[1]); w.y = cvt_pk_bf16(fast_silu(g0[2]) * u0[2], fast_silu(g0[3]) * u0[3]);
                    w.z = cvt_pk_bf16(fast_silu(g1[0]) * u1[0], fast_silu(g1[1]) * u1[1]); w.w = cvt_pk_bf16(fast_silu(g1[2]) * u1[2], fast_silu(g1[3]) * u1[3]);
                    *(u32x4*)(O + (size_t)(u.orow0 + r) * 256 + col0) = w;
                }
            }
    }
};

struct DenseSched {
    const char* Bt; int K; int nM, nN; int G, vcu; int ctx_pm0, ctx_pn0;
    __device__ __forceinline__ bool next(int i, GUnit& u) const {
        if (vcu >= G) return false;
        int L = i * G + vcu;
        const int nfull = ctx_pm0 * nN;
        int pm, pn;
        if (L < nfull) { pm = L / nN; pn = L % nN; }
        else { L -= nfull; const int w = nN - ctx_pn0; pm = ctx_pm0 + L / w; pn = ctx_pn0 + L % w; if (pm >= nM) return false; }
        u.Bp = Bt + (size_t)pn * 256 * K * 2; u.rows = nullptr; u.arow0 = pm * 256; u.orow0 = pm * 256; u.nvalid = 256; u.pn = pn; u.e = 0;
        return true;
    }
    __device__ __forceinline__ void done(const GUnit&, int) const {}
};

__device__ __forceinline__ void cvt_item(const float* W, int N, int k0, int n0, bf16_t* WT, int K, int drow0, LAS float* scr, int lane) {
#pragma unroll 8
    for (int i = 0; i < 32; ++i) { const int kk = 2 * i + (lane >> 5); scr[kk * 33 + (lane & 31)] = W[(size_t)(k0 + kk) * N + n0 + (lane & 31)]; }
    LDS_WAIT(); asm volatile("" ::: "memory");
    const int c = lane & 7;
#pragma unroll
    for (int j = 0; j < 4; ++j) { const int n = (lane >> 3) + 8 * j; const LAS float* s = scr + (8 * c) * 33 + n;
        u32x4 o; o.x = pk2(s[0 * 33], s[1 * 33]); o.y = pk2(s[2 * 33], s[3 * 33]); o.z = pk2(s[4 * 33], s[5 * 33]); o.w = pk2(s[6 * 33], s[7 * 33]);
        *(GAS u32x4*)(WT + (size_t)(drow0 + n) * K + k0 + 8 * c) = o; }
    LDS_WAIT(); asm volatile("" ::: "memory");
}
__device__ __forceinline__ bool cvt_job(int& r, const float* W, int K, int N, bf16_t* WT, LAS float* scr, int lane) {
    const int nblk = N / 32, items = (K / 64) * nblk;
    if (r >= items) { r -= items; return false; }
    const int kb = r / nblk, nb = r % nblk;
    cvt_item(W, N, kb * 64, nb * 32, WT, K, nb * 32, scr, lane);
    return true;
}
__device__ __forceinline__ void phase_cvt_mixer(const Frame& F, const In& in) {
    LAS float* scr = (LAS float*)(F.lds + F.wave * 16384);
    const int gw = F.vcu * NWAVES + F.wave, NGW = F.G * NWAVES;
    constexpr int I_AB = 16 * 56, I_O = 16 * 32, I_CD = 16 * 80;
    constexpr int NITEMS = I_AB + I_O + I_CD + I_O;
    for (int it = gw; it < NITEMS; it += NGW) {
        int r = it;
        if (cvt_job(r, in.w_in_ab, D, 1792, (bf16_t*)(F.ws + O_WINAB), scr, F.lane)) continue;
        if (cvt_job(r, in.w_out_ab, D, D, (bf16_t*)(F.ws + O_WOUTAB), scr, F.lane)) continue;
        if (cvt_job(r, in.w_in_cd, D, 2560, (bf16_t*)(F.ws + O_WINCD), scr, F.lane)) continue;
        cvt_job(r, in.w_out_cd, D, D, (bf16_t*)(F.ws + O_WOUTCD), scr, F.lane);
    }
    bf16_t* sg = (bf16_t*)(F.ws + O_SGW);
    for (int i = (F.vcu * NTHREADS + F.tid) * 4; i < 8 * 128 * 128; i += F.G * NTHREADS * 4) {
        const f32x4 v = *(const f32x4*)(in.sg_w + i);
        u32x2 o; o.x = pk2(v[0], v[1]); o.y = pk2(v[2], v[3]);
        *(u32x2*)(sg + i) = o;
    }
}
__device__ __forceinline__ void phase_cvt_down(const Frame& F, const In& in, int l, int cu0, int ncu) {
    if (F.vcu < cu0 || F.vcu >= cu0 + ncu) return;
    LAS float* scr = (LAS float*)(F.lds + F.wave * 16384);
    const int gw = (F.vcu - cu0) * NWAVES + F.wave, NGW = ncu * NWAVES;
    constexpr int I_DN = 4 * 32, N_R = 64 * I_DN;
    bf16_t* WD = (bf16_t*)(F.ws + (l == 0 ? O_WD : O_WD1)); bf16_t* WSD = (bf16_t*)(F.ws + O_WSD) + (size_t)l * D * 256;
    for (int it = gw; it < N_R + 128; it += NGW) {
        int r = it;
        if (r < N_R) { const int e = r / I_DN, q = r % I_DN, kb = q / 32, nb = q % 32;
            cvt_item(in.w_down + ((size_t)l * 64 + e) * 256 * D, D, kb * 64, nb * 32, WD + (size_t)e * D * 256, 256, nb * 32, scr, F.lane); continue; }
        r -= N_R;
        { const int kb = r / 32, nb = r % 32; cvt_item(in.ws_down + (size_t)l * 256 * D, D, kb * 64, nb * 32, WSD, 256, nb * 32, scr, F.lane); }
    }
}

struct CvtDesc { const float* W; unsigned char* WT; int N, k0, n0, drow0, router; };
constexpr int CVT32_GU = 64 * 256;
constexpr int CVT32_ITEMS = 2 * CVT32_GU + 2 * 256 + 64;
__device__ __forceinline__ CvtDesc cvt32_desc(const In& in, unsigned char* ws, int l, int it) {
    CvtDesc d; d.router = 0;
    int r = it;
    if (r < 2 * CVT32_GU) {
        const int up = r >= CVT32_GU; if (up) r -= CVT32_GU;
        const int e = r >> 8, q = r & 255, kb = q >> 3, nb = q & 7;
        d.W = (up ? in.w_up : in.w_gate) + ((size_t)l * 64 + e) * D * 256; d.N = 256; d.k0 = kb * 32; d.n0 = nb * 32;
        d.WT = ws + O_WGU; d.drow0 = e * 512 + (d.n0 / 128) * 256 + up * 128 + (d.n0 % 128);
        return d;
    }
    r -= 2 * CVT32_GU;
    if (r < 512) {
        const int up = r >= 256; if (up) r -= 256;
        const int kb = r >> 3, nb = r & 7;
        d.W = (up ? in.ws_up : in.ws_gate) + (size_t)l * D * 256; d.N = 256; d.k0 = kb * 32; d.n0 = nb * 32;
        d.WT = ws + O_WSGU + (size_t)l * 512 * D; d.drow0 = (d.n0 / 128) * 256 + up * 128 + (d.n0 % 128);
        return d;
    }
    r -= 512;
    d.W = in.w_router + (size_t)l * D * 64; d.N = 64; d.k0 = (r >> 1) * 32; d.n0 = (r & 1) * 32;
    d.WT = ws + O_WR + (size_t)l * 2 * 64 * D * 2; d.router = 1; d.drow0 = d.n0;
    return d;
}
constexpr float WSCALE8 = 64.f;
constexpr int CVB = 8;
__device__ __forceinline__ void cvt_range(const Frame& F, const In& in, int l, int it0, int it1, int scr_base) {
    LAS float* scr = (LAS float*)(F.lds + scr_base + F.wave * 4224);
    const int lane = F.lane, lk = lane >> 3, ln4 = (lane & 7) * 4;
    for (int ib = it0 + CVB * F.wave; ib < it1; ib += CVB * NWAVES) {
        CvtDesc d[CVB]; f32x4 v[CVB][4];
#pragma unroll
        for (int b = 0; b < CVB; ++b) { d[b] = cvt32_desc(in, F.ws, l, min(ib + b, it1 - 1));
#pragma unroll
            for (int i = 0; i < 4; ++i) v[b][i] = *(const f32x4*)(d[b].W + (size_t)(d[b].k0 + lk + 8 * i) * d[b].N + d[b].n0 + ln4); }
#pragma unroll
        for (int b = 0; b < CVB; ++b) {
            if (ib + b < it1) {
#pragma unroll
                for (int i = 0; i < 4; ++i) { LAS float* sp = scr + (lk + 8 * i) * 33 + ln4; sp[0] = v[b][i][0]; sp[1] = v[b][i][1]; sp[2] = v[b][i][2]; sp[3] = v[b][i][3]; }
                LDS_WAIT(); asm volatile("" ::: "memory");
                if (d[b].router) {
#pragma unroll
                    for (int j = 0; j < 2; ++j) { const int t = lane + 64 * j, n = t >> 2, c = t & 3; const LAS float* sp = scr + (8 * c) * 33 + n;
                        float x[8];
#pragma unroll
                        for (int q = 0; q < 8; ++q) x[q] = sp[q * 33];
                        u32x4 o; o.x = cvt_pk_bf16(x[0], x[1]); o.y = cvt_pk_bf16(x[2], x[3]); o.z = cvt_pk_bf16(x[4], x[5]); o.w = cvt_pk_bf16(x[6], x[7]);
                        bf16_t* wt = (bf16_t*)d[b].WT + (size_t)(d[b].drow0 + n) * D + d[b].k0 + 8 * c;
                        *(GAS u32x4*)wt = o;
                        u32x4 p; p.x = cvt_pk_bf16(x[0] - bflo(o.x), x[1] - bfhi(o.x)); p.y = cvt_pk_bf16(x[2] - bflo(o.y), x[3] - bfhi(o.y));
                        p.z = cvt_pk_bf16(x[4] - bflo(o.z), x[5] - bfhi(o.z)); p.w = cvt_pk_bf16(x[6] - bflo(o.w), x[7] - bfhi(o.w));
                        *(GAS u32x4*)(wt + 64 * D) = p; }
                } else {
                    const int n = lane >> 1, c = lane & 1; const LAS float* sp = scr + (16 * c) * 33 + n;
                    float x[16];
#pragma unroll
                    for (int q = 0; q < 16; ++q) x[q] = __builtin_amdgcn_fmed3f(sp[q * 33] * WSCALE8, -448.f, 448.f);
                    u32x4 o;
#pragma unroll
                    for (int q = 0; q < 4; ++q) { int a = __builtin_amdgcn_cvt_pk_fp8_f32(x[4 * q], x[4 * q + 1], 0, false); a = __builtin_amdgcn_cvt_pk_fp8_f32(x[4 * q + 2], x[4 * q + 3], a, true); o[q] = (unsigned)a; }
                    *(GAS u32x4*)(d[b].WT + (size_t)(d[b].drow0 + n) * D + d[b].k0 + 16 * c) = o;
                }
                LDS_WAIT(); asm volatile("" ::: "memory");
            }
        }
    }
}
__device__ __forceinline__ void cvt_wgu_part(const Frame& F, const In& in, int l, int lo, int hi, int cu0, int ncu, int scr_base) {
    if (F.vcu < cu0 || F.vcu >= cu0 + ncu) return;
    const int k = F.vcu - cu0, n = hi - lo;
    cvt_range(F, in, l, lo + (int)(((long)k * n) / ncu), lo + (int)(((long)(k + 1) * n) / ncu), scr_base);
}

__device__ __forceinline__ void normmod_row(const float* xrow, const float* g, const float* sh, const float* sc, bf16_t* orow, int lane) {
    const GAS f32x4* xr = (const GAS f32x4*)xrow + lane;
    f32x4 v[4]; float s = 0.f;
#pragma unroll
    for (int j = 0; j < 4; ++j) { v[j] = xr[64 * j]; s += (v[j].x * v[j].x + v[j].y * v[j].y) + (v[j].z * v[j].z + v[j].w * v[j].w); }
    const float rstd = rsqrtf(wave_sum(s) * (1.f / D) + EPS);
    GAS u32x2* o8 = (GAS u32x2*)orow + lane;
#pragma unroll
    for (int j = 0; j < 4; ++j) {
        const f32x4 gg = ((const GAS f32x4*)g)[lane + 64 * j], ss = ((const GAS f32x4*)sh)[lane + 64 * j], cc = ((const GAS f32x4*)sc)[lane + 64 * j];
        const f32x4 h = v[j] * rstd * gg * (1.f + cc) + ss;
        u32x2 o; o.x = pk2(h.x, h.y); o.y = pk2(h.z, h.w);
        o8[64 * j] = o;
    }
}
__device__ __forceinline__ void phase_normmod(const Frame& F, const float* xlat, const float* xctx, const float* g, const float* MODl, int jshift, bf16_t* A, int nrows) {
    const int gw = F.vcu * NWAVES + F.wave, NGW = F.G * NWAVES;
    for (int row = gw; row < nrows; row += NGW) {
        const float* xr = row < NLAT ? xlat + (size_t)row * D : xctx + (size_t)(row - NLAT) * D;
        const float* sh = MODl + (size_t)ci_of_row(row) * 6144 + jshift * D;
        normmod_row(xr, g, sh, sh + D, A + (size_t)row * D, F.lane);
    }
    if (gw == 0) { GAS u32x4* z = (GAS u32x4*)(A + (size_t)ZROW * D); z[F.lane] = (u32x4){0u, 0u, 0u, 0u}; z[F.lane + 64] = (u32x4){0u, 0u, 0u, 0u}; }
}
namespace ab {
typedef short s16x4 __attribute__((ext_vector_type(4)));
typedef float f32x16 __attribute__((ext_vector_type(16)));
constexpr int NW = 8, QBLK = 32, QB = QBLK * NW, KVBLK = 64;
__device__ __forceinline__ int crow(int r, int hi) { return (r & 3) + 8 * (r >> 2) + 4 * hi; }
#define SBAR() __builtin_amdgcn_sched_barrier(0)
constexpr int NSLOT = 3, SLOTB = 8192;
constexpr int LDS_K = 0, LDS_V = NSLOT * SLOTB, LDS_WS = 2 * NSLOT * SLOTB, LDS_OST = LDS_WS + NW * 64 * 4, ATTN_LDS_BYTES = LDS_OST + NW * 4096;
__device__ __forceinline__ void glds16(const void* gsrc, unsigned lds_dst) { unsigned keep;
  asm volatile("s_mov_b32 %0, m0\n\ts_mov_b32 m0, %2\n\ts_nop 0\n\tglobal_load_lds_dwordx4 %1, off\n\ts_mov_b32 m0, %0" : "=&s"(keep) : "v"(gsrc), "s"(lds_dst) : "memory"); }
__device__ __forceinline__ float max3f(float a, float b, float c) { float r; asm("v_max3_f32 %0, %1, %2, %3" : "=v"(r) : "v"(a), "v"(b), "v"(c)); return r; }
__device__ __forceinline__ float max2f(float a, float b) { float r; asm("v_max_f32_e32 %0, %1, %2" : "=v"(r) : "v"(a), "v"(b)); return r; }
__device__ __forceinline__ float fadd_s(float a, float b) { float r; asm("v_add_f32_e32 %0, %1, %2" : "=v"(r) : "v"(a), "v"(b)); return r; }
__device__ __forceinline__ float fsub_s(float a, float b) { float r; asm("v_sub_f32_e32 %0, %1, %2" : "=v"(r) : "v"(a), "v"(b)); return r; }
typedef float f32x2_t __attribute__((ext_vector_type(2))); typedef __bf16 bf16x2_t __attribute__((ext_vector_type(2)));
__device__ __forceinline__ unsigned cvtpk_s(float lo, float hi) { f32x2_t v = {lo, hi}; bf16x2_t b = __builtin_convertvector(v, bf16x2_t); return __builtin_bit_cast(unsigned, b); }
#define WAIT_BAR(N) asm volatile("s_waitcnt vmcnt(" #N ") lgkmcnt(0)\n\ts_barrier" ::: "memory")

__device__ __forceinline__ void qkt(f32x16& p0, f32x16& p1, const char* Kslot, const bf16x8* qr, const f32x16& negm, int r32, int hi) {
  const char* kb = Kslot + hi * 1024 + r32 * 16;
  #pragma unroll
  for (int d0 = 0; d0 < 4; ++d0) {
    const bf16x8 b0 = *reinterpret_cast<const bf16x8*>(kb + d0 * 2048);
    const bf16x8 b1 = *reinterpret_cast<const bf16x8*>(kb + d0 * 2048 + 512);
    if (d0 == 0) { p0 = __builtin_amdgcn_mfma_f32_32x32x16_bf16(b0, qr[0], negm, 0, 0, 0); p1 = __builtin_amdgcn_mfma_f32_32x32x16_bf16(b1, qr[0], negm, 0, 0, 0); }
    else { p0 = __builtin_amdgcn_mfma_f32_32x32x16_bf16(b0, qr[d0], p0, 0, 0, 0); p1 = __builtin_amdgcn_mfma_f32_32x32x16_bf16(b1, qr[d0], p1, 0, 0, 0); } }
}
typedef __attribute__((address_space(3))) const char* lds_cptr;
typedef short v4i16_t __attribute__((ext_vector_type(4)));
__device__ __forceinline__ void kload8(bf16x8* kf, lds_cptr kp) {
  kf[0] = *(const __attribute__((address_space(3))) bf16x8*)(kp);        kf[1] = *(const __attribute__((address_space(3))) bf16x8*)(kp + 512);
  kf[2] = *(const __attribute__((address_space(3))) bf16x8*)(kp + 2048); kf[3] = *(const __attribute__((address_space(3))) bf16x8*)(kp + 2560);
  kf[4] = *(const __attribute__((address_space(3))) bf16x8*)(kp + 4096); kf[5] = *(const __attribute__((address_space(3))) bf16x8*)(kp + 4608);
  kf[6] = *(const __attribute__((address_space(3))) bf16x8*)(kp + 6144); kf[7] = *(const __attribute__((address_space(3))) bf16x8*)(kp + 6656);
}
__device__ __forceinline__ void kload2(bf16x8* kf, lds_cptr kp, int j) { kf[2 * j] = *(const __attribute__((address_space(3))) bf16x8*)(kp + j * 2048); kf[2 * j + 1] = *(const __attribute__((address_space(3))) bf16x8*)(kp + j * 2048 + 512); }
__device__ __forceinline__ s16x4 vtr(lds_cptr p) { return __builtin_bit_cast(s16x4, __builtin_amdgcn_ds_read_tr16_b64_v4i16((__attribute__((address_space(3))) v4i16_t*)p)); }
__device__ __forceinline__ float rowmax(const f32x16& p0, const f32x16& p1) {
  float a = max3f(p0[0], p0[1], p1[0]), b = max3f(p0[2], p0[3], p1[1]); a = max3f(a, p1[2], p1[3]);
  #pragma unroll
  for (int r = 4; r < 16; r += 4) { a = max3f(a, p0[r], p0[r + 1]); b = max3f(b, p0[r + 2], p0[r + 3]); a = max3f(a, p1[r], p1[r + 1]); b = max3f(b, p1[r + 2], p1[r + 3]); }
  const float m = max2f(a, b);
  auto rr = __builtin_amdgcn_permlane32_swap(__float_as_uint(m), __float_as_uint(m), false, false);
  return max2f(__uint_as_float(rr[0]), __uint_as_float(rr[1]));
}
__device__ __forceinline__ void pv(f32x16* o, int vb, bf16x8 pa0, bf16x8 pa1, bf16x8 pa2, bf16x8 pa3) {
  #pragma unroll
  for (int d0 = 0; d0 < 2; ++d0) { s16x4 lo[4], hi[4];
    #pragma unroll
    for (int ks = 0; ks < 4; ++ks) {
      asm volatile("ds_read_b64_tr_b16 %0,%1 offset:%c2" : "=&v"(lo[ks]) : "v"(vb), "i"(d0 * 4096 + ks * 1024) : "memory");
      asm volatile("ds_read_b64_tr_b16 %0,%1 offset:%c2" : "=&v"(hi[ks]) : "v"(vb), "i"(d0 * 4096 + ks * 1024 + 512) : "memory"); }
    asm volatile("s_waitcnt lgkmcnt(0)" ::: "memory"); SBAR();
    #define PK(k) (bf16x8){lo[k][0], lo[k][1], lo[k][2], lo[k][3], hi[k][0], hi[k][1], hi[k][2], hi[k][3]}
    o[d0] = __builtin_amdgcn_mfma_f32_32x32x16_bf16(pa0, PK(0), o[d0], 0, 0, 0);
    o[d0] = __builtin_amdgcn_mfma_f32_32x32x16_bf16(pa1, PK(1), o[d0], 0, 0, 0);
    o[d0] = __builtin_amdgcn_mfma_f32_32x32x16_bf16(pa2, PK(2), o[d0], 0, 0, 0);
    o[d0] = __builtin_amdgcn_mfma_f32_32x32x16_bf16(pa3, PK(3), o[d0], 0, 0, 0);
    #undef PK
  }
}
struct TileMap { int nA, tokA, tokB; __device__ __forceinline__ long tok(int t) const { return t < nA ? tokA + 64 * t : tokB + 64 * (t - nA); } };
struct NoHook { __device__ __forceinline__ void operator()(f32x16&, f32x16&, int) const {} };

template <int THRL, class Hook>
__device__ __forceinline__ void attn_unit(const bf16_t* Qw0, int QP, const bf16_t* __restrict__ Kh, const bf16_t* __restrict__ Vh, int KP, const TileMap tm, const int NT,
                                          bf16_t* Ow0, int OP, char* shm, const Hook& hook) {
  int tid = threadIdx.x; asm volatile("" : "+v"(tid)); const int lane = tid & 63, r32 = lane & 31, hi = lane >> 5; const int wid = __builtin_amdgcn_readfirstlane(tid >> 6);
  const bf16_t* Qw = Qw0 + (long)wid * QBLK * QP;
  const unsigned lds0 = (unsigned)(uintptr_t)shm;
  float* wsf = (float*)(shm + LDS_WS) + wid * 64;
  const bf16_t* ksrc = Kh + (long)lane * KP + wid * 8;
  const bf16_t* vsrc = Vh + (long)(16 * (wid & 3) + (lane >> 2)) * KP + (wid >> 2) * 32 + (lane & 3) * 8;
  const unsigned kdst = lds0 + LDS_K + wid * 1024, vdst = lds0 + LDS_V + wid * 1024;
  #define DMA_K(t, slot) glds16(ksrc + tm.tok(t) * KP, (unsigned)__builtin_amdgcn_readfirstlane(kdst + (slot)))
  #define DMA_V(t, slot) glds16(vsrc + tm.tok(t) * KP, (unsigned)__builtin_amdgcn_readfirstlane(vdst + (slot)))
  const int vb0 = (int)(lds0 + LDS_V) + ((lane >> 4) & 1) * 32 + (lane & 3) * 8 + (4 * hi + ((lane & 15) >> 2)) * 64;
  const char* Kbase = shm + LDS_K; bf16x8 kf[8];
  const lds_cptr shm3 = (lds_cptr)shm; const lds_cptr kp0 = shm3 + LDS_K + hi * 1024 + r32 * 16; const lds_cptr vp0 = shm3 + LDS_V + ((lane >> 4) & 1) * 32 + (lane & 3) * 8 + (4 * hi + ((lane & 15) >> 2)) * 64;
  DMA_K(0, 0); DMA_V(0, 0); DMA_K(1, SLOTB);
  bf16x8 qr[4];
  #pragma unroll
  for (int d0 = 0; d0 < 4; ++d0) qr[d0] = *reinterpret_cast<const bf16x8*>(&Qw[(long)r32 * QP + d0 * 16 + hi * 8]);
  float mhat = 0.f, l_reg = 0.f; f32x16 o[2]; o[0] = f32x16{}; o[1] = f32x16{}; f32x16 negm = f32x16{}; asm volatile("" : "+v"(negm));
  #define HOOK(P0, P1, t) hook(P0, P1, t)
  bool resc = false;
  #define START(P0, P1) do { const float rm = rowmax(P0, P1); resc = false; \
    { const float dl = rm; mhat = fadd_s(mhat, dl); \
      _Pragma("unroll") for (int r = 0; r < 16; ++r) { P0[r] = fsub_s(P0[r], dl); P1[r] = fsub_s(P1[r], dl); } \
      _Pragma("unroll") for (int r = 0; r < 16; ++r) negm[r] = -mhat; asm volatile("" : "+v"(negm)); } \
    _Pragma("unroll") for (int r = 0; r < 16; ++r) P0[r] = __builtin_amdgcn_exp2f(P0[r]); } while (0)
  #define RESC() do { if (resc) { asm volatile("s_waitcnt lgkmcnt(0)" ::: "memory"); \
      _Pragma("unroll") for (int d_ = 0; d_ < 2; ++d_) _Pragma("unroll") for (int r = 0; r < 16; ++r) o[d_][r] *= wsf[crow(r, hi)]; } } while (0)
  f32x16 pA0, pA1, pB0, pB1;
  int sl_prev = 0, sl_cur = 0, sl_next = SLOTB;
  #define ROT() do { sl_prev = sl_cur; sl_cur = sl_next; sl_next = (sl_next == (NSLOT - 1) * SLOTB) ? 0 : sl_next + SLOTB; } while (0)
  DMA_K(2, 2 * SLOTB);
  WAIT_BAR(3);
  qkt(pA0, pA1, Kbase, qr, negm, r32, hi); asm volatile("s_nop 15\n\ts_nop 7" : "+v"(pA0), "+v"(pA1)); HOOK(pA0, pA1, 0);
  START(pA0, pA1);
  _Pragma("unroll") for (int r = 0; r < 16; ++r) pA1[r] = __builtin_amdgcn_exp2f(pA1[r]);
  WAIT_BAR(0);
  DMA_K(3, 0); DMA_V(1, SLOTB);
  ROT();
  kload8(kf, kp0 + sl_cur);
  WAIT_BAR(2);
  s16x4 vlo[8], vhi[8]; u32x4 pw0, pw1, pw2, pw3;
  #define PKW(P, B) cvtpk_s(P[B], P[B + 1])
  #define PAF(k) __builtin_bit_cast(bf16x8, pw##k)
  #define VFR(i) (bf16x8){vlo[i][0], vlo[i][1], vlo[i][2], vlo[i][3], vhi[i][0], vhi[i][1], vhi[i][2], vhi[i][3]}
  #define PIN(x) asm volatile("" : "+v"(x))
  #define MX3(a, b, c) __builtin_fmaxf(__builtin_fmaxf((a), (b)), (c))
  #define GAPA(MF, A0, A1, A2, A3, W0, W1, PW) do { MF; sacc += A0; sacc += A1; sacc += A2; sacc += A3; PIN(sacc); W0; W1; PIN(PW); SBAR(); } while (0)
  #define EX(v) __builtin_amdgcn_exp2f(v)
  #define GAPB(MF, X, B) do { MF; X[B] = EX(X[B]); X[B + 1] = EX(X[B + 1]); X[B + 2] = EX(X[B + 2]); X[B + 3] = EX(X[B + 3]); PIN(X); SBAR(); } while (0)
  #define VRD(i) do { vlo[i] = vtr(vp_ + (((i) >> 2) * 4096 + ((i) & 3) * 1024)); vhi[i] = vtr(vp_ + (((i) >> 2) * 4096 + ((i) & 3) * 1024 + 512)); } while (0)
  #define KRD(G, j) do { if (G) { kload2(kf, kp0 + sl_next, j); SBAR(); } } while (0)
  #define STEP(C0, C1, P0, P1, t, GK, GV, GL) do { SBAR(); \
    const lds_cptr vp_ = vp0 + sl_prev; \
    VRD(0); SBAR(); float sacc = (P0[0] + P0[1]); \
    GAPA(C0 = __builtin_amdgcn_mfma_f32_32x32x16_bf16(kf[0], qr[0], negm, 0, 0, 0), P0[2], P0[3], P0[4], P0[5],     pw0[0] = PKW(P0, 0), pw0[1] = PKW(P0, 2), pw0); \
    VRD(4); SBAR(); GAPA(C1 = __builtin_amdgcn_mfma_f32_32x32x16_bf16(kf[1], qr[0], negm, 0, 0, 0), P0[6], P0[7], P0[8], P0[9],     pw0[2] = PKW(P0, 4), pw0[3] = PKW(P0, 6), pw0); \
    VRD(1); SBAR(); GAPA(C0 = __builtin_amdgcn_mfma_f32_32x32x16_bf16(kf[2], qr[1], C0, 0, 0, 0),   P0[10], P0[11], P0[12], P0[13], pw1[0] = PKW(P0, 8), pw1[1] = PKW(P0, 10), pw1); \
    VRD(5); SBAR(); GAPA(C1 = __builtin_amdgcn_mfma_f32_32x32x16_bf16(kf[3], qr[1], C1, 0, 0, 0),   P0[14], P0[15], P1[0], P1[1],   pw1[2] = PKW(P0, 12), pw1[3] = PKW(P0, 14), pw1); \
    VRD(2); SBAR(); GAPA(C0 = __builtin_amdgcn_mfma_f32_32x32x16_bf16(kf[4], qr[2], C0, 0, 0, 0),   P1[2], P1[3], P1[4], P1[5],     pw2[0] = PKW(P1, 0), pw2[1] = PKW(P1, 2), pw2); \
    VRD(6); SBAR(); GAPA(C1 = __builtin_amdgcn_mfma_f32_32x32x16_bf16(kf[5], qr[2], C1, 0, 0, 0),   P1[6], P1[7], P1[8], P1[9],     pw2[2] = PKW(P1, 4), pw2[3] = PKW(P1, 6), pw2); \
    VRD(3); SBAR(); GAPA(C0 = __builtin_amdgcn_mfma_f32_32x32x16_bf16(kf[6], qr[3], C0, 0, 0, 0),   P1[10], P1[11], P1[12], P1[13], pw3[0] = PKW(P1, 8), pw3[1] = PKW(P1, 10), pw3); \
    VRD(7); SBAR(); GAPA(C1 = __builtin_amdgcn_mfma_f32_32x32x16_bf16(kf[7], qr[3], C1, 0, 0, 0),   P1[14], P1[15], 0.f, 0.f,       pw3[2] = PKW(P1, 12), pw3[3] = PKW(P1, 14), pw3); \
    l_reg += sacc; \
    if (GK) { DMA_K((t) + 3, sl_cur); } if (GV) { DMA_V((t) + 1, sl_next); } \
    HOOK(C0, C1, t); \
    { float a = MX3(C0[0], C0[1], C1[0]), b = MX3(C0[2], C0[3], C1[1]); a = MX3(a, C1[2], C1[3]); \
      _Pragma("unroll") for (int r = 4; r < 16; r += 4) { a = MX3(a, C0[r], C0[r + 1]); b = MX3(b, C0[r + 2], C0[r + 3]); a = MX3(a, C1[r], C1[r + 1]); b = MX3(b, C1[r + 2], C1[r + 3]); } \
      float rm = __builtin_fmaxf(a, b); { auto rr = __builtin_amdgcn_permlane32_swap(__float_as_uint(rm), __float_as_uint(rm), false, false); rm = __builtin_fmaxf(__uint_as_float(rr[0]), __uint_as_float(rr[1])); } \
      resc = false; \
      if (__builtin_expect(__any(rm > (float)THRL), 0)) { const float dl = __builtin_fmaxf(rm, 0.f); mhat += dl; \
        _Pragma("unroll") for (int r = 0; r < 16; ++r) { C0[r] -= dl; C1[r] -= dl; } \
        _Pragma("unroll") for (int r = 0; r < 16; ++r) negm[r] = -mhat; asm volatile("" : "+v"(negm)); \
        const float f = __builtin_amdgcn_exp2f(-dl); l_reg *= f; if (hi == 0) wsf[r32] = f; resc = true; } } \
    SBAR(); \
    GAPB(o[0] = __builtin_amdgcn_mfma_f32_32x32x16_bf16(PAF(0), VFR(0), o[0], 0, 0, 0), C0, 0); \
    GAPB(o[1] = __builtin_amdgcn_mfma_f32_32x32x16_bf16(PAF(0), VFR(4), o[1], 0, 0, 0), C0, 4); \
    KRD(GL, 0); GAPB(o[0] = __builtin_amdgcn_mfma_f32_32x32x16_bf16(PAF(1), VFR(1), o[0], 0, 0, 0), C0, 8); \
    KRD(GL, 1); GAPB(o[1] = __builtin_amdgcn_mfma_f32_32x32x16_bf16(PAF(1), VFR(5), o[1], 0, 0, 0), C0, 12); \
    KRD(GL, 2); GAPB(o[0] = __builtin_amdgcn_mfma_f32_32x32x16_bf16(PAF(2), VFR(2), o[0], 0, 0, 0), C1, 0); \
    KRD(GL, 3); GAPB(o[1] = __builtin_amdgcn_mfma_f32_32x32x16_bf16(PAF(2), VFR(6), o[1], 0, 0, 0), C1, 4); \
    GAPB(o[0] = __builtin_amdgcn_mfma_f32_32x32x16_bf16(PAF(3), VFR(3), o[0], 0, 0, 0), C1, 8); \
    GAPB(o[1] = __builtin_amdgcn_mfma_f32_32x32x16_bf16(PAF(3), VFR(7), o[1], 0, 0, 0), C1, 12); \
    } while (0)
  int t = 1;
  for (; t + 5 < NT; t += 2) {
    STEP(pB0, pB1, pA0, pA1, t, true, true, true);     WAIT_BAR(2); RESC(); ROT();
    STEP(pA0, pA1, pB0, pB1, t + 1, true, true, true); WAIT_BAR(2); RESC(); ROT();
  }
  #define ENDW(tt) do { if ((tt) + 3 < NT) { WAIT_BAR(2); } else if ((tt) + 2 < NT) { WAIT_BAR(1); } else { WAIT_BAR(0); } } while (0)
  for (; t + 1 < NT; t += 2) {
    STEP(pB0, pB1, pA0, pA1, t, (t + 3 < NT), (t + 1 < NT), (t + 1 < NT));       ENDW(t);     RESC(); ROT();
    STEP(pA0, pA1, pB0, pB1, t + 1, (t + 4 < NT), (t + 2 < NT), (t + 2 < NT));   ENDW(t + 1); RESC(); ROT();
  }
  STEP(pB0, pB1, pA0, pA1, NT - 1, false, false, false); RESC();
  { float sacc = pB0[0] + pB0[1]; _Pragma("unroll") for (int r = 2; r < 16; ++r) sacc += pB0[r]; _Pragma("unroll") for (int r = 0; r < 16; ++r) sacc += pB1[r]; l_reg += sacc;
    pw0 = (u32x4){PKW(pB0, 0), PKW(pB0, 2), PKW(pB0, 4), PKW(pB0, 6)}; pw1 = (u32x4){PKW(pB0, 8), PKW(pB0, 10), PKW(pB0, 12), PKW(pB0, 14)}; pw2 = (u32x4){PKW(pB1, 0), PKW(pB1, 2), PKW(pB1, 4), PKW(pB1, 6)}; pw3 = (u32x4){PKW(pB1, 8), PKW(pB1, 10), PKW(pB1, 12), PKW(pB1, 14)};
    SBAR(); pv(o, vb0 + sl_cur, PAF(0), PAF(1), PAF(2), PAF(3)); }
  #undef PKW
  #undef PAF
  #undef VFR
  #undef PIN
  #undef MX3
  #undef GAPA
  #undef GAPB
  #undef EX
  #undef VRD
  #undef KRD
  #undef STEP
  #undef ENDW
  { auto rr = __builtin_amdgcn_permlane32_swap(__float_as_uint(l_reg), __float_as_uint(l_reg), false, false); l_reg = __uint_as_float(rr[0]) + __uint_as_float(rr[1]); }
  if (hi == 0) wsf[32 + r32] = l_reg; asm volatile("s_waitcnt lgkmcnt(0)" ::: "memory");
  float rli[16];
  #pragma unroll
  for (int r = 0; r < 16; ++r) rli[r] = __builtin_amdgcn_rcpf(wsf[32 + crow(r, hi)]);
  bf16_t* Ow = Ow0 + (long)wid * QBLK * OP;
  { bf16_t* stg = (bf16_t*)(shm + LDS_OST) + wid * 2048;
    #pragma unroll
    for (int r = 0; r < 16; ++r) { const int orow = crow(r, hi);
      #pragma unroll
      for (int d0 = 0; d0 < 2; ++d0) stg[orow * 64 + d0 * 32 + r32] = (bf16_t)f2bf(o[d0][r] * rli[r]); }
    asm volatile("s_waitcnt lgkmcnt(0)" ::: "memory");
    #pragma unroll
    for (int i = 0; i < 4; ++i) { const int row = i * 8 + (lane >> 3), ch = lane & 7; const u32x4 v = *(const u32x4*)(stg + row * 64 + ch * 8); *(u32x4*)(Ow + (long)row * OP + ch * 8) = v; } }
  asm volatile("s_waitcnt lgkmcnt(0)\n\ts_barrier" ::: "memory");
  #undef DMA_K
  #undef DMA_V
  #undef HOOK
  #undef START
  #undef RESC
  #undef ROT
}
#undef SBAR
#undef WAIT_BAR
}
template <int J> __device__ __forceinline__ void conv_step(const LAS float* glc, const float (&w)[31], float (&acc)[32]) {
    if constexpr (J < 62) {
        const float v = glc[J * 512];
        constexpr int PLO = J - 30 > 0 ? J - 30 : 0, PHI = J < 31 ? J : 31;
#pragma unroll
        for (int p = PLO; p <= PHI; ++p) acc[p] += w[J - p] * v;
        conv_step<J + 1>(glc, w, acc);
    }
}
__device__ __forceinline__ void phase_conv0(const Frame& F, const In& in, const bf16_t* Z  , bf16_t* CAT  ) {
    const int c = F.tid;
    LAS float* gl = (LAS float*)F.lds;
    constexpr int NITEMS = 8 * 64 + 8 * 8;
    for (int it = F.vcu; it < NITEMS; it += F.G) {
        int seqbase, t0, L;
        if (it < 512) { seqbase = (it / 64) * T; t0 = (it % 64) * 32; L = T; }
        else { const int j = it - 512; seqbase = NLAT + (j / 8) * NC; t0 = (j % 8) * 32; L = NC; }
        __syncthreads();
#pragma unroll 2
        for (int i = 0; i < 8; ++i) {
            const int j = (F.tid >> 6) + 8 * i;
            const int tt = t0 - 15 + j, ch = (F.tid & 63) * 8;
            if (j < 62) {
                u32x4 a = (u32x4){0u, 0u, 0u, 0u}, g = a;
                if (tt >= 0 && tt < L) { const bf16_t* zr = Z + (size_t)(seqbase + tt) * 1792 + ch; a = *(const u32x4*)zr; g = *(const u32x4*)(zr + 512); }
                const f32x4 o0 = (f32x4){bflo(a.x) * fast_sigmoid(bflo(g.x)), bfhi(a.x) * fast_sigmoid(bfhi(g.x)), bflo(a.y) * fast_sigmoid(bflo(g.y)), bfhi(a.y) * fast_sigmoid(bfhi(g.y))};
                const f32x4 o1 = (f32x4){bflo(a.z) * fast_sigmoid(bflo(g.z)), bfhi(a.z) * fast_sigmoid(bfhi(g.z)), bflo(a.w) * fast_sigmoid(bflo(g.w)), bfhi(a.w) * fast_sigmoid(bfhi(g.w))};
                *(LAS f32x4*)(gl + j * 512 + ch) = o0; *(LAS f32x4*)(gl + j * 512 + ch + 4) = o1;
            }
        }
        __syncthreads();
        float w[31];
#pragma unroll
        for (int k = 0; k < 31; ++k) w[k] = in.conv_w[k * 512 + c];
        const float cb = in.conv_b[c];
        float acc[32];
#pragma unroll
        for (int p = 0; p < 32; ++p) acc[p] = cb;
        conv_step<0>(gl + c, w, acc);
        __syncthreads();
#pragma unroll
        for (int p = 0; p < 32; ++p) gl[p * 512 + c] = acc[p];
        __syncthreads();
#pragma unroll
        for (int q = 0; q < 4; ++q) {
            const int p = F.wave * 4 + q;
            const f32x4 a = *(const LAS f32x4*)(gl + p * 512 + 8 * F.lane), b = *(const LAS f32x4*)(gl + p * 512 + 8 * F.lane + 4);
            const float mu = wave_sum((a[0] + a[1]) + (a[2] + a[3]) + (b[0] + b[1]) + (b[2] + b[3])) * (1.f / 512.f);
            const f32x4 da = a - mu, db = b - mu;
            const float var = wave_sum((da[0] * da[0] + da[1] * da[1]) + (da[2] * da[2] + da[3] * da[3]) + (db[0] * db[0] + db[1] * db[1]) + (db[2] * db[2] + db[3] * db[3])) * (1.f / 512.f);
            const float rstd = rsqrtf(var + EPS);
            const f32x4 g0 = *(const f32x4*)(in.conv_ln_g + 8 * F.lane), g1 = *(const f32x4*)(in.conv_ln_g + 8 * F.lane + 4);
            const f32x4 b0 = *(const f32x4*)(in.conv_ln_b + 8 * F.lane), b1 = *(const f32x4*)(in.conv_ln_b + 8 * F.lane + 4);
            const f32x4 o0 = da * rstd * g0 + b0, o1 = db * rstd * g1 + b1;
            u32x4 o; o.x = pk2(fast_silu(o0[0]), fast_silu(o0[1])); o.y = pk2(fast_silu(o0[2]), fast_silu(o0[3])); o.z = pk2(fast_silu(o1[0]), fast_silu(o1[1])); o.w = pk2(fast_silu(o1[2]), fast_silu(o1[3]));
            *(u32x4*)(CAT + (size_t)(seqbase + t0 + p) * D + 8 * F.lane) = o;
        }
    }
    __syncthreads();
}

__device__ __forceinline__ void phase_qkv0(const Frame& F, const In& in, const bf16_t* Z, bf16_t* Q, bf16_t* Kb, bf16_t* Vb) {
    const int gw = F.vcu * NWAVES + F.wave, NGW = F.G * NWAVES, lane = F.lane;
    const int d0 = 4 * (lane & 15);
    const f32x4 qg = *(const f32x4*)(in.qn_g + d0), kg = *(const f32x4*)(in.kn_g + d0);
    const int half = d0 >> 5, dd = d0 & 31; const bool first = dd < 16; const int f0 = dd & 15;
    float inv[4];
#pragma unroll
    for (int e = 0; e < 4; ++e) inv[e] = __builtin_amdgcn_exp2f(-(float)(f0 + e) * (13.287712379549449f / 16.f)) * 0.15915494309189535f;
    for (int row = gw; row < NR; row += NGW) {
        const bool lat = row < NLAT;
        int b, t;
        if (lat) { b = row / T; t = row % T; } else { const int r2 = row - NLAT; b = r2 / NC; t = T + r2 % NC; }
        const size_t kvrow = (size_t)b * KEYS + t;
        const float pos = half == 0 ? (float)(t >> 6) : (float)(t & 63);
        float cs[4], sn[4];
#pragma unroll
        for (int e = 0; e < 4; ++e) { const float rev = pos * inv[e]; cs[e] = __builtin_amdgcn_cosf(rev); sn[e] = __builtin_amdgcn_sinf(rev); }
        const bf16_t* zr = Z + (size_t)row * 1792 + 1024;
#pragma unroll
        for (int g = 0; g < 3; ++g) {
            const u32x2 raw = *(const u32x2*)(zr + g * 256 + 4 * lane);
            float x[4] = {bflo(raw.x), bfhi(raw.x), bflo(raw.y), bfhi(raw.y)};
            const bool isv = (g == 2) && lane >= 32;
            float ss = (x[0] * x[0] + x[1] * x[1]) + (x[2] * x[2] + x[3] * x[3]);
            ss += __shfl_xor(ss, 1); ss += __shfl_xor(ss, 2); ss += __shfl_xor(ss, 4); ss += __shfl_xor(ss, 8);
            const float rstd = rsqrtf(ss * (1.f / 64.f) + EPS);
            const f32x4 gn = (g == 2) ? kg : qg;
            float y[4];
#pragma unroll
            for (int e = 0; e < 4; ++e) y[e] = isv ? x[e] : x[e] * rstd * gn[e];
#pragma unroll
            for (int e = 0; e < 4; ++e) {
                const float yp = __shfl_xor(y[e], 4);
                const float r = first ? y[e] * cs[e] - yp * sn[e] : y[e] * cs[e] + yp * sn[e];
                if (lat && !isv) y[e] = r;
            }
            if (g < 2) { u32x2 o; o.x = pk2(y[0] * C2, y[1] * C2); o.y = pk2(y[2] * C2, y[3] * C2); *(u32x2*)(Q + (size_t)row * 512 + g * 256 + 4 * lane) = o; }
            else { u32x2 o; o.x = pk2(y[0], y[1]); o.y = pk2(y[2], y[3]);
                if (lane < 32) *(u32x2*)(Kb + kvrow * 128 + 4 * lane) = o; else *(u32x2*)(Vb + kvrow * 128 + 4 * (lane - 32)) = o; }
        }
    }
}

constexpr int ATTN_CVT_SCR = 86016;
__device__ __forceinline__ void phase_attn0(const Frame& F, const In& in, char* shm, const bf16_t* Q, const bf16_t* Kb, const bf16_t* Vb, bf16_t* CAT) {
    for (int u = F.vcu; u < 512 + 64; u += F.G) {
        if (u < 512) {
            const int bk = u >> 5, qb = (u >> 2) & 7, g = u & 3, b = bk >> 1, hkv = bk & 1, h = hkv * 4 + g;
            const size_t row0 = (size_t)b * T + qb * 256;
            ab::TileMap tm{36, 0, 0};
            ab::attn_unit<8, ab::NoHook>(Q + row0 * 512 + h * 64, 512, Kb + (size_t)b * KEYS * 128 + hkv * 64, Vb + (size_t)b * KEYS * 128 + hkv * 64, 128, tm, 36,
                                         CAT + row0 * D + 512 + h * 64, D, shm, ab::NoHook{});
        } else {
            const int j = u - 512, b = j >> 3, h = j & 7, hkv = h >> 2;
            const size_t row0 = (size_t)NLAT + b * NC;
            ab::TileMap tm{4, T, T};
            ab::attn_unit<8, ab::NoHook>(Q + row0 * 512 + h * 64, 512, Kb + (size_t)b * KEYS * 128 + hkv * 64, Vb + (size_t)b * KEYS * 128 + hkv * 64, 128, tm, 4,
                                         CAT + row0 * D + 512 + h * 64, D, shm, ab::NoHook{});
        }
    }
}
__device__ __forceinline__ unsigned grp8_umax(unsigned v) {
    v = max(v, (unsigned)__builtin_amdgcn_update_dpp((int)v, (int)v, 0xB1, 0xf, 0xf, true));
    v = max(v, (unsigned)__builtin_amdgcn_update_dpp((int)v, (int)v, 0x4E, 0xf, 0xf, true));
    v = max(v, (unsigned)__builtin_amdgcn_update_dpp((int)v, (int)v, 0x141, 0xf, 0xf, true));
    return v;
}
__device__ __forceinline__ float grp8_fmax(float x) {
    int v = __builtin_bit_cast(int, x);
    v = __builtin_bit_cast(int, fmaxf(__builtin_bit_cast(float, v), __builtin_bit_cast(float, __builtin_amdgcn_update_dpp(v, v, 0xB1, 0xf, 0xf, true))));
    v = __builtin_bit_cast(int, fmaxf(__builtin_bit_cast(float, v), __builtin_bit_cast(float, __builtin_amdgcn_update_dpp(v, v, 0x4E, 0xf, 0xf, true))));
    v = __builtin_bit_cast(int, fmaxf(__builtin_bit_cast(float, v), __builtin_bit_cast(float, __builtin_amdgcn_update_dpp(v, v, 0x141, 0xf, 0xf, true))));
    return __builtin_bit_cast(float, v);
}
__device__ __forceinline__ void phase_route(const Frame& F, const In& in, int l, int g0, int g1, const bf16_t* X, const float* MODl, unsigned char* A2, const bool dummy) {
    const int lane = F.lane, w = F.wave, r = lane & 15, q = lane >> 4;
    constexpr int MR = 48;
    LAS float* part = (LAS float*)F.lds;
    LAS float* plog = part + 8 * MR;
    LAS float* G = plog + 8 * MR * 64;
    LAS int* cntw = (LAS int*)(G + 80 * 64);
    LAS float* rk = (LAS float*)(cntw + 8 * 64) + w * 64;
    const bf16_t* WRH = (const bf16_t*)(F.ws + O_WR) + (size_t)l * 2 * 64 * D; const bf16_t* WRL = WRH + 64 * D;
    const float* ng = in.norm_g + (l * 2 + 1) * D + 128 * w + 8 * q;
    const float brl = in.b_router[l * 64 + lane];
    unsigned* cnt = (unsigned*)(F.ws + O_CTL) + CW_CNT + (dummy ? 2 : l) * 64;
    unsigned char* tb = F.ws + (dummy ? O_Y : O_ROUTE);
    int* dest = (int*)(tb + R_DEST); int* list = (int*)(tb + R_LIST); float* gtk = (float*)(tb + R_GTK);
    if (F.vcu == 0 && w == 0) { GAS u32x4* z = (GAS u32x4*)(A2 + (size_t)ZROW * D); z[lane] = (u32x4){0u, 0u, 0u, 0u}; }
    const bf16_t* wl0 = WRL + (size_t)r * D + 128 * w + 8 * q;
    int mycnt = 0;
    const int myg = g1 - g0;
    for (int m0 = 0; m0 < myg; m0 += 3) {
        const int ng3 = min(3, myg - m0);
        int grp3[3];
#pragma unroll
        for (int gi = 0; gi < 3; ++gi) grp3[gi] = g0 + m0 + min(gi, ng3 - 1);
        {
            u32x4 xw[3][4];
#pragma unroll
            for (int gi = 0; gi < 3; ++gi) { const bf16_t* xr = X + (size_t)(grp3[gi] * 16 + r) * D + 128 * w + 8 * q;
#pragma unroll
                for (int ks = 0; ks < 4; ++ks) xw[gi][ks] = *(const u32x4*)(xr + 32 * ks); }
#pragma unroll
            for (int gi = 0; gi < 3; ++gi) { float ss = 0.f;
#pragma unroll
                for (int ks = 0; ks < 4; ++ks) { const u32x4 a = xw[gi][ks];
#pragma unroll
                    for (int j = 0; j < 4; ++j) { const float lo = bflo(a[j]), hi = bfhi(a[j]); ss += lo * lo + hi * hi; } }
                ss += __shfl_xor(ss, 16); ss += __shfl_xor(ss, 32);
                if (q == 0) part[w * MR + gi * 16 + r] = ss; }
        }
        __syncthreads();
        {
            bf16x8 bh[4][4];
            { const bf16_t* wh0 = WRH + (size_t)r * D + 128 * w + 8 * q; asm volatile("" : "+v"(wh0));
#pragma unroll
              for (int ks = 0; ks < 4; ++ks)
#pragma unroll
                for (int nf = 0; nf < 4; ++nf) bh[ks][nf] = *(const bf16x8*)(wh0 + (size_t)(16 * nf) * D + 32 * ks); }
            float rstd[3]; f32x4 acc[3][4];
#pragma unroll
            for (int gi = 0; gi < 3; ++gi) { float tot = 0.f;
#pragma unroll
                for (int j = 0; j < 8; ++j) tot += part[j * MR + gi * 16 + r];
                rstd[gi] = rsqrtf(tot * (1.f / D) + EPS);
#pragma unroll
                for (int nf = 0; nf < 4; ++nf) acc[gi][nf] = (f32x4){0.f, 0.f, 0.f, 0.f}; }
#pragma unroll
            for (int ks = 0; ks < 4; ++ks) {
                const int co = 32 * ks;
                const f32x4 g0 = *(const f32x4*)(ng + co), g1 = *(const f32x4*)(ng + co + 4);
                bf16x8 blf[4];
#pragma unroll
                for (int nf = 0; nf < 4; ++nf) blf[nf] = *(const bf16x8*)(wl0 + (size_t)(16 * nf) * D + co);
#pragma unroll
                for (int gi = 0; gi < 3; ++gi) {
                    const int row = grp3[gi] * 16 + r;
                    const bf16_t* xr = X + (size_t)row * D + 128 * w + 8 * q;
                    const float* sh = MODl + (size_t)ci_of_row(grp3[gi] * 16) * 6144 + 3 * D + 128 * w + 8 * q;
                    const u32x4 xwv = *(const u32x4*)(xr + co);
                    const f32x4 xa = (f32x4){bflo(xwv.x), bfhi(xwv.x), bflo(xwv.y), bfhi(xwv.y)}, xb = (f32x4){bflo(xwv.z), bfhi(xwv.z), bflo(xwv.w), bfhi(xwv.w)};
                    const f32x4 s0 = *(const f32x4*)(sh + co), s1 = *(const f32x4*)(sh + co + 4), c0 = *(const f32x4*)(sh + D + co), c1 = *(const f32x4*)(sh + D + co + 4);
                    const f32x4 h0 = xa * rstd[gi] * g0 * (1.f + c0) + s0, h1 = xb * rstd[gi] * g1 * (1.f + c1) + s1;
                    unsigned hb[8]; float hl[8];
#pragma unroll
                    for (int j = 0; j < 4; ++j) { hb[j] = f2bf(h0[j]); hl[j] = h0[j] - __builtin_bit_cast(float, hb[j] << 16); hb[j + 4] = f2bf(h1[j]); hl[j + 4] = h1[j] - __builtin_bit_cast(float, hb[j + 4] << 16); }
                    u32x4 hw; hw.x = hb[0] | (hb[1] << 16); hw.y = hb[2] | (hb[3] << 16); hw.z = hb[4] | (hb[5] << 16); hw.w = hb[6] | (hb[7] << 16);
                    u32x4 lw; lw.x = pk2(hl[0], hl[1]); lw.y = pk2(hl[2], hl[3]); lw.z = pk2(hl[4], hl[5]); lw.w = pk2(hl[6], hl[7]);
                    {
                        float c8[8];
#pragma unroll
                        for (int j = 0; j < 4; ++j) { c8[j] = __builtin_amdgcn_fmed3f(h0[j], -448.f, 448.f); c8[j + 4] = __builtin_amdgcn_fmed3f(h1[j], -448.f, 448.f); }
                        int a = __builtin_amdgcn_cvt_pk_fp8_f32(c8[0], c8[1], 0, false); a = __builtin_amdgcn_cvt_pk_fp8_f32(c8[2], c8[3], a, true);
                        int b = __builtin_amdgcn_cvt_pk_fp8_f32(c8[4], c8[5], 0, false); b = __builtin_amdgcn_cvt_pk_fp8_f32(c8[6], c8[7], b, true);
                        *(u32x2*)(A2 + (size_t)row * D + 128 * w + co + 8 * q) = (u32x2){(unsigned)a, (unsigned)b};
                    }
                    const bf16x8 ah = __builtin_bit_cast(bf16x8, hw), al = __builtin_bit_cast(bf16x8, lw);
#pragma unroll
                    for (int nf = 0; nf < 4; ++nf) {
                        acc[gi][nf] = __builtin_amdgcn_mfma_f32_16x16x32_bf16(ah, bh[ks][nf], acc[gi][nf], 0, 0, 0);
                        acc[gi][nf] = __builtin_amdgcn_mfma_f32_16x16x32_bf16(ah, blf[nf], acc[gi][nf], 0, 0, 0);
                        acc[gi][nf] = __builtin_amdgcn_mfma_f32_16x16x32_bf16(al, bh[ks][nf], acc[gi][nf], 0, 0, 0);
                    }
                }
            }
#pragma unroll
            for (int gi = 0; gi < 3; ++gi)
#pragma unroll
                for (int nf = 0; nf < 4; ++nf)
#pragma unroll
                    for (int g = 0; g < 4; ++g) plog[(w * MR + gi * 16 + 4 * q + g) * 64 + 16 * nf + r] = acc[gi][nf][g];
        }
        __syncthreads();
        for (int rr = w; rr < ng3 * 16; rr += 8) {
            float lgt = 0.f;
#pragma unroll
            for (int j = 0; j < 8; ++j) lgt += plog[(j * MR + rr) * 64 + lane];
            const float s = 1.f / (1.f + __expf(-lgt));
            const float b = s + brl;
            const unsigned ub = __float_as_uint(b);
            const unsigned key0 = (((ub & 0x80000000u) ? ~ub : (ub | 0x80000000u)) & ~63u) | (unsigned)(63 - lane);
            const unsigned k1 = grp8_umax(key0);
            const float b1 = grp8_fmax(b);
            const float b2 = grp8_fmax(key0 == k1 ? -INFINITY : b);
            const float gs = b1 + b2; const int g = lane >> 3;
            int grank = 0;
#pragma unroll
            for (int g2 = 0; g2 < 8; ++g2) { const float v = __builtin_bit_cast(float, __builtin_amdgcn_readlane(__builtin_bit_cast(int, gs), g2 * 8)); grank += (v > gs || (v == gs && g2 < g)) ? 1 : 0; }
            unsigned cur = grank < 4 ? key0 : 0u; bool sel = false;
#pragma unroll 1
            for (int it8 = 0; it8 < 8; ++it8) {
                unsigned gm = grp8_umax(cur);
                gm = max(gm, (unsigned)__builtin_amdgcn_update_dpp((int)gm, (int)gm, 0x128  , 0xf, 0xf, true));
                const unsigned mx = max(max((unsigned)__builtin_amdgcn_readlane((int)gm, 0), (unsigned)__builtin_amdgcn_readlane((int)gm, 16)),
                                        max((unsigned)__builtin_amdgcn_readlane((int)gm, 32), (unsigned)__builtin_amdgcn_readlane((int)gm, 48)));
                if (cur == mx) { sel = true; cur = 0u; }
            }
            const float ssum = __ockl_wfred_add_f32(sel ? s : 0.f);
            G[(m0 * 16 + rr) * 64 + lane] = sel ? s / ssum * 2.5f : 0.f;
            mycnt += sel ? 1 : 0;
        }
    }
    cntw[w * 64 + lane] = mycnt;
    __syncthreads();
    if (w == 0) {
        int tot = 0;
#pragma unroll
        for (int j = 0; j < 8; ++j) tot += cntw[j * 64 + lane];
        int base = 0;
        if (tot > 0) base = (int)__hip_atomic_fetch_add(cnt + lane, (unsigned)tot, __ATOMIC_RELAXED, __HIP_MEMORY_SCOPE_AGENT);
#pragma unroll
        for (int j = 0; j < 8; ++j) { const int cj = cntw[j * 64 + lane]; cntw[j * 64 + lane] = base; base += cj; }
    }
    __syncthreads();
    {
        int pos = cntw[w * 64 + lane];
        for (int m0 = 0; m0 < myg; m0 += 3) {
            const int ng3 = min(3, myg - m0);
            for (int rr = w; rr < ng3 * 16; rr += 8) {
                const float gt = G[(m0 * 16 + rr) * 64 + lane];
                const bool sel = gt != 0.f;
                const unsigned long long m = __ballot(sel);
                const int k = __popcll(m & ((1ull << lane) - 1ull));
                if (sel) { const int tok = (g0 + m0 + (rr >> 4)) * 16 + (rr & 15);
                    list[(size_t)lane * ECAP + pos] = tok; gtk[tok * 8 + k] = gt; dest[tok * 8 + k] = (int)((unsigned)lane << 20 | (unsigned)pos); ++pos; }
            }
        }
    }
    __syncthreads();
}

struct MoeTables { LAS int* cnt; LAS int* tp; LAS int* off; };
__device__ __forceinline__ MoeTables moe_tables(const Frame& F, int l) {
    MoeTables mt; mt.cnt = (LAS int*)(F.lds + LDSX_OFF); mt.tp = mt.cnt + 64; mt.off = mt.tp + 80;
    const unsigned* cnt = (const unsigned*)(F.ws + O_CTL) + CW_CNT + l * 64;
    __syncthreads();
    if (F.tid < 64) {
        const int c = (int)__hip_atomic_load(cnt + F.tid, __ATOMIC_RELAXED, __HIP_MEMORY_SCOPE_AGENT);
        mt.cnt[F.tid] = c;
        int t = (c + 255) >> 8, o = c;
#pragma unroll
        for (int d = 1; d < 64; d <<= 1) { const int t2 = __shfl_up(t, d), o2 = __shfl_up(o, d); if (F.tid >= d) { t += t2; o += o2; } }
        mt.tp[F.tid + 1] = t; mt.off[F.tid + 1] = o;
        if (F.tid == 0) { mt.tp[0] = 0; mt.off[0] = 0; }
    }
    __syncthreads();
    return mt;
}
__device__ __forceinline__ int moe_find_expert(const MoeTables& mt, int tile) {
    int lo = 0, hi = 64;
#pragma unroll
    for (int it = 0; it < 6; ++it) { const int mid = (lo + hi) >> 1; if (mt.tp[mid] <= tile) lo = mid; else hi = mid; }
    return __builtin_amdgcn_readfirstlane(lo);
}
struct MoeUpSched {
    MoeTables mt; const char* WGU; const char* WSGU; const int* list; int G, vcu, nshared_pm;
    __device__ __forceinline__ bool next(int i, GUnit& u) const {
        int L = i * G + vcu;
        const int ntr = __builtin_amdgcn_readfirstlane(mt.tp[64]);
        if (L < 2 * ntr) {
            const int tile = L >> 1, pn = L & 1, e = moe_find_expert(mt, tile);
            const int j = tile - __builtin_amdgcn_readfirstlane(mt.tp[e]), c = __builtin_amdgcn_readfirstlane(mt.cnt[e]), o = __builtin_amdgcn_readfirstlane(mt.off[e]);
            u.Bp = WGU + ((size_t)e * 512 + pn * 256) * D; u.rows = list + (size_t)e * ECAP + 256 * j; u.arow0 = 0; u.orow0 = o + 256 * j;
            u.nvalid = min(256, c - 256 * j); u.pn = pn; u.e = e; return true;
        }
        L -= 2 * ntr;
        const int pm = L >> 1, pn = L & 1;
        if (pm >= nshared_pm) return false;
        u.Bp = WSGU + (size_t)pn * 256 * D; u.rows = nullptr; u.arow0 = pm * 256; u.orow0 = pm * 256; u.nvalid = 256; u.pn = pn; u.e = 64; return true;
    }
    __device__ __forceinline__ void done(const GUnit&, int) const {}
};
struct EpiSwigluMoe {
    static constexpr bool PERM = true;
    bf16_t* act; bf16_t* acts;
    __device__ __forceinline__ void operator()(const Acc& acc, const GUnit& u, int wr, int wc, int fr, int fq) const {
        EpiSwiglu E{u.e == 64 ? acts : act}; E(acc, u, wr, wc, fr, fq);
    }
};
constexpr int SH_SLOT0 = NR * 8;
struct MoeDownSched {
    MoeTables mt; const char* WD; const char* WSD; int G, vcu, nshared_pm;
    __device__ __forceinline__ bool next(int i, GUnit& u) const {
        int L = i * G + vcu;
        const int ntr = __builtin_amdgcn_readfirstlane(mt.tp[64]);
        if (L < 4 * ntr) {
            const int tile = L >> 2, pn = L & 3, e = moe_find_expert(mt, tile);
            const int j = tile - __builtin_amdgcn_readfirstlane(mt.tp[e]), c = __builtin_amdgcn_readfirstlane(mt.cnt[e]), o = __builtin_amdgcn_readfirstlane(mt.off[e]);
            u.Bp = WD + ((size_t)e * D + pn * 256) * 256 * 2; u.rows = nullptr; u.arow0 = o + 256 * j; u.orow0 = o + 256 * j;
            u.nvalid = min(256, c - 256 * j); u.pn = pn; u.e = e; return true;
        }
        L -= 4 * ntr;
        const int pm = L >> 2, pn = L & 3;
        if (pm >= nshared_pm) return false;
        u.Bp = WSD + (size_t)pn * 256 * 256 * 2; u.rows = nullptr; u.arow0 = (int)((O_ACTS - O_ACT) / 512) + pm * 256; u.orow0 = SH_SLOT0 + pm * 256; u.nvalid = 256; u.pn = pn; u.e = 64; return true;
    }
    __device__ __forceinline__ void done(const GUnit&, int) const {}
};
constexpr float YSCALE = 16.f, YINV = 1.f / 16.f;
struct EpiFp8 {
    static constexpr bool PERM = true;
    unsigned char* O;
    __device__ __forceinline__ void operator()(const Acc& acc, const GUnit& u, int wr, int wc, int fr, int fq) const {
        const int odd = fq & 1;
        const int col0 = u.pn * BM + wc * 32 + 16 * (fq >> 1);
#pragma unroll
        for (int ai = 0; ai < 2; ++ai)
#pragma unroll
            for (int mp = 0; mp < 2; ++mp) {
                const int r = ai * HALF + wr * 64 + (2 * mp + odd) * 16 + fr;
#pragma unroll
                for (int bj = 0; bj < 2; ++bj) {
                    int w[2][2];
#pragma unroll
                    for (int mm = 0; mm < 2; ++mm) { f32x4 v0 = acc[ai][bj][2 * mp + mm][0] * YSCALE, v1 = acc[ai][bj][2 * mp + mm][1] * YSCALE;
#pragma unroll
                        for (int c = 0; c < 4; ++c) { v0[c] = __builtin_amdgcn_fmed3f(v0[c], -448.f, 448.f); v1[c] = __builtin_amdgcn_fmed3f(v1[c], -448.f, 448.f); }
                        int a = __builtin_amdgcn_cvt_pk_fp8_f32(v0[0], v0[1], 0, false); a = __builtin_amdgcn_cvt_pk_fp8_f32(v0[2], v0[3], a, true);
                        int b = __builtin_amdgcn_cvt_pk_fp8_f32(v1[0], v1[1], 0, false); b = __builtin_amdgcn_cvt_pk_fp8_f32(v1[2], v1[3], b, true);
                        w[mm][0] = a; w[mm][1] = b; }
                    const int s0 = odd ? w[0][0] : w[1][0], s1 = odd ? w[0][1] : w[1][1];
                    const int g0 = __shfl_xor(s0, 16), g1 = __shfl_xor(s1, 16);
                    const int k0 = odd ? w[1][0] : w[0][0], k1 = odd ? w[1][1] : w[0][1];
                    const u32x4 o = odd ? (u32x4){(unsigned)g0, (unsigned)g1, (unsigned)k0, (unsigned)k1} : (u32x4){(unsigned)k0, (unsigned)k1, (unsigned)g0, (unsigned)g1};
                    if (r < u.nvalid) *(u32x4*)(O + (size_t)(u.orow0 + r) * D + col0 + bj * HALF) = o;
                }
            }
    }
};
__device__ __forceinline__ void phase_combine(const Frame& F, int l, int nrows, bf16_t* X, const float* MODl, const unsigned char* Y, float* out_final, const float* gfin,
                                              bf16_t* nxtA, const float* nxt_g, const float* nxt_MOD) {
    const MoeTables mt = moe_tables(F, l);
    const int gw = F.vcu * NWAVES + F.wave, NGW = F.G * NWAVES, lane = F.lane;
    if (nxtA && gw == 0) { GAS u32x4* z = (GAS u32x4*)(nxtA + (size_t)ZROW * D); z[lane] = (u32x4){0u, 0u, 0u, 0u}; z[lane + 64] = (u32x4){0u, 0u, 0u, 0u}; }
    const int* dest = (const int*)(F.ws + O_ROUTE + R_DEST); const float* gtk = (const float*)(F.ws + O_ROUTE + R_GTK);
    int dvn = 0; float gvn = 0.f;
    if (gw < nrows) { dvn = dest[gw * 8 + (lane & 7)]; gvn = gtk[gw * 8 + (lane & 7)]; }
    for (int row = gw; row < nrows; row += NGW) {
        const int dv = dvn; const float gv = gvn;
        if (row + NGW < nrows) { dvn = dest[(row + NGW) * 8 + (lane & 7)]; gvn = gtk[(row + NGW) * 8 + (lane & 7)]; }
        const int sl = mt.off[(dv >> 20) & 63] + (dv & 0xfffff);
        float s[16];
#pragma unroll
        for (int i = 0; i < 16; ++i) s[i] = 0.f;
#pragma unroll
        for (int k = 0; k < 8; ++k) {
            const int slot = __builtin_amdgcn_readlane(sl, k);
            const float gk = __builtin_bit_cast(float, __builtin_amdgcn_readlane(__builtin_bit_cast(int, gv), k));
            const u32x4 a = *(const u32x4*)(Y + (size_t)slot * D + 16 * lane);
            const float gs = gk * YINV;
#pragma unroll
            for (int j = 0; j < 4; ++j) { const f32x2 lo = __builtin_amdgcn_cvt_pk_f32_fp8((int)a[j], false), hi = __builtin_amdgcn_cvt_pk_f32_fp8((int)a[j], true);
                s[4 * j] += gs * lo.x; s[4 * j + 1] += gs * lo.y; s[4 * j + 2] += gs * hi.x; s[4 * j + 3] += gs * hi.y; }
        }
        {
            const u32x4 a = *(const u32x4*)(Y + (size_t)(SH_SLOT0 + row) * D + 16 * lane);
#pragma unroll
            for (int j = 0; j < 4; ++j) { const f32x2 lo = __builtin_amdgcn_cvt_pk_f32_fp8((int)a[j], false), hi = __builtin_amdgcn_cvt_pk_f32_fp8((int)a[j], true);
                s[4 * j] += YINV * lo.x; s[4 * j + 1] += YINV * lo.y; s[4 * j + 2] += YINV * hi.x; s[4 * j + 3] += YINV * hi.y; }
        }
        const float* g5 = MODl + (size_t)ci_of_row(row) * 6144 + 5 * D + 16 * lane;
        bf16_t* xp = X + (size_t)row * D + 16 * lane;
        const u32x4 xw0 = *(const u32x4*)xp, xw1 = *(const u32x4*)(xp + 8);
        const unsigned xwu[8] = {xw0.x, xw0.y, xw0.z, xw0.w, xw1.x, xw1.y, xw1.z, xw1.w};
        f32x4 xv[4]; float ss = 0.f;
#pragma unroll
        for (int j = 0; j < 4; ++j) { const f32x4 g = *(const f32x4*)(g5 + 4 * j);
            const unsigned wa = xwu[2 * j], wb = xwu[2 * j + 1];
            f32x4 x = (f32x4){bflo(wa), bfhi(wa), bflo(wb), bfhi(wb)};
            x[0] += g[0] * s[4 * j]; x[1] += g[1] * s[4 * j + 1]; x[2] += g[2] * s[4 * j + 2]; x[3] += g[3] * s[4 * j + 3]; xv[j] = x;
            ss += (x[0] * x[0] + x[1] * x[1]) + (x[2] * x[2] + x[3] * x[3]); }
        if (out_final) {
            const float rstd = rsqrtf(wave_sum(ss) * (1.f / D) + EPS);
#pragma unroll
            for (int j = 0; j < 4; ++j) { const f32x4 g = *(const f32x4*)(gfin + 16 * lane + 4 * j); *(f32x4*)(out_final + (size_t)row * D + 16 * lane + 4 * j) = xv[j] * rstd * g; }
        } else {
            { u32x4 o0, o1; o0.x = cvt_pk_bf16(xv[0][0], xv[0][1]); o0.y = cvt_pk_bf16(xv[0][2], xv[0][3]); o0.z = cvt_pk_bf16(xv[1][0], xv[1][1]); o0.w = cvt_pk_bf16(xv[1][2], xv[1][3]);
              o1.x = cvt_pk_bf16(xv[2][0], xv[2][1]); o1.y = cvt_pk_bf16(xv[2][2], xv[2][3]); o1.z = cvt_pk_bf16(xv[3][0], xv[3][1]); o1.w = cvt_pk_bf16(xv[3][2], xv[3][3]);
              *(u32x4*)xp = o0; *(u32x4*)(xp + 8) = o1; }
            if (nxtA) {
                const float rstd = rsqrtf(wave_sum(ss) * (1.f / D) + EPS);
                const float* sh = nxt_MOD + (size_t)ci_of_row(row) * 6144 + 16 * lane;
                u32x4 o[2];
#pragma unroll
                for (int j = 0; j < 4; ++j) { const f32x4 g = *(const f32x4*)(nxt_g + 16 * lane + 4 * j), s0 = *(const f32x4*)(sh + 4 * j), c0 = *(const f32x4*)(sh + D + 4 * j);
                    const f32x4 h = xv[j] * rstd * g * (1.f + c0) + s0;
                    o[j >> 1][(j & 1) * 2] = pk2(h[0], h[1]); o[j >> 1][(j & 1) * 2 + 1] = pk2(h[2], h[3]); }
                *(u32x4*)(nxtA + (size_t)row * D + 16 * lane) = o[0]; *(u32x4*)(nxtA + (size_t)row * D + 16 * lane + 8) = o[1];
            }
        }
    }
}
__device__ __forceinline__ void phase_moe_up(const Frame& F, const In& in, int l, int nrows) {
    const MoeTables mt = moe_tables(F, l);
    MoeUpSched S{mt, (const char*)(F.ws + O_WGU), (const char*)(F.ws + O_WSGU) + (size_t)l * 512 * D, (const int*)(F.ws + O_ROUTE + R_LIST), F.G, F.vcu, nrows / 256};
    EpiSwigluMoe E{(bf16_t*)(F.ws + O_ACT), (bf16_t*)(F.ws + O_ACTS)};
    gemm_phase<EpiSwigluMoe, MoeUpSched, 1, 124>(F.lds, (const char*)(F.ws + O_A2), D, S, E);
    if (l == 0) {
        const int nu = 2 * __builtin_amdgcn_readfirstlane(mt.tp[64]) + 2 * (nrows / 256), rem = nu % F.G;
        __syncthreads();
        phase_cvt_down(F, in, 1, rem, F.G - rem);
    }
}
__device__ __forceinline__ void phase_moe_down(const Frame& F, const In& in, int l, int nrows) {
    const MoeTables mt = moe_tables(F, l);
    MoeDownSched S{mt, (const char*)(F.ws + (l == 0 ? O_WD : O_WD1)), (const char*)(F.ws + O_WSD) + (size_t)l * D * 256 * 2, F.G, F.vcu, nrows / 256};
    EpiFp8 E{F.ws + O_Y};
    gemm_phase(F.lds, (const char*)(F.ws + O_ACT), 256, S, E);
    if (l == 0) {
        const int nu = 4 * __builtin_amdgcn_readfirstlane(mt.tp[64]) + 4 * (nrows / 256), rem = nu % F.G;
        __syncthreads();
        cvt_wgu_part(F, in, 1, 0, CVT32_ITEMS / 3, rem, F.G - rem, 0);
    }
}
__device__ __forceinline__ f32x2 gelu_pk(f32x2 v) {
    const f32x2 av = __builtin_elementwise_abs(v), d = av * 0.2316418882f + 1.0f;
    f32x2 t; t.x = __builtin_amdgcn_rcpf(d.x); t.y = __builtin_amdgcn_rcpf(d.y);
    f32x2 q = t * 0.5307027145f + (-0.7265760135f); q = q * t + 0.7107068705f; q = q * t + (-0.142248368f); q = q * t + 0.127414796f; q = q * t;
    const f32x2 s = (v * v) * (-0.72134752044f);
    f32x2 e; e.x = __builtin_amdgcn_exp2f(s.x); e.y = __builtin_amdgcn_exp2f(s.y);
    const f32x2 m = v * (q * e), r = v - m;
    f32x2 o; o.x = v.x < 0.f ? m.x : r.x; o.y = v.y < 0.f ? m.y : r.y; return o;
}
struct EpiZ {
    static constexpr bool PERM = true;
    bf16_t* O; int ldc, n_gelu, s_lo, s_hi;
    __device__ __forceinline__ void operator()(const Acc& acc, const GUnit& u, int wr, int wc, int fr, int fq) const {
        const int col0 = u.pn * BM + wc * 32 + 8 * fq;
        const int mode = u.pn < n_gelu ? 1 : ((u.pn >= s_lo && u.pn < s_hi) ? 2 : 0);
#pragma unroll
        for (int ai = 0; ai < 2; ++ai)
#pragma unroll
            for (int m = 0; m < 4; ++m) {
                bf16_t* rowp = O + (size_t)(u.orow0 + ai * HALF + wr * 64 + m * 16 + fr) * ldc + col0;
#pragma unroll
                for (int bj = 0; bj < 2; ++bj) { f32x4 v0 = acc[ai][bj][m][0], v1 = acc[ai][bj][m][1];
                    if (mode == 1) { const f32x2 a = gelu_pk((f32x2){v0[0], v0[1]}), b = gelu_pk((f32x2){v0[2], v0[3]}), c = gelu_pk((f32x2){v1[0], v1[1]}), d = gelu_pk((f32x2){v1[2], v1[3]});
                        v0 = (f32x4){a.x, a.y, b.x, b.y}; v1 = (f32x4){c.x, c.y, d.x, d.y}; }
                    else if (mode == 2) { v0 = v0 * C2; v1 = v1 * C2; }
                    u32x4 w; w.x = cvt_pk_bf16(v0[0], v0[1]); w.y = cvt_pk_bf16(v0[2], v0[3]); w.z = cvt_pk_bf16(v1[0], v1[1]); w.w = cvt_pk_bf16(v1[2], v1[3]);
                    *(u32x4*)(rowp + bj * HALF) = w; }
            }
    }
};

__device__ __forceinline__ void phase_sg(const Frame& F, const In& in, const bf16_t* Z1, bf16_t* CAT) {
    constexpr int VTS = 272;
    LAS unsigned char* VT = F.lds;
    const bf16_t* SGW = (const bf16_t*)(F.ws + O_SGW);
    const int lane = F.lane, w = F.wave;
    for (int it = F.vcu; it < NB * 16 * 2; it += F.G) {
        const int half = it & 1, chunk = (it >> 1) & 15, b = it >> 5;
        const size_t row0 = (size_t)b * T + chunk * 128;
        const int p = 16 * w + (lane & 15), kq = lane >> 4;
        bf16x8 wf[4][4]; u32x2 uu[4][4]; float bs[4];
#pragma unroll
        for (int gl = 0; gl < 4; ++gl) { const int g = 4 * half + gl; bs[gl] = in.sg_b[g * 128 + p];
#pragma unroll
            for (int ks = 0; ks < 4; ++ks) wf[gl][ks] = *(const bf16x8*)(SGW + ((size_t)g * 128 + p) * 128 + 32 * ks + 8 * kq);
#pragma unroll
            for (int nf = 0; nf < 4; ++nf) uu[gl][nf] = *(const u32x2*)(Z1 + (row0 + p) * 2560 + g * 64 + nf * 16 + 4 * kq); }
        __syncthreads();
        float lg4[4], lb4[4];
#pragma unroll
        for (int e = 0; e < 4; ++e) { lg4[e] = in.sg_ln_g[lane + 64 * e + 256 * half]; lb4[e] = in.sg_ln_b[lane + 64 * e + 256 * half]; }
#pragma unroll 1
        for (int rb = 0; rb < 16; rb += 4) {
            float raw[4][8];
#pragma unroll
            for (int j = 0; j < 4; ++j) { const bf16_t* vr = Z1 + (row0 + 16 * w + rb + j) * 2560 + 512;
#pragma unroll
                for (int e = 0; e < 8; ++e) raw[j][e] = bf2f(vr[lane + 64 * e]); }
#pragma unroll
            for (int j = 0; j < 4; ++j) {
                const int q = 16 * w + rb + j;
                float v[8]; float s = 0.f;
#pragma unroll
                for (int e = 0; e < 8; e += 2) { const f32x2 gg = gelu_pk((f32x2){raw[j][e], raw[j][e + 1]}); v[e] = gg.x; v[e + 1] = gg.y; s += gg.x + gg.y; }
                const float mu = wave_sum(s) * (1.f / 512.f);
                float s2 = 0.f;
#pragma unroll
                for (int e = 0; e < 8; ++e) { v[e] -= mu; s2 += v[e] * v[e]; }
                const float rstd = rsqrtf(wave_sum(s2) * (1.f / 512.f) + EPS);
                if (half) {
#pragma unroll
                    for (int e = 0; e < 4; ++e) *(LAS bf16_t*)(VT + (lane + 64 * e) * VTS + q * 2) = (bf16_t)f2bf(v[e + 4] * rstd * lg4[e] + lb4[e]);
                } else {
#pragma unroll
                    for (int e = 0; e < 4; ++e) *(LAS bf16_t*)(VT + (lane + 64 * e) * VTS + q * 2) = (bf16_t)f2bf(v[e] * rstd * lg4[e] + lb4[e]);
                }
            }
        }
        __syncthreads();
#pragma unroll
        for (int gl = 0; gl < 4; ++gl) {
            const int g = 4 * half + gl;
            f32x4 acc[4];
#pragma unroll
            for (int nf = 0; nf < 4; ++nf) acc[nf] = (f32x4){0.f, 0.f, 0.f, 0.f};
#pragma unroll
            for (int ks = 0; ks < 4; ++ks)
#pragma unroll
                for (int nf = 0; nf < 4; ++nf) {
                    const bf16x8 vf = *(const LAS bf16x8*)(VT + (gl * 64 + nf * 16 + (lane & 15)) * VTS + (32 * ks + 8 * kq) * 2);
                    acc[nf] = __builtin_amdgcn_mfma_f32_16x16x32_bf16(vf, wf[gl][ks], acc[nf], 0, 0, 0);
                }
#pragma unroll
            for (int nf = 0; nf < 4; ++nf) {
                const int c = g * 64 + nf * 16 + 4 * kq;
                const f32x2 u01 = gelu_pk((f32x2){bflo(uu[gl][nf].x), bfhi(uu[gl][nf].x)}), u23 = gelu_pk((f32x2){bflo(uu[gl][nf].y), bfhi(uu[gl][nf].y)});
                u32x2 o; o.x = pk2(u01.x * (acc[nf][0] + bs[gl]), u01.y * (acc[nf][1] + bs[gl])); o.y = pk2(u23.x * (acc[nf][2] + bs[gl]), u23.y * (acc[nf][3] + bs[gl]));
                *(u32x2*)(CAT + (row0 + p) * D + c) = o;
            }
        }
    }
    __syncthreads();
}

struct NaHook {
    const LAS float* rpbl;
    int nA, rs_lo, r, c, hi; unsigned vmask;
    __device__ __forceinline__ void init() {
        const int cs = min(max(c - 8, 0), 48); unsigned m = 0u;
#pragma unroll
        for (int i = 0; i < 16; ++i) { const int kc = ab::crow(i, hi); if (kc >= cs && kc < cs + 16) m |= 1u << i; if (kc + 32 >= cs && kc + 32 < cs + 16) m |= 1u << (16 + i); }
        vmask = m;
    }
    __device__ __forceinline__ void operator()(ab::f32x16& p0, ab::f32x16& p1, int t) const {
        if (t < nA) return;
        const int R = rs_lo + (t - nA);
        const int rs = min(max(r - 4, 0), 24);
        if (R < rs || R >= rs + 8) {
#pragma unroll
            for (int i = 0; i < 16; ++i) { p0[i] = -INFINITY; p1[i] = -INFINITY; }
            return;
        }
        const LAS float* tb = rpbl + ((R - r + 7) * 31 - c + 15 + 4 * hi);
#pragma unroll
        for (int i0 = 0; i0 < 16; i0 += 8) {
            float b[8];
#pragma unroll
            for (int i = 0; i < 8; ++i) b[i] = tb[((i0 + i) & 3) + 8 * ((i0 + i) >> 2)];
#pragma unroll
            for (int i = 0; i < 8; ++i) p0[i0 + i] = ((vmask >> (i0 + i)) & 1u) ? p0[i0 + i] + b[i] : -INFINITY;
            asm volatile("" ::: "memory");
#pragma unroll
            for (int i = 0; i < 8; ++i) b[i] = tb[32 + ((i0 + i) & 3) + 8 * ((i0 + i) >> 2)];
#pragma unroll
            for (int i = 0; i < 8; ++i) p1[i0 + i] = ((vmask >> (16 + i0 + i)) & 1u) ? p1[i0 + i] + b[i] : -INFINITY;
            asm volatile("" ::: "memory");
        }
    }
};
__device__ __forceinline__ void phase_na(const Frame& F, const In& in, char* shm, const bf16_t* Z1, bf16_t* CAT) {
    LAS float* rpbl = (LAS float*)(F.lds + LDSX_OFF + 4096);
    constexpr int CV0 = (2 * CVT32_ITEMS) / 3;
    if ((F.vcu & 1) == 0) cvt_wgu_part(F, in, 1, CV0, CVT32_ITEMS, 0, F.G, ATTN_CVT_SCR);
    for (int u = F.vcu; u < 512; u += F.G) {
        const int rg = u & 7, h = (u >> 3) & 7, b = u >> 6, r0 = 4 * rg;
        const int rs_lo = min(max(r0 - 4, 0), 24);
        const int nnb = (rg == 0 || rg == 7) ? 8 : 12;
        __syncthreads();
        for (int i = F.tid; i < 15 * 31; i += NTHREADS) rpbl[i] = in.na_rpb[h * 465 + i] * 1.4426950408889634f;
        __syncthreads();
        const size_t row0 = (size_t)b * T + r0 * 64;
        ab::TileMap tm{4, NLAT + b * NC, b * T + rs_lo * 64};
        NaHook hook{rpbl, 4, rs_lo, r0 + (F.wave >> 1), (F.wave & 1) * 32 + (F.lane & 31), F.lane >> 5, 0u}; hook.init();
        ab::attn_unit<8, NaHook>(Z1 + row0 * 2560 + 1024 + h * 64, 2560, Z1 + 1536 + h * 64, Z1 + 2048 + h * 64, 2560, tm, 4 + nnb,
                                 CAT + row0 * D + 512 + h * 64, D, shm, hook);
    }
    if (F.vcu & 1) { __syncthreads(); cvt_wgu_part(F, in, 1, CV0, CVT32_ITEMS, 0, F.G, ATTN_CVT_SCR); }
}

__device__ __forceinline__ void phase_adaln(const Frame& F, const In& in, float* MOD) {
    LAS float* sc = (LAS float*)F.lds;
    LAS float* red = sc + 9 * 1024;
    for (int i = F.tid; i < 9 * 1024; i += NTHREADS) { const float x = i < 8 * 1024 ? in.c[i] : in.c_ctx[i - 8 * 1024]; sc[i] = x / (1.f + __expf(-x)); }
    __syncthreads();
    const int ks = F.tid >> 6, cl = F.tid & 63;
    for (int it = F.vcu; it < 2 * 96; it += F.G) {
        const int l = it / 96, c0 = (it % 96) * 64;
        const float* w = in.w_ada + (size_t)l * D * 6144 + c0 + cl;
        float acc[9];
#pragma unroll
        for (int j = 0; j < 9; ++j) acc[j] = 0.f;
#pragma unroll 8
        for (int k = ks * 128; k < ks * 128 + 128; ++k) { const float wv = w[(size_t)k * 6144];
#pragma unroll
            for (int j = 0; j < 9; ++j) acc[j] += sc[j * 1024 + k] * wv; }
        __syncthreads();
#pragma unroll
        for (int j = 0; j < 9; ++j) red[(ks * 9 + j) * 64 + cl] = acc[j];
        __syncthreads();
        for (int o = F.tid; o < 9 * 64; o += NTHREADS) { const int j = o >> 6, cc = o & 63; float s = in.b_ada[l * 6144 + c0 + cc];
#pragma unroll
            for (int q = 0; q < 8; ++q) s += red[(q * 9 + j) * 64 + cc];
            MOD[((size_t)l * 9 + j) * 6144 + c0 + cc] = s; }
    }
    __syncthreads();
}
enum Phase { PH_INIT = 0, PH_NORM0, PH_IN0, PH_PREP0, PH_ATTN0, PH_OUT0, PH_ROUTE0, PH_UP0, PH_DOWN0, PH_COMB0,
             PH_IN1, PH_MIX1, PH_OUT1, PH_ROUTE1, PH_UP1, PH_DOWN1, PH_COMB1, PH_COUNT };

__global__ void __launch_bounds__(NTHREADS, 2) mk_fwd(Args args) {
    extern __shared__ __attribute__((aligned(16))) unsigned char lds_raw[];
    Frame F;
    F.lds = (LAS unsigned char*)lds_raw; F.ws = args.ws;
    F.tid = threadIdx.x; F.lane = F.tid & 63; F.wave = __builtin_amdgcn_readfirstlane(F.tid >> 6);
    F.G = gridDim.x; { const int bx = blockIdx.x; F.vcu = (F.G % 8 == 0) ? (bx % 8) * (F.G / 8) + bx / 8 : bx; }
    volatile LAS unsigned* MISC = (volatile LAS unsigned*)(F.lds + MISC_OFF);
    for (int u = F.tid; u < (LDS_BYTES - MISC_OFF) / 4; u += NTHREADS) ((LAS unsigned*)(F.lds + MISC_OFF))[u] = 0u;
    __syncthreads();
    gu32* ctl = (gu32*)(args.ws + O_CTL);
    const bool multi = (args.ph_hi - args.ph_lo) > 1;
    XcdBarrier bar; bar.bar = (unsigned*)(ctl + CW_BAR) + args.li * XCD_BAR_WORDS; bar.x = 0; bar.st = nullptr;
    if (multi) bar = xcd_barrier_post((unsigned*)(ctl + CW_BAR) + args.li * XCD_BAR_WORDS, MISC + 8);
    typedef const __attribute__((address_space(4))) Args* ArgK;
    ArgK argp = (ArgK)__builtin_amdgcn_kernarg_segment_ptr();
    const int lo = args.ph_lo, hi = args.ph_hi;
    const bool dummy = args.pad != 0;
#define IN(k) (lo <= (k) && (k) < hi)
#define SEAM(k) do { if (IN((k) + 1)) xcd_barrier(bar); } while (0)

#if defined(__HIP_DEVICE_COMPILE__)
#define LOADARGS_() const Args al = *argp
#else
#define LOADARGS_() const Args al = args
#endif
#define LOADIN() LOADARGS_(); const In& inl = al.in; F.ws = al.ws; \
    float* const MOD = (float*)(al.ws + O_MOD); bf16_t* const X = (bf16_t*)(al.ws + O_X); \
    bf16_t* const A = (bf16_t*)(al.ws + O_A); bf16_t* const Z = (bf16_t*)(al.ws + O_Z); bf16_t* const CAT = (bf16_t*)(al.ws + O_CAT); \
    const float* const ZEROG = (const float*)(al.ws + O_CTL + 512 * 1024); (void)MOD; (void)X; (void)A; (void)Z; (void)CAT; (void)ZEROG
    if (IN(PH_INIT)) { LOADIN(); phase_adaln(F, inl, MOD); phase_cvt_mixer(F, inl); SEAM(PH_INIT); }
#define RELAUNDER() do { int t_ = threadIdx.x; asm volatile("" : "+v"(t_)); F.tid = t_; F.lane = t_ & 63; F.wave = __builtin_amdgcn_readfirstlane(t_ >> 6); int v_ = F.vcu; asm volatile("" : "+s"(v_)); F.vcu = v_; argp = (ArgK)__builtin_amdgcn_kernarg_segment_ptr(); asm volatile("" : "+s"(argp)); } while (0)
#define PH_IN(l, p1) \
    if (IN(p1)) { RELAUNDER(); LOADIN(); \
        DenseSched S{(const char*)(al.ws + (l == 0 ? O_WINAB : O_WINCD)), D, NR / 256, l == 0 ? 7 : 10, F.G, F.vcu, l == 0 ? NR / 256 : NLAT / 256, l == 0 ? 0 : 6}; \
        EpiZ E{Z, l == 0 ? 1792 : 2560, 0, 4, l == 0 ? 0 : 6}; \
        gemm_phase(F.lds, (const char*)A, D, S, E); \
        if (l == 1) { const int nu_ = 64 * 10 + 8 * 4, rem_ = nu_ % F.G; __syncthreads(); cvt_wgu_part(F, inl, 1, CVT32_ITEMS / 3, (2 * CVT32_ITEMS) / 3, rem_, F.G - rem_, 0); }     \
        SEAM(p1); }
#define PH_OUT_MOE(l, pb, nrows) \
    if (IN(pb)) { RELAUNDER(); LOADIN(); \
        const int gg_ = (l == 0 && F.G == 256) ? 144 : F.G;     \
        DenseSched S{(const char*)(al.ws + (l == 0 ? O_WOUTAB : O_WOUTCD)), D, (nrows) / 256, D / 256, gg_, F.vcu, (nrows) / 256, 0}; \
        EpiResid E{inl.x, inl.ctx, l == 0 ? nullptr : X, X, ((dummy && l == 1) ? ZEROG : MOD + (size_t)l * 9 * 6144) + 2 * D}; \
        gemm_phase(F.lds, (const char*)CAT, D, S, E); \
        if (l == 0) { __syncthreads(); const int c0_ = F.G == 256 ? 144 : 0; phase_cvt_down(F, inl, 0, c0_, F.G - c0_); __syncthreads(); cvt_wgu_part(F, inl, 0, 0, CVT32_ITEMS, c0_, F.G - c0_, 0); }     \
        SEAM(pb); } \
    if (IN(pb + 1)) { RELAUNDER(); LOADIN(); \
        const int ng_ = (nrows) / 16; const int g0 = (int)(((long)F.vcu * ng_) / F.G), g1 = (int)(((long)(F.vcu + 1) * ng_) / F.G); \
        phase_route(F, inl, l, g0, g1, X, MOD + (size_t)l * 9 * 6144, al.ws + O_A2, dummy);     \
        SEAM(pb + 1); } \
    if (IN(pb + 2)) { RELAUNDER(); LOADIN(); phase_moe_up(F, inl, l, nrows); SEAM(pb + 2); } \
    if (IN(pb + 3)) { RELAUNDER(); LOADIN(); phase_moe_down(F, inl, l, nrows); SEAM(pb + 3); } \
    if (IN(pb + 4)) { RELAUNDER(); LOADIN(); phase_combine(F, l, nrows, X, dummy ? ZEROG : MOD + (size_t)l * 9 * 6144, (const unsigned char*)(al.ws + O_Y), l == 1 ? al.out : nullptr, inl.g_final, l == 0 ? A : nullptr, inl.norm_g + 2 * D, MOD + (size_t)9 * 6144); \
        SEAM(pb + 4); }

    if (IN(PH_NORM0)) { RELAUNDER(); LOADIN(); phase_normmod(F, inl.x, inl.ctx, inl.norm_g, MOD, 0, A, NR); SEAM(PH_NORM0); }
    PH_IN(0, PH_IN0)
    if (IN(PH_PREP0)) { RELAUNDER(); LOADIN();
        phase_conv0(F, inl, Z, CAT);
        if (!dummy) phase_qkv0(F, inl, Z, (bf16_t*)(al.ws + O_Q), (bf16_t*)(al.ws + O_K), (bf16_t*)(al.ws + O_V));
        SEAM(PH_PREP0); }
    if (IN(PH_ATTN0)) { RELAUNDER(); LOADIN();
        phase_attn0(F, inl, (char*)lds_raw, (const bf16_t*)(al.ws + O_Q), (const bf16_t*)(al.ws + O_K), (const bf16_t*)(al.ws + O_V), CAT);
        SEAM(PH_ATTN0); }
    PH_OUT_MOE(0, PH_OUT0, NR)
    PH_IN(1, PH_IN1)
    if (IN(PH_MIX1)) { RELAUNDER(); LOADIN(); phase_sg(F, inl, Z, CAT); phase_na(F, inl, (char*)lds_raw, Z, CAT); SEAM(PH_MIX1); }
    PH_OUT_MOE(1, PH_OUT1, NLAT)
#undef IN
#undef SEAM
}

static int g_grid = 0;
inline bool mk_init() {
    if (g_grid != 0) return g_grid > 0;
    int dev = 0, cus = 0, per_cu = 0;
    if (hipGetDevice(&dev) != hipSuccess || hipDeviceGetAttribute(&cus, hipDeviceAttributeMultiprocessorCount, dev) != hipSuccess) { g_grid = -1; return false; }
    if (hipFuncSetAttribute((const void*)mk_fwd, hipFuncAttributeMaxDynamicSharedMemorySize, LDS_BYTES) != hipSuccess) { fprintf(stderr, "hipFuncSetAttribute failed\n"); g_grid = -1; return false; }
    if (hipOccupancyMaxActiveBlocksPerMultiprocessor(&per_cu, (const void*)mk_fwd, NTHREADS, LDS_BYTES) != hipSuccess || per_cu < 1) { fprintf(stderr, "occupancy query: %d\n", per_cu); (void)hipGetLastError(); per_cu = 1; }
    if (cus != 256) { fprintf(stderr, "kernel_launch: built for a 256-CU MI355X (one workgroup per CU); this device reports %d CUs; nothing launched\n", cus); g_grid = -1; return false; }
    g_grid = cus;
    return true;
}
inline void mk_launch(hipStream_t st, const In& in, float* out, unsigned char* ws, int lo, int hi, int li, int dummy = 0) {
    Args a{}; a.in = in; a.out = out; a.ws = ws; a.ph_lo = lo; a.ph_hi = hi; a.li = li; a.pad = dummy;
    hipLaunchKernelGGL(mk_fwd, dim3(g_grid), dim3(NTHREADS), LDS_BYTES, st, a);
}
}
extern "C" void kernel_launch(void* const* d_in, const int* in_sizes, int n_in, void* d_out, int out_size, void* d_ws, size_t ws_size, hipStream_t stream) {
    if (n_in != 31 || ws_size < mk::O_END) { fprintf(stderr, "kernel_launch: unexpected n_in %d / ws %zu\n", n_in, ws_size); return; }
    if (!mk::mk_init()) return;
    mk::In min; const float** q = (const float**)&min;
    for (int i = 0; i < 31; ++i) q[i] = (const float*)d_in[i];
    unsigned char* ws = (unsigned char*)d_ws;
    (void)hipMemsetAsync(ws + mk::O_CTL, 0, 1 << 20, stream);
    mk::mk_launch(stream, min, (float*)d_out, ws, 0, mk::PH_COUNT, 0);
}
```

```cpp
#include <hip/hip_runtime.h>
#include <hip/hip_bf16.h>
#include <cstdio>
#include <cstdint>
#include <cmath>
extern "C" __device__ float __ockl_wfred_max_f32(float);
extern "C" __device__ float __ockl_wfred_add_f32(float);
namespace mk {
#define LAS __attribute__((address_space(3)))
#define GAS __attribute__((address_space(1)))
typedef unsigned short bf16_t;
typedef short bf16x8 __attribute__((ext_vector_type(8)));
typedef float f32x4 __attribute__((ext_vector_type(4)));
typedef float f32x2 __attribute__((ext_vector_type(2)));
typedef unsigned u32x4 __attribute__((ext_vector_type(4)));
typedef unsigned u32x2 __attribute__((ext_vector_type(2)));
typedef GAS unsigned gu32;
#define RLX_AGENT __ATOMIC_RELAXED, __HIP_MEMORY_SCOPE_AGENT
#define LDS_WAIT() asm volatile("s_waitcnt lgkmcnt(0)" ::: "memory")
#define VM_WAIT() asm volatile("s_waitcnt vmcnt(0)" ::: "memory")

constexpr int D = 1024, NB = 8, T = 2048, NC = 256, NLAT = NB * T, NCTX = NB * NC, NR = NLAT + NCTX, KEYS = T + NC;
constexpr int ZROW = NR;
constexpr float EPS = 1e-6f;
constexpr int NWAVES = 8, NTHREADS = 512;
constexpr int ECAP = NR;
constexpr float C2 = 0.125f * 1.4426950408889634f;

constexpr size_t MiB = 1ull << 20;
constexpr size_t O_X = 0;
constexpr size_t O_ROUTE = 72 * MiB;
constexpr size_t O_WD = 82 * MiB;
constexpr size_t O_ACT = 114 * MiB;
constexpr size_t O_ACTS = 187 * MiB;
constexpr size_t O_Y = 196 * MiB;
constexpr size_t O_A = 120 * MiB;
constexpr size_t O_Z = 157 * MiB;
constexpr size_t O_CAT = 247 * MiB;
constexpr size_t O_Q = 283 * MiB;
constexpr size_t O_K = 301 * MiB;
constexpr size_t O_V = 319 * MiB;
constexpr size_t O_A2 = 340 * MiB;
constexpr size_t O_WD1 = 464 * MiB;
constexpr size_t O_WGU = 400 * MiB;
constexpr size_t O_MOD = 500 * MiB;
constexpr size_t O_CTL = 509 * MiB;
constexpr size_t O_WINAB = 510 * MiB;
constexpr size_t O_WOUTAB = 514 * MiB;
constexpr size_t O_WINCD = 516 * MiB;
constexpr size_t O_WOUTCD = 521 * MiB;
constexpr size_t O_WR = 523 * MiB;
constexpr size_t O_WSGU = 524 * MiB;
constexpr size_t O_WSD = 526 * MiB;
constexpr size_t O_SGW = 527 * MiB;
constexpr size_t O_END = 528 * MiB;
constexpr size_t R_DEST = 0;
constexpr size_t R_LIST = 1 * MiB;
constexpr size_t R_GTK = 5 * MiB + MiB / 2;
static_assert(R_LIST + (size_t)64 * ECAP * 4 <= R_GTK && R_GTK + (size_t)NR * 8 * 4 <= 10 * MiB, "route map");
constexpr int CW_TMO = 0;
constexpr int CW_CNT = 64;
constexpr int CW_BAR = 4096;

constexpr int RING_BYTES = 131072;
constexpr int LDSX_OFF = RING_BYTES;
constexpr int MISC_OFF = RING_BYTES + 12288;
constexpr int LDS_BYTES = 147456;

__device__ __forceinline__ unsigned f2bf(float f) { unsigned u = __builtin_bit_cast(unsigned, f); return (u + 0x7fffu + ((u >> 16) & 1u)) >> 16; }
__device__ __forceinline__ unsigned pk2(float lo, float hi) { return f2bf(lo) | (f2bf(hi) << 16); }
__device__ __forceinline__ float bf2f(unsigned short b) { return __builtin_bit_cast(float, (unsigned)b << 16); }
__device__ __forceinline__ float bflo(unsigned w) { return __builtin_bit_cast(float, w << 16); }
__device__ __forceinline__ float bfhi(unsigned w) { return __builtin_bit_cast(float, w & 0xffff0000u); }
__device__ __forceinline__ float wave_sum(float v) { return __ockl_wfred_add_f32(v); }
__device__ __forceinline__ float fast_sigmoid(float x) { return __builtin_amdgcn_rcpf(1.f + __builtin_amdgcn_exp2f(-1.4426950408889634f * x)); }
__device__ __forceinline__ float fast_silu(float x) { return x * fast_sigmoid(x); }
__device__ __forceinline__ int ci_of_row(int row) { return row < NLAT ? row / T : 8; }

#define XB_TMO      128
#define XB_XCNT(j)  (256  + 64 * (j))
#define XB_XSUB(j)  (1280 + 64 * (j))
#define XB_XGEN(j)  (2304 + 64 * (j))
#define XB_TOP      3328
#define XB_TOPGEN   3392
#define XCD_BAR_WORDS 3456
#define XB_SPIN_CAP (1u << 18)
__device__ __forceinline__ unsigned xb_ld(unsigned* p)              { return __hip_atomic_load(p, __ATOMIC_RELAXED, __HIP_MEMORY_SCOPE_AGENT); }
__device__ __forceinline__ unsigned xb_add(unsigned* p, unsigned v) { return __hip_atomic_fetch_add(p, v, __ATOMIC_RELAXED, __HIP_MEMORY_SCOPE_AGENT); }
__device__ __forceinline__ unsigned xb_xcc_id() { return (unsigned)__builtin_amdgcn_s_getreg((3 << 11) | 20) & 0xFu; }
#define XB_SPIN(cond, bar) do { unsigned _sp = 0; while (cond) { __builtin_amdgcn_s_sleep(1); \
    if ((++_sp & 255u) == 0u) { if (xb_ld(&(bar)[XB_TMO])) break; if (_sp > XB_SPIN_CAP) { atomicAdd(&(bar)[XB_TMO], 1u); break; } } } } while (0)
struct XcdBarrier { unsigned* bar; unsigned x; volatile LAS unsigned* st; };
__device__ __forceinline__ XcdBarrier xcd_barrier_post(unsigned* bar, volatile LAS unsigned* st) {
    XcdBarrier b; b.bar = bar; b.x = xb_xcc_id(); b.st = st;
    if (threadIdx.x == 0) (void)xb_add(&bar[XB_XCNT(b.x)], 1u);
    return b;
}
__device__ __forceinline__ void xcd_barrier_complete(unsigned* bar, unsigned x, unsigned& nloc, unsigned& nx) {
    const unsigned G = gridDim.x * gridDim.y * gridDim.z;
    unsigned sum, cnt, mine, sp = 0u;
    for (;;) {
        sum = 0u; cnt = 0u; mine = 0u;
#pragma unroll
        for (unsigned j = 0; j < 16; ++j) { const unsigned c = xb_ld(&bar[XB_XCNT(j)]); sum += c; cnt += (c > 0u) ? 1u : 0u; mine = (j == x) ? c : mine; }
        if (sum == G) break;
        __builtin_amdgcn_s_sleep(1);
        if ((++sp & 255u) == 0u) { if (xb_ld(&bar[XB_TMO])) break; if (sp > XB_SPIN_CAP) { atomicAdd(&bar[XB_TMO], 1u); break; } }
    }
    nloc = mine > 0u ? mine : 1u; nx = cnt > 0u ? cnt : 1u;
}
__device__ __forceinline__ void xcd_barrier(const XcdBarrier& b) {
    asm volatile("s_waitcnt vmcnt(0)" ::: "memory");
    __syncthreads();
    if (threadIdx.x == 0) {
        unsigned* bar = b.bar;
        __builtin_amdgcn_s_waitcnt(0);
        unsigned nloc = b.st[0], nx = b.st[1];
        if (nloc == 0u) { xcd_barrier_complete(bar, b.x, nloc, nx); b.st[0] = nloc; b.st[1] = nx; }
        const unsigned old = xb_add(&bar[XB_XSUB(b.x)], 1u);
        const unsigned gen = old / nloc;
        if (old + 1u == (gen + 1u) * nloc) {
            __builtin_amdgcn_fence(__ATOMIC_RELEASE, "agent");
            asm volatile("s_waitcnt vmcnt(0)" ::: "memory");
            const unsigned og = xb_add(&bar[XB_TOP], 1u);
            const unsigned tg = og / nx;
            if (og + 1u == (tg + 1u) * nx) xb_add(&bar[XB_TOPGEN], 1u);
            else XB_SPIN(xb_ld(&bar[XB_TOPGEN]) == tg, bar);
            __builtin_amdgcn_fence(__ATOMIC_ACQUIRE, "agent");
            xb_add(&bar[XB_XGEN(b.x)], 1u);
            asm volatile("s_waitcnt vmcnt(0)" ::: "memory");
        } else {
            XB_SPIN(xb_ld(&bar[XB_XGEN(b.x)]) == gen, bar);
            __builtin_amdgcn_fence(__ATOMIC_ACQUIRE, "agent");
            asm volatile("s_waitcnt vmcnt(0)" ::: "memory");
        }
    }
    __syncthreads();
}

struct In {
    const float *x, *c, *ctx, *c_ctx, *norm_g, *w_ada, *b_ada, *w_in_ab, *w_out_ab, *conv_w, *conv_b, *conv_ln_g, *conv_ln_b, *qn_g, *kn_g,
        *w_in_cd, *w_out_cd, *sg_ln_g, *sg_ln_b, *sg_w, *sg_b, *na_rpb, *w_router, *b_router, *w_gate, *w_up, *w_down, *ws_gate, *ws_up, *ws_down, *g_final;
};
struct Args { In in; float* out; unsigned char* ws; int ph_lo, ph_hi, li, pad; };
struct Frame {
    LAS unsigned char* lds;
    unsigned char* ws;
    int tid, lane, wave, vcu, G;
};

typedef int i32x8 __attribute__((ext_vector_type(8)));
typedef int i32x4 __attribute__((ext_vector_type(4)));
__device__ __forceinline__ i32x8 cat8(bf16x8 a, bf16x8 b) { return __builtin_shufflevector(__builtin_bit_cast(i32x4, a), __builtin_bit_cast(i32x4, b), 0, 1, 2, 3, 4, 5, 6, 7); }
constexpr int BM = 256, BK = 64, HALF = 128, HTB = HALF * BK * 2, STAGE_BYTES = 8 * HTB;
__device__ __forceinline__ int lds_byte(int r, int c) { const int st = (r >> 4) * 2 + (c >> 5), rr = r & 15, cc = c & 31, ob = rr * 64 + cc * 2; return st * 1024 + (ob ^ (((ob >> 9) & 1) << 5)); }
__device__ __forceinline__ void stage_rc(int b, int& R, int& C) { const int st = b / 1024, sb = b % 1024, swz = sb ^ (((sb >> 9) & 1) << 5); R = (st >> 1) * 16 + swz / 64; C = (st & 1) * 32 + (swz % 64) / 2; }
__device__ __forceinline__ int perm32(int rho) { const int n = rho >> 4, i = rho & 15; return 8 * (i >> 2) + 4 * n + (i & 3); }
__device__ __forceinline__ unsigned cvt_pk_bf16(float lo, float hi) { unsigned r; asm volatile("v_cvt_pk_bf16_f32 %0, %1, %2" : "=v"(r) : "v"(lo), "v"(hi)); return r; }

struct GUnit {
    const char* Bp;
    const int* rows;
    int arow0;
    int orow0;
    int nvalid;
    int pn;
    int e;
};
typedef f32x4 Acc[2][2][4][2];

template <class Epi, class Sched, int ES = 2, int SCB = 127>
__device__ __forceinline__ void gemm_phase(LAS unsigned char* lds, const char* Abase, const int K, const Sched& S, const Epi& E) {
    int tid = threadIdx.x; asm volatile("" : "+v"(tid));
    const int wid = __builtin_amdgcn_readfirstlane(tid >> 6), lane = tid & 63, wr = wid >> 2, wc = wid & 3, fr = lane & 15, fq = lane >> 4;
    const int nt = K * ES / (BK * 2);
    int R0, C0; stage_rc(tid * 16, R0, C0);
    unsigned voffB[2];
#pragma unroll
    for (int i = 0; i < 2; ++i) { const int R = R0 + 64 * i; const int Rb = Epi::PERM ? ((R & ~31) + perm32(R & 31)) : R; voffB[i] = (unsigned)(Rb * K * ES + C0 * 2); }
    const size_t kstep = (size_t)(BK * 2);
    const size_t hstep = (size_t)HALF * K * ES;
    const unsigned ldsw = (unsigned)wid * 1024u;
    const unsigned ldsbase = (unsigned)(size_t)lds + ldsw;
    const int aoff = lds_byte(wr * 64 + fr, fq * 8), boff = lds_byte(wc * 32 + fr, fq * 8);
#define PG8_SA(b, h) (((b) * 2 + (h)) * HTB)
#define PG8_SB(b, h) ((4 + (b) * 2 + (h)) * HTB)
#define PG8_STAGE2(bufoff, gbase, v0, v1) do { if constexpr (ES == 2) { \
        __builtin_amdgcn_global_load_lds((const unsigned*)((const char*)(gbase) + (v0)), (LAS unsigned*)(lds + (bufoff) + ldsw), 16, 0, 0); \
        __builtin_amdgcn_global_load_lds((const unsigned*)((const char*)(gbase) + (v1)), (LAS unsigned*)(lds + (bufoff) + ldsw + 8192), 16, 0, 0); } else { \
          \
        const unsigned m0a_ = ldsbase + (unsigned)(bufoff); const char* gb_ = (const char*)(gbase); \
        asm volatile("s_mov_b32 m0, %0\n\ts_nop 0\n\tglobal_load_lds_dwordx4 %2, %4\n\ts_mov_b32 m0, %1\n\ts_nop 0\n\tglobal_load_lds_dwordx4 %3, %4" \
                     :: "s"(m0a_), "s"(m0a_ + 8192u), "v"(v0), "v"(v1), "s"(gb_) : "memory"); } } while (0)
#define PG8_STAGEB(bufoff, gbase) PG8_STAGE2(bufoff, gbase, voffB[0], voffB[1])
#define PG8_LDA(dst, b, h) do { _Pragma("unroll") for (int m = 0; m < 4; ++m) _Pragma("unroll") for (int k = 0; k < 2; ++k) dst[m][k] = *(const LAS bf16x8*)(lds + PG8_SA(b, h) + aoff + m * 2048 + k * 1024); } while (0)
#define PG8_LDB(dst, b, h) do { _Pragma("unroll") for (int n = 0; n < 2; ++n) _Pragma("unroll") for (int k = 0; k < 2; ++k) dst[n][k] = *(const LAS bf16x8*)(lds + PG8_SB(b, h) + boff + n * 2048 + k * 1024); } while (0)
#define PG8_MMA(ai, bj, At, Bt) do { __builtin_amdgcn_s_setprio(1); _Pragma("unroll") for (int m = 0; m < 4; ++m) _Pragma("unroll") for (int n = 0; n < 2; ++n) { \
        if constexpr (ES == 2) { _Pragma("unroll") for (int k = 0; k < 2; ++k) acc[ai][bj][m][n] = __builtin_amdgcn_mfma_f32_16x16x32_bf16(Bt[n][k], At[m][k], acc[ai][bj][m][n], 0, 0, 0); } \
        else {   \
            asm volatile("v_mfma_scale_f32_16x16x128_f8f6f4 %0, %1, %2, %0, %3, %3 op_sel_hi:[0,0,0]" : "+v"(acc[ai][bj][m][n]) : "v"(cat8(Bt[n][0], Bt[n][1])), "v"(cat8(At[m][0], At[m][1])), "v"(SCB * 0x01010101)); } } \
        __builtin_amdgcn_s_setprio(0); } while (0)
#define PG8_WAIT_V(n) asm volatile("s_waitcnt vmcnt(" #n ")" ::: "memory")
#define PG8_WAIT_L(n) asm volatile("s_waitcnt lgkmcnt(" #n ")" ::: "memory")
#define PG8_BAR __builtin_amdgcn_s_barrier()
#define PG8_SCHED __builtin_amdgcn_sched_barrier(0)
#define PG8_VOFF(u, vo) do { int R0l_ = R0; asm volatile("" : "+v"(R0l_));   \
        _Pragma("unroll") for (int h_ = 0; h_ < 2; ++h_) _Pragma("unroll") for (int i_ = 0; i_ < 2; ++i_) { const int r_ = h_ * 128 + R0l_ + 64 * i_; \
        int row_; if ((u).rows) { row_ = ZROW; if (r_ < (u).nvalid) row_ = (u).rows[r_]; } else row_ = (u).arow0 + r_; vo[h_][i_] = (unsigned)(row_ * K * ES + C0 * 2); } } while (0)
    GUnit cur, nxt; int ui = 0;
    if (!S.next(0, cur)) return;
    Acc acc;
#pragma unroll
    for (int a = 0; a < 2; ++a)
#pragma unroll
        for (int b = 0; b < 2; ++b)
#pragma unroll
            for (int m = 0; m < 4; ++m)
#pragma unroll
                for (int n = 0; n < 2; ++n) acc[a][b][m][n] = (f32x4){0.f, 0.f, 0.f, 0.f};
    bf16x8 At[4][2], B0[2][2], B1[2][2];
    unsigned vA[2][2], vN[2][2];
    PG8_VOFF(cur, vA);
    const char* cB = cur.Bp;
    const char* const cA = Abase;
    PG8_STAGEB(PG8_SB(0, 0), cB); PG8_STAGEB(PG8_SB(0, 1), cB + hstep); PG8_STAGE2(PG8_SA(0, 0), cA, vA[0][0], vA[0][1]); PG8_STAGE2(PG8_SA(0, 1), cA, vA[1][0], vA[1][1]);
    if (wr == 1) PG8_BAR;
    PG8_WAIT_V(2); PG8_BAR;
    PG8_STAGEB(PG8_SB(1, 0), cB + kstep); PG8_STAGE2(PG8_SA(1, 0), cA + kstep, vA[0][0], vA[0][1]); PG8_STAGEB(PG8_SB(1, 1), cB + hstep + kstep);
    PG8_WAIT_V(6); PG8_BAR;
    for (;;) {
        const bool has_next = S.next(ui + 1, nxt);
        if (has_next) { PG8_VOFF(nxt, vN); }
        else {
#pragma unroll
            for (int h = 0; h < 2; ++h)
#pragma unroll
                for (int i = 0; i < 2; ++i) vN[h][i] = vA[h][i];
        }
        const char* nB = has_next ? nxt.Bp : cB;
#pragma nounroll
        for (int t = 0; t < nt; t += 2) {
            const bool last = (t == nt - 2);
            const char* a1 = cA + (size_t)(t + 1) * kstep;
            const char* a2 = last ? cA : cA + (size_t)(t + 2) * kstep; const char* b2 = last ? nB : cB + (size_t)(t + 2) * kstep;
            const char* a3 = a2 + kstep; const char* b3 = b2 + kstep;
            const unsigned w00 = last ? vN[0][0] : vA[0][0], w01 = last ? vN[0][1] : vA[0][1], w10 = last ? vN[1][0] : vA[1][0], w11 = last ? vN[1][1] : vA[1][1];
            PG8_LDB(B0, 0, 0); PG8_LDB(B1, 0, 1); PG8_SCHED; PG8_LDA(At, 0, 0); PG8_STAGE2(PG8_SA(1, 1), a1, vA[1][0], vA[1][1]);
            PG8_WAIT_V(8); PG8_WAIT_L(0); PG8_BAR; PG8_MMA(0, 0, At, B0); PG8_MMA(0, 1, At, B1); PG8_BAR; PG8_SCHED;
            PG8_LDA(At, 0, 1); PG8_STAGEB(PG8_SB(0, 0), b2); PG8_STAGEB(PG8_SB(0, 1), b2 + hstep); PG8_STAGE2(PG8_SA(0, 0), a2, w00, w01);
            PG8_WAIT_V(8); PG8_WAIT_L(0); PG8_BAR; PG8_MMA(1, 0, At, B0); PG8_MMA(1, 1, At, B1); PG8_BAR; PG8_SCHED;
            PG8_LDB(B0, 1, 0); PG8_LDB(B1, 1, 1); PG8_SCHED; PG8_LDA(At, 1, 0); PG8_STAGE2(PG8_SA(0, 1), a2, w10, w11);
            PG8_WAIT_V(8); PG8_WAIT_L(0); PG8_BAR; PG8_MMA(0, 0, At, B0); PG8_MMA(0, 1, At, B1); PG8_BAR; PG8_SCHED;
            PG8_LDA(At, 1, 1); PG8_STAGEB(PG8_SB(1, 0), b3); PG8_STAGEB(PG8_SB(1, 1), b3 + hstep); PG8_STAGE2(PG8_SA(1, 0), a3, w00, w01);
            PG8_WAIT_V(8); PG8_WAIT_L(0); PG8_BAR; PG8_MMA(1, 0, At, B0); PG8_MMA(1, 1, At, B1); PG8_BAR; PG8_SCHED;
        }
        if constexpr (ES == 1) asm volatile("s_nop 15\n\ts_nop 15" ::: "memory");
        if (wr == 0) PG8_BAR;
        { int tl = tid; asm volatile("" : "+v"(tl));
          E(acc, cur, wr, wc, tl & 15, (tl >> 4) & 3); }
        S.done(cur, lane);
        if (!has_next) break;
#pragma unroll
        for (int a = 0; a < 2; ++a)
#pragma unroll
            for (int b = 0; b < 2; ++b)
#pragma unroll
                for (int m = 0; m < 4; ++m)
#pragma unroll
                    for (int n = 0; n < 2; ++n) acc[a][b][m][n] = (f32x4){0.f, 0.f, 0.f, 0.f};
        cur = nxt; cB = nB; ++ui;
#pragma unroll
        for (int h = 0; h < 2; ++h)
#pragma unroll
            for (int i = 0; i < 2; ++i) vA[h][i] = vN[h][i];
        if (wr == 1) PG8_BAR;
    }
    PG8_WAIT_V(0);
    PG8_BAR;
#undef PG8_SA
#undef PG8_SB
#undef PG8_STAGE2
#undef PG8_STAGEB
#undef PG8_LDA
#undef PG8_LDB
#undef PG8_MMA
#undef PG8_WAIT_V
#undef PG8_WAIT_L
#undef PG8_BAR
#undef PG8_SCHED
#undef PG8_VOFF
}

struct EpiBf16 {
    static constexpr bool PERM = true;
    bf16_t* O; int ldc;
    __device__ __forceinline__ void operator()(const Acc& acc, const GUnit& u, int wr, int wc, int fr, int fq) const {
        const int col0 = u.pn * BM + wc * 32 + 8 * fq;
#pragma unroll
        for (int ai = 0; ai < 2; ++ai)
#pragma unroll
            for (int m = 0; m < 4; ++m) {
                const int r = ai * HALF + wr * 64 + m * 16 + fr;
                if (r < u.nvalid) {
                    bf16_t* rowp = O + (size_t)(u.orow0 + r) * ldc + col0;
#pragma unroll
                    for (int bj = 0; bj < 2; ++bj) { const f32x4 v0 = acc[ai][bj][m][0], v1 = acc[ai][bj][m][1];
                        u32x4 w; w.x = cvt_pk_bf16(v0[0], v0[1]); w.y = cvt_pk_bf16(v0[2], v0[3]); w.z = cvt_pk_bf16(v1[0], v1[1]); w.w = cvt_pk_bf16(v1[2], v1[3]);
                        *(u32x4*)(rowp + bj * HALF) = w; }
                }
            }
    }
};
struct EpiResid {
    static constexpr bool PERM = true;
    const float* blat; const float* bctx; const bf16_t* bx; bf16_t* out; const float* gate;
    __device__ __forceinline__ void operator()(const Acc& acc, const GUnit& u, int wr, int wc, int fr, int fq) const {
        const int col0 = u.pn * BM + wc * 32 + 8 * fq;
        const int ci = ci_of_row(u.orow0);
        const float* basef = u.orow0 < NLAT ? blat + (size_t)u.orow0 * D : bctx + (size_t)(u.orow0 - NLAT) * D;
#pragma unroll
        for (int bj = 0; bj < 2; ++bj) {
            const f32x4 gv0 = *(const f32x4*)(gate + (size_t)ci * 6144 + col0 + bj * HALF), gv1 = *(const f32x4*)(gate + (size_t)ci * 6144 + col0 + bj * HALF + 4);
#pragma unroll
            for (int ai = 0; ai < 2; ++ai)
#pragma unroll
                for (int m = 0; m < 4; ++m) {
                    const int r = ai * HALF + wr * 64 + m * 16 + fr;
                    f32x4 b0, b1;
                    if (bx) { const u32x4 w = *(const u32x4*)(bx + (size_t)(u.orow0 + r) * D + col0 + bj * HALF);
                        b0 = (f32x4){bflo(w.x), bfhi(w.x), bflo(w.y), bfhi(w.y)}; b1 = (f32x4){bflo(w.z), bfhi(w.z), bflo(w.w), bfhi(w.w)}; }
                    else { b0 = *(const f32x4*)(basef + (size_t)r * D + col0 + bj * HALF); b1 = *(const f32x4*)(basef + (size_t)r * D + col0 + bj * HALF + 4); }
                    const f32x4 o0 = b0 + gv0 * acc[ai][bj][m][0], o1 = b1 + gv1 * acc[ai][bj][m][1];
                    u32x4 w; w.x = cvt_pk_bf16(o0[0], o0[1]); w.y = cvt_pk_bf16(o0[2], o0[3]); w.z = cvt_pk_bf16(o1[0], o1[1]); w.w = cvt_pk_bf16(o1[2], o1[3]);
                    *(u32x4*)(out + (size_t)(u.orow0 + r) * D + col0 + bj * HALF) = w;
                    if (m & 1) asm volatile("" ::: "memory");
                }
        }
    }
};
constexpr float ASCALE8 = 8.f;
struct EpiSwiglu {
    static constexpr bool PERM = true;
    unsigned char* O;
    __device__ __forceinline__ void operator()(const Acc& acc, const GUnit& u, int wr, int wc, int fr, int fq) const {
        const int col0 = u.pn * HALF + wc * 32 + 8 * fq;
#pragma unroll
        for (int ai = 0; ai < 2; ++ai)
#pragma unroll
            for (int m = 0; m < 4; ++m) {
                const int r = ai * HALF + wr * 64 + m * 16 + fr;
                if (r < u.nvalid) {
                    const f32x4 g0 = acc[ai][0][m][0], g1 = acc[ai][0][m][1], u0 = acc[ai][1][m][0], u1 = acc[ai][1][m][1];
                    float a[8];
#pragma unroll
                    for (int c = 0; c < 4; ++c) { a[c] = __builtin_amdgcn_fmed3f(fast_silu(g0[c]) * (u0[c] * ASCALE8), -448.f, 448.f); a[c + 4] = __builtin_amdgcn_fmed3f(fast_silu(g1[c]) * (u1[c] * ASCALE8), -448.f, 448.f); }
                    int w0 = __builtin_amdgcn_cvt_pk_fp8_f32(a[0], a[1], 0, false); w0 = __builtin_amdgcn_cvt_pk_fp8_f32(a[2], a[3], w0, true);
                    int w1 = __builtin_amdgcn_cvt_pk_fp8_f32(a[4], a[5], 0, false); w1 = __builtin_amdgcn_cvt_pk_fp8_f32(a[6], a[7], w1, true);
                    *(u32x2*)(O + (size_t)(u.orow0 + r) * 256 + col0) = (u32x2){(unsigned)w0, (unsigned)w1};
                }
            }
    }
};

struct DenseSched {
    const char* Bt; int K; int nM, nN; int G, vcu; int ctx_pm0, ctx_pn0;
    __device__ __forceinline__ bool next(int i, GUnit& u) const {
        if (vcu >= G) return false;
        int L = i * G + vcu;
        const int nfull = ctx_pm0 * nN;
        int pm, pn;
        if (L < nfull) { pm = L / nN; pn = L % nN; }
        else { L -= nfull; const int w = nN - ctx_pn0; pm = ctx_pm0 + L / w; pn = ctx_pn0 + L % w; if (pm >= nM) return false; }
        u.Bp = Bt + (size_t)pn * 256 * K * 2; u.rows = nullptr; u.arow0 = pm * 256; u.orow0 = pm * 256; u.nvalid = 256; u.pn = pn; u.e = 0;
        return true;
    }
    __device__ __forceinline__ void done(const GUnit&, int) const {}
};

__device__ __forceinline__ void cvt_item(const float* W, int N, int k0, int n0, bf16_t* WT, int K, int drow0, LAS float* scr, int lane) {
#pragma unroll 8
    for (int i = 0; i < 32; ++i) { const int kk = 2 * i + (lane >> 5); scr[kk * 33 + (lane & 31)] = W[(size_t)(k0 + kk) * N + n0 + (lane & 31)]; }
    LDS_WAIT(); asm volatile("" ::: "memory");
    const int c = lane & 7;
#pragma unroll
    for (int j = 0; j < 4; ++j) { const int n = (lane >> 3) + 8 * j; const LAS float* s = scr + (8 * c) * 33 + n;
        u32x4 o; o.x = pk2(s[0 * 33], s[1 * 33]); o.y = pk2(s[2 * 33], s[3 * 33]); o.z = pk2(s[4 * 33], s[5 * 33]); o.w = pk2(s[6 * 33], s[7 * 33]);
        *(GAS u32x4*)(WT + (size_t)(drow0 + n) * K + k0 + 8 * c) = o; }
    LDS_WAIT(); asm volatile("" ::: "memory");
}
constexpr float WSCALE8 = 64.f;
__device__ __forceinline__ void cvt_item8(const float* W, int N, int k0, int n0, unsigned char* WT, int K, int drow0, LAS float* scr, int lane) {
#pragma unroll 8
    for (int i = 0; i < 32; ++i) { const int kk = 2 * i + (lane >> 5); scr[kk * 33 + (lane & 31)] = W[(size_t)(k0 + kk) * N + n0 + (lane & 31)]; }
    LDS_WAIT(); asm volatile("" ::: "memory");
    const int c = lane & 3;
#pragma unroll
    for (int j = 0; j < 2; ++j) { const int n = (lane >> 2) + 16 * j; const LAS float* s = scr + (16 * c) * 33 + n;
        u32x4 o;
#pragma unroll
        for (int q = 0; q < 4; ++q) { float x[4];
#pragma unroll
            for (int t = 0; t < 4; ++t) x[t] = __builtin_amdgcn_fmed3f(s[(4 * q + t) * 33] * WSCALE8, -448.f, 448.f);
            int a = __builtin_amdgcn_cvt_pk_fp8_f32(x[0], x[1], 0, false); a = __builtin_amdgcn_cvt_pk_fp8_f32(x[2], x[3], a, true); o[q] = (unsigned)a; }
        *(GAS u32x4*)(WT + (size_t)(drow0 + n) * K + k0 + 16 * c) = o; }
    LDS_WAIT(); asm volatile("" ::: "memory");
}
__device__ __forceinline__ bool cvt_job(int& r, const float* W, int K, int N, bf16_t* WT, LAS float* scr, int lane) {
    const int nblk = N / 32, items = (K / 64) * nblk;
    if (r >= items) { r -= items; return false; }
    const int kb = r / nblk, nb = r % nblk;
    cvt_item(W, N, kb * 64, nb * 32, WT, K, nb * 32, scr, lane);
    return true;
}
__device__ __forceinline__ void phase_cvt_mixer(const Frame& F, const In& in) {
    LAS float* scr = (LAS float*)(F.lds + F.wave * 16384);
    const int gw = F.vcu * NWAVES + F.wave, NGW = F.G * NWAVES;
    constexpr int I_AB = 16 * 56, I_O = 16 * 32, I_CD = 16 * 80;
    constexpr int NITEMS = I_AB + I_O + I_CD + I_O;
    for (int it = gw; it < NITEMS; it += NGW) {
        int r = it;
        if (cvt_job(r, in.w_in_ab, D, 1792, (bf16_t*)(F.ws + O_WINAB), scr, F.lane)) continue;
        if (cvt_job(r, in.w_out_ab, D, D, (bf16_t*)(F.ws + O_WOUTAB), scr, F.lane)) continue;
        if (cvt_job(r, in.w_in_cd, D, 2560, (bf16_t*)(F.ws + O_WINCD), scr, F.lane)) continue;
        cvt_job(r, in.w_out_cd, D, D, (bf16_t*)(F.ws + O_WOUTCD), scr, F.lane);
    }
    bf16_t* sg = (bf16_t*)(F.ws + O_SGW);
    for (int i = (F.vcu * NTHREADS + F.tid) * 4; i < 8 * 128 * 128; i += F.G * NTHREADS * 4) {
        const f32x4 v = *(const f32x4*)(in.sg_w + i);
        u32x2 o; o.x = pk2(v[0], v[1]); o.y = pk2(v[2], v[3]);
        *(u32x2*)(sg + i) = o;
    }
}
__device__ __forceinline__ void phase_cvt_down(const Frame& F, const In& in, int l, int cu0, int ncu) {
    if (F.vcu < cu0 || F.vcu >= cu0 + ncu) return;
    LAS float* scr = (LAS float*)(F.lds + F.wave * 16384);
    const int gw = (F.vcu - cu0) * NWAVES + F.wave, NGW = ncu * NWAVES;
    constexpr int I_DN = 4 * 32, N_R = 64 * I_DN;
    unsigned char* WD = F.ws + (l == 0 ? O_WD : O_WD1); unsigned char* WSD = F.ws + O_WSD + (size_t)l * D * 256;
    for (int it = gw; it < N_R + 128; it += NGW) {
        int r = it;
        if (r < N_R) { const int e = r / I_DN, q = r % I_DN, kb = q / 32, nb = q % 32;
            cvt_item8(in.w_down + ((size_t)l * 64 + e) * 256 * D, D, kb * 64, nb * 32, WD + (size_t)e * D * 256, 256, nb * 32, scr, F.lane); continue; }
        r -= N_R;
        { const int kb = r / 32, nb = r % 32; cvt_item8(in.ws_down + (size_t)l * 256 * D, D, kb * 64, nb * 32, WSD, 256, nb * 32, scr, F.lane); }
    }
}

struct CvtDesc { const float* W; unsigned char* WT; int N, k0, n0, drow0, router; };
constexpr int CVT32_GU = 64 * 256;
constexpr int CVT32_ITEMS = 2 * CVT32_GU + 2 * 256 + 64;
__device__ __forceinline__ CvtDesc cvt32_desc(const In& in, unsigned char* ws, int l, int it) {
    CvtDesc d; d.router = 0;
    int r = it;
    if (r < 2 * CVT32_GU) {
        const int up = r >= CVT32_GU; if (up) r -= CVT32_GU;
        const int e = r >> 8, q = r & 255, kb = q >> 3, nb = q & 7;
        d.W = (up ? in.w_up : in.w_gate) + ((size_t)l * 64 + e) * D * 256; d.N = 256; d.k0 = kb * 32; d.n0 = nb * 32;
        d.WT = ws + O_WGU; d.drow0 = e * 512 + (d.n0 / 128) * 256 + up * 128 + (d.n0 % 128);
        return d;
    }
    r -= 2 * CVT32_GU;
    if (r < 512) {
        const int up = r >= 256; if (up) r -= 256;
        const int kb = r >> 3, nb = r & 7;
        d.W = (up ? in.ws_up : in.ws_gate) + (size_t)l * D * 256; d.N = 256; d.k0 = kb * 32; d.n0 = nb * 32;
        d.WT = ws + O_WSGU + (size_t)l * 512 * D; d.drow0 = (d.n0 / 128) * 256 + up * 128 + (d.n0 % 128);
        return d;
    }
    r -= 512;
    d.W = in.w_router + (size_t)l * D * 64; d.N = 64; d.k0 = (r >> 1) * 32; d.n0 = (r & 1) * 32;
    d.WT = ws + O_WR + (size_t)l * 2 * 64 * D * 2; d.router = 1; d.drow0 = d.n0;
    return d;
}
constexpr int CVB = 8;
__device__ __forceinline__ void cvt_range(const Frame& F, const In& in, int l, int it0, int it1, int scr_base) {
    LAS float* scr = (LAS float*)(F.lds + scr_base + F.wave * 4224);
    const int lane = F.lane, lk = lane >> 3, ln4 = (lane & 7) * 4;
    for (int ib = it0 + CVB * F.wave; ib < it1; ib += CVB * NWAVES) {
        CvtDesc d[CVB]; f32x4 v[CVB][4];
#pragma unroll
        for (int b = 0; b < CVB; ++b) { d[b] = cvt32_desc(in, F.ws, l, min(ib + b, it1 - 1));
#pragma unroll
            for (int i = 0; i < 4; ++i) v[b][i] = *(const f32x4*)(d[b].W + (size_t)(d[b].k0 + lk + 8 * i) * d[b].N + d[b].n0 + ln4); }
#pragma unroll
        for (int b = 0; b < CVB; ++b) {
            if (ib + b < it1) {
#pragma unroll
                for (int i = 0; i < 4; ++i) { LAS float* sp = scr + (lk + 8 * i) * 33 + ln4; sp[0] = v[b][i][0]; sp[1] = v[b][i][1]; sp[2] = v[b][i][2]; sp[3] = v[b][i][3]; }
                LDS_WAIT(); asm volatile("" ::: "memory");
                if (d[b].router) {
#pragma unroll
                    for (int j = 0; j < 2; ++j) { const int t = lane + 64 * j, n = t >> 2, c = t & 3; const LAS float* sp = scr + (8 * c) * 33 + n;
                        float x[8];
#pragma unroll
                        for (int q = 0; q < 8; ++q) x[q] = sp[q * 33];
                        u32x4 o; o.x = cvt_pk_bf16(x[0], x[1]); o.y = cvt_pk_bf16(x[2], x[3]); o.z = cvt_pk_bf16(x[4], x[5]); o.w = cvt_pk_bf16(x[6], x[7]);
                        bf16_t* wt = (bf16_t*)d[b].WT + (size_t)(d[b].drow0 + n) * D + d[b].k0 + 8 * c;
                        *(GAS u32x4*)wt = o;
                        u32x4 p; p.x = cvt_pk_bf16(x[0] - bflo(o.x), x[1] - bfhi(o.x)); p.y = cvt_pk_bf16(x[2] - bflo(o.y), x[3] - bfhi(o.y));
                        p.z = cvt_pk_bf16(x[4] - bflo(o.z), x[5] - bfhi(o.z)); p.w = cvt_pk_bf16(x[6] - bflo(o.w), x[7] - bfhi(o.w));
                        *(GAS u32x4*)(wt + 64 * D) = p; }
                } else {
                    const int n = lane >> 1, c = lane & 1; const LAS float* sp = scr + (16 * c) * 33 + n;
                    float x[16];
#pragma unroll
                    for (int q = 0; q < 16; ++q) x[q] = __builtin_amdgcn_fmed3f(sp[q * 33] * WSCALE8, -448.f, 448.f);
                    u32x4 o;
#pragma unroll
                    for (int q = 0; q < 4; ++q) { int a = __builtin_amdgcn_cvt_pk_fp8_f32(x[4 * q], x[4 * q + 1], 0, false); a = __builtin_amdgcn_cvt_pk_fp8_f32(x[4 * q + 2], x[4 * q + 3], a, true); o[q] = (unsigned)a; }
                    *(GAS u32x4*)(d[b].WT + (size_t)(d[b].drow0 + n) * D + d[b].k0 + 16 * c) = o;
                }
                LDS_WAIT(); asm volatile("" ::: "memory");
            }
        }
    }
}
__device__ __forceinline__ void cvt_wgu_part(const Frame& F, const In& in, int l, int lo, int hi, int cu0, int ncu, int scr_base) {
    if (F.vcu < cu0 || F.vcu >= cu0 + ncu) return;
    const int k = F.vcu - cu0, n = hi - lo;
    cvt_range(F, in, l, lo + (int)(((long)k * n) / ncu), lo + (int)(((long)(k + 1) * n) / ncu), scr_base);
}

__device__ __forceinline__ void normmod_row(const float* xrow, const float* g, const float* sh, const float* sc, bf16_t* orow, int lane) {
    const GAS f32x4* xr = (const GAS f32x4*)xrow + lane;
    f32x4 v[4]; float s = 0.f;
#pragma unroll
    for (int j = 0; j < 4; ++j) { v[j] = xr[64 * j]; s += (v[j].x * v[j].x + v[j].y * v[j].y) + (v[j].z * v[j].z + v[j].w * v[j].w); }
    const float rstd = rsqrtf(wave_sum(s) * (1.f / D) + EPS);
    GAS u32x2* o8 = (GAS u32x2*)orow + lane;
#pragma unroll
    for (int j = 0; j < 4; ++j) {
        const f32x4 gg = ((const GAS f32x4*)g)[lane + 64 * j], ss = ((const GAS f32x4*)sh)[lane + 64 * j], cc = ((const GAS f32x4*)sc)[lane + 64 * j];
        const f32x4 h = v[j] * rstd * gg * (1.f + cc) + ss;
        u32x2 o; o.x = pk2(h.x, h.y); o.y = pk2(h.z, h.w);
        o8[64 * j] = o;
    }
}
__device__ __forceinline__ void phase_normmod(const Frame& F, const float* xlat, const float* xctx, const float* g, const float* MODl, int jshift, bf16_t* A, int nrows) {
    const int gw = F.vcu * NWAVES + F.wave, NGW = F.G * NWAVES;
    for (int row = gw; row < nrows; row += NGW) {
        const float* xr = row < NLAT ? xlat + (size_t)row * D : xctx + (size_t)(row - NLAT) * D;
        const float* sh = MODl + (size_t)ci_of_row(row) * 6144 + jshift * D;
        normmod_row(xr, g, sh, sh + D, A + (size_t)row * D, F.lane);
    }
    if (gw == 0) { GAS u32x4* z = (GAS u32x4*)(A + (size_t)ZROW * D); z[F.lane] = (u32x4){0u, 0u, 0u, 0u}; z[F.lane + 64] = (u32x4){0u, 0u, 0u, 0u}; }
}
namespace ab {
typedef short s16x4 __attribute__((ext_vector_type(4)));
typedef float f32x16 __attribute__((ext_vector_type(16)));
constexpr int NW = 8, QBLK = 32, QB = QBLK * NW, KVBLK = 64;
__device__ __forceinline__ int crow(int r, int hi) { return (r & 3) + 8 * (r >> 2) + 4 * hi; }
#define SBAR() __builtin_amdgcn_sched_barrier(0)
constexpr int NSLOT = 3, SLOTB = 8192;
constexpr int LDS_K = 0, LDS_V = NSLOT * SLOTB, LDS_WS = 2 * NSLOT * SLOTB, LDS_OST = LDS_WS + NW * 64 * 4, ATTN_LDS_BYTES = LDS_OST + NW * 4096;
__device__ __forceinline__ void glds16(const void* gsrc, unsigned lds_dst) { unsigned keep;
  asm volatile("s_mov_b32 %0, m0\n\ts_mov_b32 m0, %2\n\ts_nop 0\n\tglobal_load_lds_dwordx4 %1, off\n\ts_mov_b32 m0, %0" : "=&s"(keep) : "v"(gsrc), "s"(lds_dst) : "memory"); }
__device__ __forceinline__ float max3f(float a, float b, float c) { float r; asm("v_max3_f32 %0, %1, %2, %3" : "=v"(r) : "v"(a), "v"(b), "v"(c)); return r; }
__device__ __forceinline__ float max2f(float a, float b) { float r; asm("v_max_f32_e32 %0, %1, %2" : "=v"(r) : "v"(a), "v"(b)); return r; }
__device__ __forceinline__ float fadd_s(float a, float b) { float r; asm("v_add_f32_e32 %0, %1, %2" : "=v"(r) : "v"(a), "v"(b)); return r; }
__device__ __forceinline__ float fsub_s(float a, float b) { float r; asm("v_sub_f32_e32 %0, %1, %2" : "=v"(r) : "v"(a), "v"(b)); return r; }
typedef float f32x2_t __attribute__((ext_vector_type(2))); typedef __bf16 bf16x2_t __attribute__((ext_vector_type(2)));
__device__ __forceinline__ unsigned cvtpk_s(float lo, float hi) { f32x2_t v = {lo, hi}; bf16x2_t b = __builtin_convertvector(v, bf16x2_t); return __builtin_bit_cast(unsigned, b); }
#define WAIT_BAR(N) asm volatile("s_waitcnt vmcnt(" #N ") lgkmcnt(0)\n\ts_barrier" ::: "memory")

__device__ __forceinline__ void qkt(f32x16& p0, f32x16& p1, const char* Kslot, const bf16x8* qr, const f32x16& negm, int r32, int hi) {
  const char* kb = Kslot + hi * 1024 + r32 * 16;
  #pragma unroll
  for (int d0 = 0; d0 < 4; ++d0) {
    const bf16x8 b0 = *reinterpret_cast<const bf16x8*>(kb + d0 * 2048);
    const bf16x8 b1 = *reinterpret_cast<const bf16x8*>(kb + d0 * 2048 + 512);
    if (d0 == 0) { p0 = __builtin_amdgcn_mfma_f32_32x32x16_bf16(b0, qr[0], negm, 0, 0, 0); p1 = __builtin_amdgcn_mfma_f32_32x32x16_bf16(b1, qr[0], negm, 0, 0, 0); }
    else { p0 = __builtin_amdgcn_mfma_f32_32x32x16_bf16(b0, qr[d0], p0, 0, 0, 0); p1 = __builtin_amdgcn_mfma_f32_32x32x16_bf16(b1, qr[d0], p1, 0, 0, 0); } }
}
typedef __attribute__((address_space(3))) const char* lds_cptr;
typedef short v4i16_t __attribute__((ext_vector_type(4)));
__device__ __forceinline__ void kload8(bf16x8* kf, lds_cptr kp) {
  kf[0] = *(const __attribute__((address_space(3))) bf16x8*)(kp);        kf[1] = *(const __attribute__((address_space(3))) bf16x8*)(kp + 512);
  kf[2] = *(const __attribute__((address_space(3))) bf16x8*)(kp + 2048); kf[3] = *(const __attribute__((address_space(3))) bf16x8*)(kp + 2560);
  kf[4] = *(const __attribute__((address_space(3))) bf16x8*)(kp + 4096); kf[5] = *(const __attribute__((address_space(3))) bf16x8*)(kp + 4608);
  kf[6] = *(const __attribute__((address_space(3))) bf16x8*)(kp + 6144); kf[7] = *(const __attribute__((address_space(3))) bf16x8*)(kp + 6656);
}
__device__ __forceinline__ void kload2(bf16x8* kf, lds_cptr kp, int j) { kf[2 * j] = *(const __attribute__((address_space(3))) bf16x8*)(kp + j * 2048); kf[2 * j + 1] = *(const __attribute__((address_space(3))) bf16x8*)(kp + j * 2048 + 512); }
__device__ __forceinline__ s16x4 vtr(lds_cptr p) { return __builtin_bit_cast(s16x4, __builtin_amdgcn_ds_read_tr16_b64_v4i16((__attribute__((address_space(3))) v4i16_t*)p)); }
__device__ __forceinline__ float rowmax(const f32x16& p0, const f32x16& p1) {
  float a = max3f(p0[0], p0[1], p1[0]), b = max3f(p0[2], p0[3], p1[1]); a = max3f(a, p1[2], p1[3]);
  #pragma unroll
  for (int r = 4; r < 16; r += 4) { a = max3f(a, p0[r], p0[r + 1]); b = max3f(b, p0[r + 2], p0[r + 3]); a = max3f(a, p1[r], p1[r + 1]); b = max3f(b, p1[r + 2], p1[r + 3]); }
  const float m = max2f(a, b);
  auto rr = __builtin_amdgcn_permlane32_swap(__float_as_uint(m), __float_as_uint(m), false, false);
  return max2f(__uint_as_float(rr[0]), __uint_as_float(rr[1]));
}
__device__ __forceinline__ void pv(f32x16* o, int vb, bf16x8 pa0, bf16x8 pa1, bf16x8 pa2, bf16x8 pa3) {
  #pragma unroll
  for (int d0 = 0; d0 < 2; ++d0) { s16x4 lo[4], hi[4];
    #pragma unroll
    for (int ks = 0; ks < 4; ++ks) {
      asm volatile("ds_read_b64_tr_b16 %0,%1 offset:%c2" : "=&v"(lo[ks]) : "v"(vb), "i"(d0 * 4096 + ks * 1024) : "memory");
      asm volatile("ds_read_b64_tr_b16 %0,%1 offset:%c2" : "=&v"(hi[ks]) : "v"(vb), "i"(d0 * 4096 + ks * 1024 + 512) : "memory"); }
    asm volatile("s_waitcnt lgkmcnt(0)" ::: "memory"); SBAR();
    #define PK(k) (bf16x8){lo[k][0], lo[k][1], lo[k][2], lo[k][3], hi[k][0], hi[k][1], hi[k][2], hi[k][3]}
    o[d0] = __builtin_amdgcn_mfma_f32_32x32x16_bf16(pa0, PK(0), o[d0], 0, 0, 0);
    o[d0] = __builtin_amdgcn_mfma_f32_32x32x16_bf16(pa1, PK(1), o[d0], 0, 0, 0);
    o[d0] = __builtin_amdgcn_mfma_f32_32x32x16_bf16(pa2, PK(2), o[d0], 0, 0, 0);
    o[d0] = __builtin_amdgcn_mfma_f32_32x32x16_bf16(pa3, PK(3), o[d0], 0, 0, 0);
    #undef PK
  }
}
struct TileMap { int nA, tokA, tokB; __device__ __forceinline__ long tok(int t) const { return t < nA ? tokA + 64 * t : tokB + 64 * (t - nA); } };
struct NoHook { __device__ __forceinline__ void operator()(f32x16&, f32x16&, int) const {} };

template <int THRL, class Hook>
__device__ __forceinline__ void attn_unit(const bf16_t* Qw0, int QP, const bf16_t* __restrict__ Kh, const bf16_t* __restrict__ Vh, int KP, const TileMap tm, const int NT,
                                          bf16_t* Ow0, int OP, char* shm, const Hook& hook) {
  int tid = threadIdx.x; asm volatile("" : "+v"(tid)); const int lane = tid & 63, r32 = lane & 31, hi = lane >> 5; const int wid = __builtin_amdgcn_readfirstlane(tid >> 6);
  const bf16_t* Qw = Qw0 + (long)wid * QBLK * QP;
  const unsigned lds0 = (unsigned)(uintptr_t)shm;
  float* wsf = (float*)(shm + LDS_WS) + wid * 64;
  const bf16_t* ksrc = Kh + (long)lane * KP + wid * 8;
  const bf16_t* vsrc = Vh + (long)(16 * (wid & 3) + (lane >> 2)) * KP + (wid >> 2) * 32 + (lane & 3) * 8;
  const unsigned kdst = lds0 + LDS_K + wid * 1024, vdst = lds0 + LDS_V + wid * 1024;
  #define DMA_K(t, slot) glds16(ksrc + tm.tok(t) * KP, (unsigned)__builtin_amdgcn_readfirstlane(kdst + (slot)))
  #define DMA_V(t, slot) glds16(vsrc + tm.tok(t) * KP, (unsigned)__builtin_amdgcn_readfirstlane(vdst + (slot)))
  const int vb0 = (int)(lds0 + LDS_V) + ((lane >> 4) & 1) * 32 + (lane & 3) * 8 + (4 * hi + ((lane & 15) >> 2)) * 64;
  const char* Kbase = shm + LDS_K; bf16x8 kf[8];
  const lds_cptr shm3 = (lds_cptr)shm; const lds_cptr kp0 = shm3 + LDS_K + hi * 1024 + r32 * 16; const lds_cptr vp0 = shm3 + LDS_V + ((lane >> 4) & 1) * 32 + (lane & 3) * 8 + (4 * hi + ((lane & 15) >> 2)) * 64;
  DMA_K(0, 0); DMA_V(0, 0); DMA_K(1, SLOTB);
  bf16x8 qr[4];
  #pragma unroll
  for (int d0 = 0; d0 < 4; ++d0) qr[d0] = *reinterpret_cast<const bf16x8*>(&Qw[(long)r32 * QP + d0 * 16 + hi * 8]);
  float mhat = 0.f, l_reg = 0.f; f32x16 o[2]; o[0] = f32x16{}; o[1] = f32x16{}; f32x16 negm = f32x16{}; asm volatile("" : "+v"(negm));
  #define HOOK(P0, P1, t) hook(P0, P1, t)
  bool resc = false;
  #define START(P0, P1) do { const float rm = rowmax(P0, P1); resc = false; \
    { const float dl = rm; mhat = fadd_s(mhat, dl); \
      _Pragma("unroll") for (int r = 0; r < 16; ++r) { P0[r] = fsub_s(P0[r], dl); P1[r] = fsub_s(P1[r], dl); } \
      _Pragma("unroll") for (int r = 0; r < 16; ++r) negm[r] = -mhat; asm volatile("" : "+v"(negm)); } \
    _Pragma("unroll") for (int r = 0; r < 16; ++r) P0[r] = __builtin_amdgcn_exp2f(P0[r]); } while (0)
  #define RESC() do { if (resc) { asm volatile("s_waitcnt lgkmcnt(0)" ::: "memory"); \
      _Pragma("unroll") for (int d_ = 0; d_ < 2; ++d_) _Pragma("unroll") for (int r = 0; r < 16; ++r) o[d_][r] *= wsf[crow(r, hi)]; } } while (0)
  f32x16 pA0, pA1, pB0, pB1;
  int sl_prev = 0, sl_cur = 0, sl_next = SLOTB;
  #define ROT() do { sl_prev = sl_cur; sl_cur = sl_next; sl_next = (sl_next == (NSLOT - 1) * SLOTB) ? 0 : sl_next + SLOTB; } while (0)
  DMA_K(2, 2 * SLOTB);
  WAIT_BAR(3);
  qkt(pA0, pA1, Kbase, qr, negm, r32, hi); asm volatile("s_nop 15\n\ts_nop 7" : "+v"(pA0), "+v"(pA1)); HOOK(pA0, pA1, 0);
  START(pA0, pA1);
  _Pragma("unroll") for (int r = 0; r < 16; ++r) pA1[r] = __builtin_amdgcn_exp2f(pA1[r]);
  WAIT_BAR(0);
  DMA_K(3, 0); DMA_V(1, SLOTB);
  ROT();
  kload8(kf, kp0 + sl_cur);
  WAIT_BAR(2);
  s16x4 vlo[8], vhi[8]; u32x4 pw0, pw1, pw2, pw3;
  #define PKW(P, B) cvtpk_s(P[B], P[B + 1])
  #define PAF(k) __builtin_bit_cast(bf16x8, pw##k)
  #define VFR(i) (bf16x8){vlo[i][0], vlo[i][1], vlo[i][2], vlo[i][3], vhi[i][0], vhi[i][1], vhi[i][2], vhi[i][3]}
  #define PIN(x) asm volatile("" : "+v"(x))
  #define MX3(a, b, c) __builtin_fmaxf(__builtin_fmaxf((a), (b)), (c))
  #define GAPA(MF, A0, A1, A2, A3, W0, W1, PW) do { MF; sacc += A0; sacc += A1; sacc += A2; sacc += A3; PIN(sacc); W0; W1; PIN(PW); SBAR(); } while (0)
  #define EX(v) __builtin_amdgcn_exp2f(v)
  #define GAPB(MF, X, B) do { MF; X[B] = EX(X[B]); X[B + 1] = EX(X[B + 1]); X[B + 2] = EX(X[B + 2]); X[B + 3] = EX(X[B + 3]); PIN(X); SBAR(); } while (0)
  #define VRD(i) do { vlo[i] = vtr(vp_ + (((i) >> 2) * 4096 + ((i) & 3) * 1024)); vhi[i] = vtr(vp_ + (((i) >> 2) * 4096 + ((i) & 3) * 1024 + 512)); } while (0)
  #define KRD(G, j) do { if (G) { kload2(kf, kp0 + sl_next, j); SBAR(); } } while (0)
  #define STEP(C0, C1, P0, P1, t, GK, GV, GL) do { SBAR(); \
    const lds_cptr vp_ = vp0 + sl_prev; \
    VRD(0); SBAR(); float sacc = (P0[0] + P0[1]); \
    GAPA(C0 = __builtin_amdgcn_mfma_f32_32x32x16_bf16(kf[0], qr[0], negm, 0, 0, 0), P0[2], P0[3], P0[4], P0[5],     pw0[0] = PKW(P0, 0), pw0[1] = PKW(P0, 2), pw0); \
    VRD(4); SBAR(); GAPA(C1 = __builtin_amdgcn_mfma_f32_32x32x16_bf16(kf[1], qr[0], negm, 0, 0, 0), P0[6], P0[7], P0[8], P0[9],     pw0[2] = PKW(P0, 4), pw0[3] = PKW(P0, 6), pw0); \
    VRD(1); SBAR(); GAPA(C0 = __builtin_amdgcn_mfma_f32_32x32x16_bf16(kf[2], qr[1], C0, 0, 0, 0),   P0[10], P0[11], P0[12], P0[13], pw1[0] = PKW(P0, 8), pw1[1] = PKW(P0, 10), pw1); \
    VRD(5); SBAR(); GAPA(C1 = __builtin_amdgcn_mfma_f32_32x32x16_bf16(kf[3], qr[1], C1, 0, 0, 0),   P0[14], P0[15], P1[0], P1[1],   pw1[2] = PKW(P0, 12), pw1[3] = PKW(P0, 14), pw1); \
    VRD(2); SBAR(); GAPA(C0 = __builtin_amdgcn_mfma_f32_32x32x16_bf16(kf[4], qr[2], C0, 0, 0, 0),   P1[2], P1[3], P1[4], P1[5],     pw2[0] = PKW(P1, 0), pw2[1] = PKW(P1, 2), pw2); \
    VRD(6); SBAR(); GAPA(C1 = __builtin_amdgcn_mfma_f32_32x32x16_bf16(kf[5], qr[2], C1, 0, 0, 0),   P1[6], P1[7], P1[8], P1[9],     pw2[2] = PKW(P1, 4), pw2[3] = PKW(P1, 6), pw2); \
    VRD(3); SBAR(); GAPA(C0 = __builtin_amdgcn_mfma_f32_32x32x16_bf16(kf[6], qr[3], C0, 0, 0, 0),   P1[10], P1[11], P1[12], P1[13], pw3[0] = PKW(P1, 8), pw3[1] = PKW(P1, 10), pw3); \
    VRD(7); SBAR(); GAPA(C1 = __builtin_amdgcn_mfma_f32_32x32x16_bf16(kf[7], qr[3], C1, 0, 0, 0),   P1[14], P1[15], 0.f, 0.f,       pw3[2] = PKW(P1, 12), pw3[3] = PKW(P1, 14), pw3); \
    l_reg += sacc; \
    if (GK) { DMA_K((t) + 3, sl_cur); } if (GV) { DMA_V((t) + 1, sl_next); } \
    HOOK(C0, C1, t); \
    { float a = MX3(C0[0], C0[1], C1[0]), b = MX3(C0[2], C0[3], C1[1]); a = MX3(a, C1[2], C1[3]); \
      _Pragma("unroll") for (int r = 4; r < 16; r += 4) { a = MX3(a, C0[r], C0[r + 1]); b = MX3(b, C0[r + 2], C0[r + 3]); a = MX3(a, C1[r], C1[r + 1]); b = MX3(b, C1[r + 2], C1[r + 3]); } \
      float rm = __builtin_fmaxf(a, b); { auto rr = __builtin_amdgcn_permlane32_swap(__float_as_uint(rm), __float_as_uint(rm), false, false); rm = __builtin_fmaxf(__uint_as_float(rr[0]), __uint_as_float(rr[1])); } \
      resc = false; \
      if (__builtin_expect(__any(rm > (float)THRL), 0)) { const float dl = __builtin_fmaxf(rm, 0.f); mhat += dl; \
        _Pragma("unroll") for (int r = 0; r < 16; ++r) { C0[r] -= dl; C1[r] -= dl; } \
        _Pragma("unroll") for (int r = 0; r < 16; ++r) negm[r] = -mhat; asm volatile("" : "+v"(negm)); \
        const float f = __builtin_amdgcn_exp2f(-dl); l_reg *= f; if (hi == 0) wsf[r32] = f; resc = true; } } \
    SBAR(); \
    GAPB(o[0] = __builtin_amdgcn_mfma_f32_32x32x16_bf16(PAF(0), VFR(0), o[0], 0, 0, 0), C0, 0); \
    GAPB(o[1] = __builtin_amdgcn_mfma_f32_32x32x16_bf16(PAF(0), VFR(4), o[1], 0, 0, 0), C0, 4); \
    KRD(GL, 0); GAPB(o[0] = __builtin_amdgcn_mfma_f32_32x32x16_bf16(PAF(1), VFR(1), o[0], 0, 0, 0), C0, 8); \
    KRD(GL, 1); GAPB(o[1] = __builtin_amdgcn_mfma_f32_32x32x16_bf16(PAF(1), VFR(5), o[1], 0, 0, 0), C0, 12); \
    KRD(GL, 2); GAPB(o[0] = __builtin_amdgcn_mfma_f32_32x32x16_bf16(PAF(2), VFR(2), o[0], 0, 0, 0), C1, 0); \
    KRD(GL, 3); GAPB(o[1] = __builtin_amdgcn_mfma_f32_32x32x16_bf16(PAF(2), VFR(6), o[1], 0, 0, 0), C1, 4); \
    GAPB(o[0] = __builtin_amdgcn_mfma_f32_32x32x16_bf16(PAF(3), VFR(3), o[0], 0, 0, 0), C1, 8); \
    GAPB(o[1] = __builtin_amdgcn_mfma_f32_32x32x16_bf16(PAF(3), VFR(7), o[1], 0, 0, 0), C1, 12); \
    } while (0)
  int t = 1;
  for (; t + 5 < NT; t += 2) {
    STEP(pB0, pB1, pA0, pA1, t, true, true, true);     WAIT_BAR(2); RESC(); ROT();
    STEP(pA0, pA1, pB0, pB1, t + 1, true, true, true); WAIT_BAR(2); RESC(); ROT();
  }
  #define ENDW(tt) do { if ((tt) + 3 < NT) { WAIT_BAR(2); } else if ((tt) + 2 < NT) { WAIT_BAR(1); } else { WAIT_BAR(0); } } while (0)
  for (; t + 1 < NT; t += 2) {
    STEP(pB0, pB1, pA0, pA1, t, (t + 3 < NT), (t + 1 < NT), (t + 1 < NT));       ENDW(t);     RESC(); ROT();
    STEP(pA0, pA1, pB0, pB1, t + 1, (t + 4 < NT), (t + 2 < NT), (t + 2 < NT));   ENDW(t + 1); RESC(); ROT();
  }
  STEP(pB0, pB1, pA0, pA1, NT - 1, false, false, false); RESC();
  { float sacc = pB0[0] + pB0[1]; _Pragma("unroll") for (int r = 2; r < 16; ++r) sacc += pB0[r]; _Pragma("unroll") for (int r = 0; r < 16; ++r) sacc += pB1[r]; l_reg += sacc;
    pw0 = (u32x4){PKW(pB0, 0), PKW(pB0, 2), PKW(pB0, 4), PKW(pB0, 6)}; pw1 = (u32x4){PKW(pB0, 8), PKW(pB0, 10), PKW(pB0, 12), PKW(pB0, 14)}; pw2 = (u32x4){PKW(pB1, 0), PKW(pB1, 2), PKW(pB1, 4), PKW(pB1, 6)}; pw3 = (u32x4){PKW(pB1, 8), PKW(pB1, 10), PKW(pB1, 12), PKW(pB1, 14)};
    SBAR(); pv(o, vb0 + sl_cur, PAF(0), PAF(1), PAF(2), PAF(3)); }
  #undef PKW
  #undef PAF
  #undef VFR
  #undef PIN
  #undef MX3
  #undef GAPA
  #undef GAPB
  #undef EX
  #undef VRD
  #undef KRD
  #undef STEP
  #undef ENDW
  { auto rr = __builtin_amdgcn_permlane32_swap(__float_as_uint(l_reg), __float_as_uint(l_reg), false, false); l_reg = __uint_as_float(rr[0]) + __uint_as_float(rr[1]); }
  if (hi == 0) wsf[32 + r32] = l_reg; asm volatile("s_waitcnt lgkmcnt(0)" ::: "memory");
  float rli[16];
  #pragma unroll
  for (int r = 0; r < 16; ++r) rli[r] = __builtin_amdgcn_rcpf(wsf[32 + crow(r, hi)]);
  bf16_t* Ow = Ow0 + (long)wid * QBLK * OP;
  { bf16_t* stg = (bf16_t*)(shm + LDS_OST) + wid * 2048;
    #pragma unroll
    for (int r = 0; r < 16; ++r) { const int orow = crow(r, hi);
      #pragma unroll
      for (int d0 = 0; d0 < 2; ++d0) stg[orow * 64 + d0 * 32 + r32] = (bf16_t)f2bf(o[d0][r] * rli[r]); }
    asm volatile("s_waitcnt lgkmcnt(0)" ::: "memory");
    #pragma unroll
    for (int i = 0; i < 4; ++i) { const int row = i * 8 + (lane >> 3), ch = lane & 7; const u32x4 v = *(const u32x4*)(stg + row * 64 + ch * 8); *(u32x4*)(Ow + (long)row * OP + ch * 8) = v; } }
  asm volatile("s_waitcnt lgkmcnt(0)\n\ts_barrier" ::: "memory");
  #undef DMA_K
  #undef DMA_V
  #undef HOOK
  #undef START
  #undef RESC
  #undef ROT
}
#undef SBAR
#undef WAIT_BAR
}
template <int J> __device__ __forceinline__ void conv_step(const LAS float* glc, const float (&w)[31], float (&acc)[32]) {
    if constexpr (J < 62) {
        const float v = glc[J * 512];
        constexpr int PLO = J - 30 > 0 ? J - 30 : 0, PHI = J < 31 ? J : 31;
#pragma unroll
        for (int p = PLO; p <= PHI; ++p) acc[p] += w[J - p] * v;
        conv_step<J + 1>(glc, w, acc);
    }
}
__device__ __forceinline__ void phase_conv0(const Frame& F, const In& in, const bf16_t* Z  , bf16_t* CAT  ) {
    const int c = F.tid;
    LAS float* gl = (LAS float*)F.lds;
    constexpr int NITEMS = 8 * 64 + 8 * 8;
    for (int it = F.vcu; it < NITEMS; it += F.G) {
        int seqbase, t0, L;
        if (it < 512) { seqbase = (it / 64) * T; t0 = (it % 64) * 32; L = T; }
        else { const int j = it - 512; seqbase = NLAT + (j / 8) * NC; t0 = (j % 8) * 32; L = NC; }
        __syncthreads();
#pragma unroll 2
        for (int i = 0; i < 8; ++i) {
            const int j = (F.tid >> 6) + 8 * i;
            const int tt = t0 - 15 + j, ch = (F.tid & 63) * 8;
            if (j < 62) {
                u32x4 a = (u32x4){0u, 0u, 0u, 0u}, g = a;
                if (tt >= 0 && tt < L) { const bf16_t* zr = Z + (size_t)(seqbase + tt) * 1792 + ch; a = *(const u32x4*)zr; g = *(const u32x4*)(zr + 512); }
                const f32x4 o0 = (f32x4){bflo(a.x) * fast_sigmoid(bflo(g.x)), bfhi(a.x) * fast_sigmoid(bfhi(g.x)), bflo(a.y) * fast_sigmoid(bflo(g.y)), bfhi(a.y) * fast_sigmoid(bfhi(g.y))};
                const f32x4 o1 = (f32x4){bflo(a.z) * fast_sigmoid(bflo(g.z)), bfhi(a.z) * fast_sigmoid(bfhi(g.z)), bflo(a.w) * fast_sigmoid(bflo(g.w)), bfhi(a.w) * fast_sigmoid(bfhi(g.w))};
                *(LAS f32x4*)(gl + j * 512 + ch) = o0; *(LAS f32x4*)(gl + j * 512 + ch + 4) = o1;
            }
        }
        __syncthreads();
        float w[31];
#pragma unroll
        for (int k = 0; k < 31; ++k) w[k] = in.conv_w[k * 512 + c];
        const float cb = in.conv_b[c];
        float acc[32];
#pragma unroll
        for (int p = 0; p < 32; ++p) acc[p] = cb;
        conv_step<0>(gl + c, w, acc);
        __syncthreads();
#pragma unroll
        for (int p = 0; p < 32; ++p) gl[p * 512 + c] = acc[p];
        __syncthreads();
#pragma unroll
        for (int q = 0; q < 4; ++q) {
            const int p = F.wave * 4 + q;
            const f32x4 a = *(const LAS f32x4*)(gl + p * 512 + 8 * F.lane), b = *(const LAS f32x4*)(gl + p * 512 + 8 * F.lane + 4);
            const float mu = wave_sum((a[0] + a[1]) + (a[2] + a[3]) + (b[0] + b[1]) + (b[2] + b[3])) * (1.f / 512.f);
            const f32x4 da = a - mu, db = b - mu;
            const float var = wave_sum((da[0] * da[0] + da[1] * da[1]) + (da[2] * da[2] + da[3] * da[3]) + (db[0] * db[0] + db[1] * db[1]) + (db[2] * db[2] + db[3] * db[3])) * (1.f / 512.f);
            const float rstd = rsqrtf(var + EPS);
            const f32x4 g0 = *(const f32x4*)(in.conv_ln_g + 8 * F.lane), g1 = *(const f32x4*)(in.conv_ln_g + 8 * F.lane + 4);
            const f32x4 b0 = *(const f32x4*)(in.conv_ln_b + 8 * F.lane), b1 = *(const f32x4*)(in.conv_ln_b + 8 * F.lane + 4);
            const f32x4 o0 = da * rstd * g0 + b0, o1 = db * rstd * g1 + b1;
            u32x4 o; o.x = pk2(fast_silu(o0[0]), fast_silu(o0[1])); o.y = pk2(fast_silu(o0[2]), fast_silu(o0[3])); o.z = pk2(fast_silu(o1[0]), fast_silu(o1[1])); o.w = pk2(fast_silu(o1[2]), fast_silu(o1[3]));
            *(u32x4*)(CAT + (size_t)(seqbase + t0 + p) * D + 8 * F.lane) = o;
        }
    }
    __syncthreads();
}

__device__ __forceinline__ void phase_qkv0(const Frame& F, const In& in, const bf16_t* Z, bf16_t* Q, bf16_t* Kb, bf16_t* Vb) {
    const int gw = F.vcu * NWAVES + F.wave, NGW = F.G * NWAVES, lane = F.lane;
    const int d0 = 4 * (lane & 15);
    const f32x4 qg = *(const f32x4*)(in.qn_g + d0), kg = *(const f32x4*)(in.kn_g + d0);
    const int half = d0 >> 5, dd = d0 & 31; const bool first = dd < 16; const int f0 = dd & 15;
    float inv[4];
#pragma unroll
    for (int e = 0; e < 4; ++e) inv[e] = __builtin_amdgcn_exp2f(-(float)(f0 + e) * (13.287712379549449f / 16.f)) * 0.15915494309189535f;
    for (int row = gw; row < NR; row += NGW) {
        const bool lat = row < NLAT;
        int b, t;
        if (lat) { b = row / T; t = row % T; } else { const int r2 = row - NLAT; b = r2 / NC; t = T + r2 % NC; }
        const size_t kvrow = (size_t)b * KEYS + t;
        const float pos = half == 0 ? (float)(t >> 6) : (float)(t & 63);
        float cs[4], sn[4];
#pragma unroll
        for (int e = 0; e < 4; ++e) { const float rev = pos * inv[e]; cs[e] = __builtin_amdgcn_cosf(rev); sn[e] = __builtin_amdgcn_sinf(rev); }
        const bf16_t* zr = Z + (size_t)row * 1792 + 1024;
#pragma unroll
        for (int g = 0; g < 3; ++g) {
            const u32x2 raw = *(const u32x2*)(zr + g * 256 + 4 * lane);
            float x[4] = {bflo(raw.x), bfhi(raw.x), bflo(raw.y), bfhi(raw.y)};
            const bool isv = (g == 2) && lane >= 32;
            float ss = (x[0] * x[0] + x[1] * x[1]) + (x[2] * x[2] + x[3] * x[3]);
            ss += __shfl_xor(ss, 1); ss += __shfl_xor(ss, 2); ss += __shfl_xor(ss, 4); ss += __shfl_xor(ss, 8);
            const float rstd = rsqrtf(ss * (1.f / 64.f) + EPS);
            const f32x4 gn = (g == 2) ? kg : qg;
            float y[4];
#pragma unroll
            for (int e = 0; e < 4; ++e) y[e] = isv ? x[e] : x[e] * rstd * gn[e];
#pragma unroll
            for (int e = 0; e < 4; ++e) {
                const float yp = __shfl_xor(y[e], 4);
                const float r = first ? y[e] * cs[e] - yp * sn[e] : y[e] * cs[e] + yp * sn[e];
                if (lat && !isv) y[e] = r;
            }
            if (g < 2) { u32x2 o; o.x = pk2(y[0] * C2, y[1] * C2); o.y = pk2(y[2] * C2, y[3] * C2); *(u32x2*)(Q + (size_t)row * 512 + g * 256 + 4 * lane) = o; }
            else { u32x2 o; o.x = pk2(y[0], y[1]); o.y = pk2(y[2], y[3]);
                if (lane < 32) *(u32x2*)(Kb + kvrow * 128 + 4 * lane) = o; else *(u32x2*)(Vb + kvrow * 128 + 4 * (lane - 32)) = o; }
        }
    }
}

constexpr int ATTN_CVT_SCR = 86016;
__device__ __forceinline__ void phase_attn0(const Frame& F, const In& in, char* shm, const bf16_t* Q, const bf16_t* Kb, const bf16_t* Vb, bf16_t* CAT) {
    for (int u = F.vcu; u < 512 + 64; u += F.G) {
        if (u < 512) {
            const int bk = u >> 5, qb = (u >> 2) & 7, g = u & 3, b = bk >> 1, hkv = bk & 1, h = hkv * 4 + g;
            const size_t row0 = (size_t)b * T + qb * 256;
            ab::TileMap tm{36, 0, 0};
            ab::attn_unit<8, ab::NoHook>(Q + row0 * 512 + h * 64, 512, Kb + (size_t)b * KEYS * 128 + hkv * 64, Vb + (size_t)b * KEYS * 128 + hkv * 64, 128, tm, 36,
                                         CAT + row0 * D + 512 + h * 64, D, shm, ab::NoHook{});
        } else {
            const int j = u - 512, b = j >> 3, h = j & 7, hkv = h >> 2;
            const size_t row0 = (size_t)NLAT + b * NC;
            ab::TileMap tm{4, T, T};
            ab::attn_unit<8, ab::NoHook>(Q + row0 * 512 + h * 64, 512, Kb + (size_t)b * KEYS * 128 + hkv * 64, Vb + (size_t)b * KEYS * 128 + hkv * 64, 128, tm, 4,
                                         CAT + row0 * D + 512 + h * 64, D, shm, ab::NoHook{});
        }
    }
}
__device__ __forceinline__ unsigned grp8_umax(unsigned v) {
    v = max(v, (unsigned)__builtin_amdgcn_update_dpp((int)v, (int)v, 0xB1, 0xf, 0xf, true));
    v = max(v, (unsigned)__builtin_amdgcn_update_dpp((int)v, (int)v, 0x4E, 0xf, 0xf, true));
    v = max(v, (unsigned)__builtin_amdgcn_update_dpp((int)v, (int)v, 0x141, 0xf, 0xf, true));
    return v;
}
__device__ __forceinline__ float grp8_fmax(float x) {
    int v = __builtin_bit_cast(int, x);
    v = __builtin_bit_cast(int, fmaxf(__builtin_bit_cast(float, v), __builtin_bit_cast(float, __builtin_amdgcn_update_dpp(v, v, 0xB1, 0xf, 0xf, true))));
    v = __builtin_bit_cast(int, fmaxf(__builtin_bit_cast(float, v), __builtin_bit_cast(float, __builtin_amdgcn_update_dpp(v, v, 0x4E, 0xf, 0xf, true))));
    v = __builtin_bit_cast(int, fmaxf(__builtin_bit_cast(float, v), __builtin_bit_cast(float, __builtin_amdgcn_update_dpp(v, v, 0x141, 0xf, 0xf, true))));
    return __builtin_bit_cast(float, v);
}
__device__ __forceinline__ void phase_route(const Frame& F, const In& in, int l, int g0, int g1, const bf16_t* X, const float* MODl, unsigned char* A2, const bool dummy) {
    const int lane = F.lane, w = F.wave, r = lane & 15, q = lane >> 4;
    constexpr int MR = 48;
    LAS float* part = (LAS float*)F.lds;
    LAS float* plog = part + 8 * MR;
    LAS float* G = plog + 8 * MR * 64;
    LAS int* cntw = (LAS int*)(G + 80 * 64);
    LAS float* rk = (LAS float*)(cntw + 8 * 64) + w * 64;
    const bf16_t* WRH = (const bf16_t*)(F.ws + O_WR) + (size_t)l * 2 * 64 * D; const bf16_t* WRL = WRH + 64 * D;
    const float* ng = in.norm_g + (l * 2 + 1) * D + 128 * w + 8 * q;
    const float brl = in.b_router[l * 64 + lane];
    unsigned* cnt = (unsigned*)(F.ws + O_CTL) + CW_CNT + (dummy ? 2 : l) * 64;
    unsigned char* tb = F.ws + (dummy ? O_Y : O_ROUTE);
    int* dest = (int*)(tb + R_DEST); int* list = (int*)(tb + R_LIST); float* gtk = (float*)(tb + R_GTK);
    if (F.vcu == 0 && w == 0) { GAS u32x4* z = (GAS u32x4*)(A2 + (size_t)ZROW * D); z[lane] = (u32x4){0u, 0u, 0u, 0u}; }
    const bf16_t* wl0 = WRL + (size_t)r * D + 128 * w + 8 * q;
    int mycnt = 0;
    const int myg = g1 - g0;
    for (int m0 = 0; m0 < myg; m0 += 3) {
        const int ng3 = min(3, myg - m0);
        int grp3[3];
#pragma unroll
        for (int gi = 0; gi < 3; ++gi) grp3[gi] = g0 + m0 + min(gi, ng3 - 1);
        {
            u32x4 xw[3][4];
#pragma unroll
            for (int gi = 0; gi < 3; ++gi) { const bf16_t* xr = X + (size_t)(grp3[gi] * 16 + r) * D + 128 * w + 8 * q;
#pragma unroll
                for (int ks = 0; ks < 4; ++ks) xw[gi][ks] = *(const u32x4*)(xr + 32 * ks); }
#pragma unroll
            for (int gi = 0; gi < 3; ++gi) { float ss = 0.f;
#pragma unroll
                for (int ks = 0; ks < 4; ++ks) { const u32x4 a = xw[gi][ks];
#pragma unroll
                    for (int j = 0; j < 4; ++j) { const float lo = bflo(a[j]), hi = bfhi(a[j]); ss += lo * lo + hi * hi; } }
                ss += __shfl_xor(ss, 16); ss += __shfl_xor(ss, 32);
                if (q == 0) part[w * MR + gi * 16 + r] = ss; }
        }
        __syncthreads();
        {
            bf16x8 bh[4][4];
            { const bf16_t* wh0 = WRH + (size_t)r * D + 128 * w + 8 * q; asm volatile("" : "+v"(wh0));
#pragma unroll
              for (int ks = 0; ks < 4; ++ks)
#pragma unroll
                for (int nf = 0; nf < 4; ++nf) bh[ks][nf] = *(const bf16x8*)(wh0 + (size_t)(16 * nf) * D + 32 * ks); }
            float rstd[3]; f32x4 acc[3][4];
#pragma unroll
            for (int gi = 0; gi < 3; ++gi) { float tot = 0.f;
#pragma unroll
                for (int j = 0; j < 8; ++j) tot += part[j * MR + gi * 16 + r];
                rstd[gi] = rsqrtf(tot * (1.f / D) + EPS);
#pragma unroll
                for (int nf = 0; nf < 4; ++nf) acc[gi][nf] = (f32x4){0.f, 0.f, 0.f, 0.f}; }
#pragma unroll
            for (int ks = 0; ks < 4; ++ks) {
                const int co = 32 * ks;
                const f32x4 g0 = *(const f32x4*)(ng + co), g1 = *(const f32x4*)(ng + co + 4);
                bf16x8 blf[4];
#pragma unroll
                for (int nf = 0; nf < 4; ++nf) blf[nf] = *(const bf16x8*)(wl0 + (size_t)(16 * nf) * D + co);
#pragma unroll
                for (int gi = 0; gi < 3; ++gi) {
                    const int row = grp3[gi] * 16 + r;
                    const bf16_t* xr = X + (size_t)row * D + 128 * w + 8 * q;
                    const float* sh = MODl + (size_t)ci_of_row(grp3[gi] * 16) * 6144 + 3 * D + 128 * w + 8 * q;
                    const u32x4 xwv = *(const u32x4*)(xr + co);
                    const f32x4 xa = (f32x4){bflo(xwv.x), bfhi(xwv.x), bflo(xwv.y), bfhi(xwv.y)}, xb = (f32x4){bflo(xwv.z), bfhi(xwv.z), bflo(xwv.w), bfhi(xwv.w)};
                    const f32x4 s0 = *(const f32x4*)(sh + co), s1 = *(const f32x4*)(sh + co + 4), c0 = *(const f32x4*)(sh + D + co), c1 = *(const f32x4*)(sh + D + co + 4);
                    const f32x4 h0 = xa * rstd[gi] * g0 * (1.f + c0) + s0, h1 = xb * rstd[gi] * g1 * (1.f + c1) + s1;
                    unsigned hb[8]; float hl[8];
#pragma unroll
                    for (int j = 0; j < 4; ++j) { hb[j] = f2bf(h0[j]); hl[j] = h0[j] - __builtin_bit_cast(float, hb[j] << 16); hb[j + 4] = f2bf(h1[j]); hl[j + 4] = h1[j] - __builtin_bit_cast(float, hb[j + 4] << 16); }
                    u32x4 hw; hw.x = hb[0] | (hb[1] << 16); hw.y = hb[2] | (hb[3] << 16); hw.z = hb[4] | (hb[5] << 16); hw.w = hb[6] | (hb[7] << 16);
                    u32x4 lw; lw.x = pk2(hl[0], hl[1]); lw.y = pk2(hl[2], hl[3]); lw.z = pk2(hl[4], hl[5]); lw.w = pk2(hl[6], hl[7]);
                    {
                        float c8[8];
#pragma unroll
                        for (int j = 0; j < 4; ++j) { c8[j] = __builtin_amdgcn_fmed3f(h0[j], -448.f, 448.f); c8[j + 4] = __builtin_amdgcn_fmed3f(h1[j], -448.f, 448.f); }
                        int a = __builtin_amdgcn_cvt_pk_fp8_f32(c8[0], c8[1], 0, false); a = __builtin_amdgcn_cvt_pk_fp8_f32(c8[2], c8[3], a, true);
                        int b = __builtin_amdgcn_cvt_pk_fp8_f32(c8[4], c8[5], 0, false); b = __builtin_amdgcn_cvt_pk_fp8_f32(c8[6], c8[7], b, true);
                        *(u32x2*)(A2 + (size_t)row * D + 128 * w + co + 8 * q) = (u32x2){(unsigned)a, (unsigned)b};
                    }
                    const bf16x8 ah = __builtin_bit_cast(bf16x8, hw), al = __builtin_bit_cast(bf16x8, lw);
#pragma unroll
                    for (int nf = 0; nf < 4; ++nf) {
                        acc[gi][nf] = __builtin_amdgcn_mfma_f32_16x16x32_bf16(ah, bh[ks][nf], acc[gi][nf], 0, 0, 0);
                        acc[gi][nf] = __builtin_amdgcn_mfma_f32_16x16x32_bf16(ah, blf[nf], acc[gi][nf], 0, 0, 0);
                        acc[gi][nf] = __builtin_amdgcn_mfma_f32_16x16x32_bf16(al, bh[ks][nf], acc[gi][nf], 0, 0, 0);
                    }
                }
            }
#pragma unroll
            for (int gi = 0; gi < 3; ++gi)
#pragma unroll
                for (int nf = 0; nf < 4; ++nf)
#pragma unroll
                    for (int g = 0; g < 4; ++g) plog[(w * MR + gi * 16 + 4 * q + g) * 64 + 16 * nf + r] = acc[gi][nf][g];
        }
        __syncthreads();
        for (int rr = w; rr < ng3 * 16; rr += 8) {
            float lgt = 0.f;
#pragma unroll
            for (int j = 0; j < 8; ++j) lgt += plog[(j * MR + rr) * 64 + lane];
            const float s = 1.f / (1.f + __expf(-lgt));
            const float b = s + brl;
            const unsigned ub = __float_as_uint(b);
            const unsigned key0 = (((ub & 0x80000000u) ? ~ub : (ub | 0x80000000u)) & ~63u) | (unsigned)(63 - lane);
            const unsigned k1 = grp8_umax(key0);
            const float b1 = grp8_fmax(b);
            const float b2 = grp8_fmax(key0 == k1 ? -INFINITY : b);
            const float gs = b1 + b2; const int g = lane >> 3;
            int grank = 0;
#pragma unroll
            for (int g2 = 0; g2 < 8; ++g2) { const float v = __builtin_bit_cast(float, __builtin_amdgcn_readlane(__builtin_bit_cast(int, gs), g2 * 8)); grank += (v > gs || (v == gs && g2 < g)) ? 1 : 0; }
            unsigned cur = grank < 4 ? key0 : 0u; bool sel = false;
#pragma unroll 1
            for (int it8 = 0; it8 < 8; ++it8) {
                unsigned gm = grp8_umax(cur);
                gm = max(gm, (unsigned)__builtin_amdgcn_update_dpp((int)gm, (int)gm, 0x128  , 0xf, 0xf, true));
                const unsigned mx = max(max((unsigned)__builtin_amdgcn_readlane((int)gm, 0), (unsigned)__builtin_amdgcn_readlane((int)gm, 16)),
                                        max((unsigned)__builtin_amdgcn_readlane((int)gm, 32), (unsigned)__builtin_amdgcn_readlane((int)gm, 48)));
                if (cur == mx) { sel = true; cur = 0u; }
            }
            const float ssum = __ockl_wfred_add_f32(sel ? s : 0.f);
            G[(m0 * 16 + rr) * 64 + lane] = sel ? s / ssum * 2.5f : 0.f;
            mycnt += sel ? 1 : 0;
        }
    }
    cntw[w * 64 + lane] = mycnt;
    __syncthreads();
    if (w == 0) {
        int tot = 0;
#pragma unroll
        for (int j = 0; j < 8; ++j) tot += cntw[j * 64 + lane];
        int base = 0;
        if (tot > 0) base = (int)__hip_atomic_fetch_add(cnt + lane, (unsigned)tot, __ATOMIC_RELAXED, __HIP_MEMORY_SCOPE_AGENT);
#pragma unroll
        for (int j = 0; j < 8; ++j) { const int cj = cntw[j * 64 + lane]; cntw[j * 64 + lane] = base; base += cj; }
    }
    __syncthreads();
    {
        int pos = cntw[w * 64 + lane];
        for (int m0 = 0; m0 < myg; m0 += 3) {
            const int ng3 = min(3, myg - m0);
            for (int rr = w; rr < ng3 * 16; rr += 8) {
                const float gt = G[(m0 * 16 + rr) * 64 + lane];
                const bool sel = gt != 0.f;
                const unsigned long long m = __ballot(sel);
                const int k = __popcll(m & ((1ull << lane) - 1ull));
                if (sel) { const int tok = (g0 + m0 + (rr >> 4)) * 16 + (rr & 15);
                    list[(size_t)lane * ECAP + pos] = tok; gtk[tok * 8 + k] = gt; dest[tok * 8 + k] = (int)((unsigned)lane << 20 | (unsigned)pos); ++pos; }
            }
        }
    }
    __syncthreads();
}

struct MoeTables { LAS int* cnt; LAS int* tp; LAS int* off; };
__device__ __forceinline__ MoeTables moe_tables(const Frame& F, int l) {
    MoeTables mt; mt.cnt = (LAS int*)(F.lds + LDSX_OFF); mt.tp = mt.cnt + 64; mt.off = mt.tp + 80;
    const unsigned* cnt = (const unsigned*)(F.ws + O_CTL) + CW_CNT + l * 64;
    __syncthreads();
    if (F.tid < 64) {
        const int c = (int)__hip_atomic_load(cnt + F.tid, __ATOMIC_RELAXED, __HIP_MEMORY_SCOPE_AGENT);
        mt.cnt[F.tid] = c;
        int t = (c + 255) >> 8, o = c;
#pragma unroll
        for (int d = 1; d < 64; d <<= 1) { const int t2 = __shfl_up(t, d), o2 = __shfl_up(o, d); if (F.tid >= d) { t += t2; o += o2; } }
        mt.tp[F.tid + 1] = t; mt.off[F.tid + 1] = o;
        if (F.tid == 0) { mt.tp[0] = 0; mt.off[0] = 0; }
    }
    __syncthreads();
    return mt;
}
__device__ __forceinline__ int moe_find_expert(const MoeTables& mt, int tile) {
    int lo = 0, hi = 64;
#pragma unroll
    for (int it = 0; it < 6; ++it) { const int mid = (lo + hi) >> 1; if (mt.tp[mid] <= tile) lo = mid; else hi = mid; }
    return __builtin_amdgcn_readfirstlane(lo);
}
struct MoeUpSched {
    MoeTables mt; const char* WGU; const char* WSGU; const int* list; int G, vcu, nshared_pm;
    __device__ __forceinline__ bool next(int i, GUnit& u) const {
        int L = i * G + vcu;
        const int ntr = __builtin_amdgcn_readfirstlane(mt.tp[64]);
        if (L < 2 * ntr) {
            const int tile = L >> 1, pn = L & 1, e = moe_find_expert(mt, tile);
            const int j = tile - __builtin_amdgcn_readfirstlane(mt.tp[e]), c = __builtin_amdgcn_readfirstlane(mt.cnt[e]), o = __builtin_amdgcn_readfirstlane(mt.off[e]);
            u.Bp = WGU + ((size_t)e * 512 + pn * 256) * D; u.rows = list + (size_t)e * ECAP + 256 * j; u.arow0 = 0; u.orow0 = o + 256 * j;
            u.nvalid = min(256, c - 256 * j); u.pn = pn; u.e = e; return true;
        }
        L -= 2 * ntr;
        const int pm = L >> 1, pn = L & 1;
        if (pm >= nshared_pm) return false;
        u.Bp = WSGU + (size_t)pn * 256 * D; u.rows = nullptr; u.arow0 = pm * 256; u.orow0 = pm * 256; u.nvalid = 256; u.pn = pn; u.e = 64; return true;
    }
    __device__ __forceinline__ void done(const GUnit&, int) const {}
};
struct EpiSwigluMoe {
    static constexpr bool PERM = true;
    unsigned char* act; unsigned char* acts;
    __device__ __forceinline__ void operator()(const Acc& acc, const GUnit& u, int wr, int wc, int fr, int fq) const {
        EpiSwiglu E{u.e == 64 ? acts : act}; E(acc, u, wr, wc, fr, fq);
    }
};
constexpr int SH_SLOT0 = NR * 8;
struct MoeDownSched {
    MoeTables mt; const char* WD; const char* WSD; int G, vcu, nshared_pm;
    __device__ __forceinline__ bool next(int i, GUnit& u) const {
        int L = i * G + vcu;
        const int ntr = __builtin_amdgcn_readfirstlane(mt.tp[64]);
        if (L < 4 * ntr) {
            const int tile = L >> 2, pn = L & 3, e = moe_find_expert(mt, tile);
            const int j = tile - __builtin_amdgcn_readfirstlane(mt.tp[e]), c = __builtin_amdgcn_readfirstlane(mt.cnt[e]), o = __builtin_amdgcn_readfirstlane(mt.off[e]);
            u.Bp = WD + ((size_t)e * D + pn * 256) * 256; u.rows = nullptr; u.arow0 = o + 256 * j; u.orow0 = o + 256 * j;
            u.nvalid = min(256, c - 256 * j); u.pn = pn; u.e = e; return true;
        }
        L -= 4 * ntr;
        const int pm = L >> 2, pn = L & 3;
        if (pm >= nshared_pm) return false;
        u.Bp = WSD + (size_t)pn * 256 * 256; u.rows = nullptr; u.arow0 = (int)((O_ACTS - O_ACT) / 256) + pm * 256; u.orow0 = SH_SLOT0 + pm * 256; u.nvalid = 256; u.pn = pn; u.e = 64; return true;
    }
    __device__ __forceinline__ void done(const GUnit&, int) const {}
};
constexpr float YSCALE = 16.f, YINV = 1.f / 16.f;
constexpr float YACC = YSCALE / (ASCALE8 * WSCALE8);
struct EpiFp8 {
    static constexpr bool PERM = true;
    unsigned char* O;
    __device__ __forceinline__ void operator()(const Acc& acc, const GUnit& u, int wr, int wc, int fr, int fq) const {
        const int odd = fq & 1;
        const int col0 = u.pn * BM + wc * 32 + 16 * (fq >> 1);
#pragma unroll
        for (int ai = 0; ai < 2; ++ai)
#pragma unroll
            for (int mp = 0; mp < 2; ++mp) {
                const int r = ai * HALF + wr * 64 + (2 * mp + odd) * 16 + fr;
#pragma unroll
                for (int bj = 0; bj < 2; ++bj) {
                    int w[2][2];
#pragma unroll
                    for (int mm = 0; mm < 2; ++mm) { f32x4 v0 = acc[ai][bj][2 * mp + mm][0] * YACC, v1 = acc[ai][bj][2 * mp + mm][1] * YACC;
#pragma unroll
                        for (int c = 0; c < 4; ++c) { v0[c] = __builtin_amdgcn_fmed3f(v0[c], -448.f, 448.f); v1[c] = __builtin_amdgcn_fmed3f(v1[c], -448.f, 448.f); }
                        int a = __builtin_amdgcn_cvt_pk_fp8_f32(v0[0], v0[1], 0, false); a = __builtin_amdgcn_cvt_pk_fp8_f32(v0[2], v0[3], a, true);
                        int b = __builtin_amdgcn_cvt_pk_fp8_f32(v1[0], v1[1], 0, false); b = __builtin_amdgcn_cvt_pk_fp8_f32(v1[2], v1[3], b, true);
                        w[mm][0] = a; w[mm][1] = b; }
                    const int s0 = odd ? w[0][0] : w[1][0], s1 = odd ? w[0][1] : w[1][1];
                    const int g0 = __shfl_xor(s0, 16), g1 = __shfl_xor(s1, 16);
                    const int k0 = odd ? w[1][0] : w[0][0], k1 = odd ? w[1][1] : w[0][1];
                    const u32x4 o = odd ? (u32x4){(unsigned)g0, (unsigned)g1, (unsigned)k0, (unsigned)k1} : (u32x4){(unsigned)k0, (unsigned)k1, (unsigned)g0, (unsigned)g1};
                    if (r < u.nvalid) *(u32x4*)(O + (size_t)(u.orow0 + r) * D + col0 + bj * HALF) = o;
                }
            }
    }
};
__device__ __forceinline__ void phase_combine(const Frame& F, int l, int nrows, bf16_t* X, const float* MODl, const unsigned char* Y, float* out_final, const float* gfin,
                                              bf16_t* nxtA, const float* nxt_g, const float* nxt_MOD) {
    const MoeTables mt = moe_tables(F, l);
    const int gw = F.vcu * NWAVES + F.wave, NGW = F.G * NWAVES, lane = F.lane;
    if (nxtA && gw == 0) { GAS u32x4* z = (GAS u32x4*)(nxtA + (size_t)ZROW * D); z[lane] = (u32x4){0u, 0u, 0u, 0u}; z[lane + 64] = (u32x4){0u, 0u, 0u, 0u}; }
    const int* dest = (const int*)(F.ws + O_ROUTE + R_DEST); const float* gtk = (const float*)(F.ws + O_ROUTE + R_GTK);
    int dvn = 0; float gvn = 0.f;
    if (gw < nrows) { dvn = dest[gw * 8 + (lane & 7)]; gvn = gtk[gw * 8 + (lane & 7)]; }
    for (int row = gw; row < nrows; row += NGW) {
        const int dv = dvn; const float gv = gvn;
        if (row + NGW < nrows) { dvn = dest[(row + NGW) * 8 + (lane & 7)]; gvn = gtk[(row + NGW) * 8 + (lane & 7)]; }
        const int sl = mt.off[(dv >> 20) & 63] + (dv & 0xfffff);
        float s[16];
#pragma unroll
        for (int i = 0; i < 16; ++i) s[i] = 0.f;
#pragma unroll
        for (int k = 0; k < 8; ++k) {
            const int slot = __builtin_amdgcn_readlane(sl, k);
            const float gk = __builtin_bit_cast(float, __builtin_amdgcn_readlane(__builtin_bit_cast(int, gv), k));
            const u32x4 a = *(const u32x4*)(Y + (size_t)slot * D + 16 * lane);
            const float gs = gk * YINV;
#pragma unroll
            for (int j = 0; j < 4; ++j) { const f32x2 lo = __builtin_amdgcn_cvt_pk_f32_fp8((int)a[j], false), hi = __builtin_amdgcn_cvt_pk_f32_fp8((int)a[j], true);
                s[4 * j] += gs * lo.x; s[4 * j + 1] += gs * lo.y; s[4 * j + 2] += gs * hi.x; s[4 * j + 3] += gs * hi.y; }
        }
        {
            const u32x4 a = *(const u32x4*)(Y + (size_t)(SH_SLOT0 + row) * D + 16 * lane);
#pragma unroll
            for (int j = 0; j < 4; ++j) { const f32x2 lo = __builtin_amdgcn_cvt_pk_f32_fp8((int)a[j], false), hi = __builtin_amdgcn_cvt_pk_f32_fp8((int)a[j], true);
                s[4 * j] += YINV * lo.x; s[4 * j + 1] += YINV * lo.y; s[4 * j + 2] += YINV * hi.x; s[4 * j + 3] += YINV * hi.y; }
        }
        const float* g5 = MODl + (size_t)ci_of_row(row) * 6144 + 5 * D + 16 * lane;
        bf16_t* xp = X + (size_t)row * D + 16 * lane;
        const u32x4 xw0 = *(const u32x4*)xp, xw1 = *(const u32x4*)(xp + 8);
        const unsigned xwu[8] = {xw0.x, xw0.y, xw0.z, xw0.w, xw1.x, xw1.y, xw1.z, xw1.w};
        f32x4 xv[4]; float ss = 0.f;
#pragma unroll
        for (int j = 0; j < 4; ++j) { const f32x4 g = *(const f32x4*)(g5 + 4 * j);
            const unsigned wa = xwu[2 * j], wb = xwu[2 * j + 1];
            f32x4 x = (f32x4){bflo(wa), bfhi(wa), bflo(wb), bfhi(wb)};
            x[0] += g[0] * s[4 * j]; x[1] += g[1] * s[4 * j + 1]; x[2] += g[2] * s[4 * j + 2]; x[3] += g[3] * s[4 * j + 3]; xv[j] = x;
            ss += (x[0] * x[0] + x[1] * x[1]) + (x[2] * x[2] + x[3] * x[3]); }
        if (out_final) {
            const float rstd = rsqrtf(wave_sum(ss) * (1.f / D) + EPS);
#pragma unroll
            for (int j = 0; j < 4; ++j) { const f32x4 g = *(const f32x4*)(gfin + 16 * lane + 4 * j); *(f32x4*)(out_final + (size_t)row * D + 16 * lane + 4 * j) = xv[j] * rstd * g; }
        } else {
            { u32x4 o0, o1; o0.x = cvt_pk_bf16(xv[0][0], xv[0][1]); o0.y = cvt_pk_bf16(xv[0][2], xv[0][3]); o0.z = cvt_pk_bf16(xv[1][0], xv[1][1]); o0.w = cvt_pk_bf16(xv[1][2], xv[1][3]);
              o1.x = cvt_pk_bf16(xv[2][0], xv[2][1]); o1.y = cvt_pk_bf16(xv[2][2], xv[2][3]); o1.z = cvt_pk_bf16(xv[3][0], xv[3][1]); o1.w = cvt_pk_bf16(xv[3][2], xv[3][3]);
              *(u32x4*)xp = o0; *(u32x4*)(xp + 8) = o1; }
            if (nxtA) {
                const float rstd = rsqrtf(wave_sum(ss) * (1.f / D) + EPS);
                const float* sh = nxt_MOD + (size_t)ci_of_row(row) * 6144 + 16 * lane;
                u32x4 o[2];
#pragma unroll
                for (int j = 0; j < 4; ++j) { const f32x4 g = *(const f32x4*)(nxt_g + 16 * lane + 4 * j), s0 = *(const f32x4*)(sh + 4 * j), c0 = *(const f32x4*)(sh + D + 4 * j);
                    const f32x4 h = xv[j] * rstd * g * (1.f + c0) + s0;
                    o[j >> 1][(j & 1) * 2] = pk2(h[0], h[1]); o[j >> 1][(j & 1) * 2 + 1] = pk2(h[2], h[3]); }
                *(u32x4*)(nxtA + (size_t)row * D + 16 * lane) = o[0]; *(u32x4*)(nxtA + (size_t)row * D + 16 * lane + 8) = o[1];
            }
        }
    }
}
__device__ __forceinline__ void phase_moe_up(const Frame& F, const In& in, int l, int nrows) {
    const MoeTables mt = moe_tables(F, l);
    MoeUpSched S{mt, (const char*)(F.ws + O_WGU), (const char*)(F.ws + O_WSGU) + (size_t)l * 512 * D, (const int*)(F.ws + O_ROUTE + R_LIST), F.G, F.vcu, nrows / 256};
    EpiSwigluMoe E{F.ws + O_ACT, F.ws + O_ACTS};
    gemm_phase<EpiSwigluMoe, MoeUpSched, 1, 124>(F.lds, (const char*)(F.ws + O_A2), D, S, E);
    if (l == 0) {
        const int nu = 2 * __builtin_amdgcn_readfirstlane(mt.tp[64]) + 2 * (nrows / 256), rem = nu % F.G;
        __syncthreads();
        phase_cvt_down(F, in, 1, rem, F.G - rem);
    }
}
__device__ __forceinline__ void phase_moe_down(const Frame& F, const In& in, int l, int nrows) {
    const MoeTables mt = moe_tables(F, l);
    MoeDownSched S{mt, (const char*)(F.ws + (l == 0 ? O_WD : O_WD1)), (const char*)(F.ws + O_WSD) + (size_t)l * D * 256, F.G, F.vcu, nrows / 256};
    EpiFp8 E{F.ws + O_Y};
    gemm_phase<EpiFp8, MoeDownSched, 1, 127>(F.lds, (const char*)(F.ws + O_ACT), 256, S, E);
    if (l == 0) {
        const int nu = 4 * __builtin_amdgcn_readfirstlane(mt.tp[64]) + 4 * (nrows / 256), rem = nu % F.G;
        __syncthreads();
        cvt_wgu_part(F, in, 1, 0, CVT32_ITEMS / 3, rem, F.G - rem, 0);
    }
}
__device__ __forceinline__ f32x2 gelu_pk(f32x2 v) {
    const f32x2 av = __builtin_elementwise_abs(v), d = av * 0.2316418882f + 1.0f;
    f32x2 t; t.x = __builtin_amdgcn_rcpf(d.x); t.y = __builtin_amdgcn_rcpf(d.y);
    f32x2 q = t * 0.5307027145f + (-0.7265760135f); q = q * t + 0.7107068705f; q = q * t + (-0.142248368f); q = q * t + 0.127414796f; q = q * t;
    const f32x2 s = (v * v) * (-0.72134752044f);
    f32x2 e; e.x = __builtin_amdgcn_exp2f(s.x); e.y = __builtin_amdgcn_exp2f(s.y);
    const f32x2 m = v * (q * e), r = v - m;
    f32x2 o; o.x = v.x < 0.f ? m.x : r.x; o.y = v.y < 0.f ? m.y : r.y; return o;
}
struct EpiZ {
    static constexpr bool PERM = true;
    bf16_t* O; int ldc, n_gelu, s_lo, s_hi;
    __device__ __forceinline__ void operator()(const Acc& acc, const GUnit& u, int wr, int wc, int fr, int fq) const {
        const int col0 = u.pn * BM + wc * 32 + 8 * fq;
        const int mode = u.pn < n_gelu ? 1 : ((u.pn >= s_lo && u.pn < s_hi) ? 2 : 0);
#pragma unroll
        for (int ai = 0; ai < 2; ++ai)
#pragma unroll
            for (int m = 0; m < 4; ++m) {
                bf16_t* rowp = O + (size_t)(u.orow0 + ai * HALF + wr * 64 + m * 16 + fr) * ldc + col0;
#pragma unroll
                for (int bj = 0; bj < 2; ++bj) { f32x4 v0 = acc[ai][bj][m][0], v1 = acc[ai][bj][m][1];
                    if (mode == 1) { const f32x2 a = gelu_pk((f32x2){v0[0], v0[1]}), b = gelu_pk((f32x2){v0[2], v0[3]}), c = gelu_pk((f32x2){v1[0], v1[1]}), d = gelu_pk((f32x2){v1[2], v1[3]});
                        v0 = (f32x4){a.x, a.y, b.x, b.y}; v1 = (f32x4){c.x, c.y, d.x, d.y}; }
                    else if (mode == 2) { v0 = v0 * C2; v1 = v1 * C2; }
                    u32x4 w; w.x = cvt_pk_bf16(v0[0], v0[1]); w.y = cvt_pk_bf16(v0[2], v0[3]); w.z = cvt_pk_bf16(v1[0], v1[1]); w.w = cvt_pk_bf16(v1[2], v1[3]);
                    *(u32x4*)(rowp + bj * HALF) = w; }
            }
    }
};

__device__ __forceinline__ void phase_sg(const Frame& F, const In& in, const bf16_t* Z1, bf16_t* CAT) {
    constexpr int VTS = 272;
    LAS unsigned char* VT = F.lds;
    const bf16_t* SGW = (const bf16_t*)(F.ws + O_SGW);
    const int lane = F.lane, w = F.wave;
    for (int it = F.vcu; it < NB * 16 * 2; it += F.G) {
        const int half = it & 1, chunk = (it >> 1) & 15, b = it >> 5;
        const size_t row0 = (size_t)b * T + chunk * 128;
        const int p = 16 * w + (lane & 15), kq = lane >> 4;
        bf16x8 wf[4][4]; u32x2 uu[4][4]; float bs[4];
#pragma unroll
        for (int gl = 0; gl < 4; ++gl) { const int g = 4 * half + gl; bs[gl] = in.sg_b[g * 128 + p];
#pragma unroll
            for (int ks = 0; ks < 4; ++ks) wf[gl][ks] = *(const bf16x8*)(SGW + ((size_t)g * 128 + p) * 128 + 32 * ks + 8 * kq);
#pragma unroll
            for (int nf = 0; nf < 4; ++nf) uu[gl][nf] = *(const u32x2*)(Z1 + (row0 + p) * 2560 + g * 64 + nf * 16 + 4 * kq); }
        __syncthreads();
        float lg4[4], lb4[4];
#pragma unroll
        for (int e = 0; e < 4; ++e) { lg4[e] = in.sg_ln_g[lane + 64 * e + 256 * half]; lb4[e] = in.sg_ln_b[lane + 64 * e + 256 * half]; }
#pragma unroll 1
        for (int rb = 0; rb < 16; rb += 4) {
            float raw[4][8];
#pragma unroll
            for (int j = 0; j < 4; ++j) { const bf16_t* vr = Z1 + (row0 + 16 * w + rb + j) * 2560 + 512;
#pragma unroll
                for (int e = 0; e < 8; ++e) raw[j][e] = bf2f(vr[lane + 64 * e]); }
#pragma unroll
            for (int j = 0; j < 4; ++j) {
                const int q = 16 * w + rb + j;
                float v[8]; float s = 0.f;
#pragma unroll
                for (int e = 0; e < 8; e += 2) { const f32x2 gg = gelu_pk((f32x2){raw[j][e], raw[j][e + 1]}); v[e] = gg.x; v[e + 1] = gg.y; s += gg.x + gg.y; }
                const float mu = wave_sum(s) * (1.f / 512.f);
                float s2 = 0.f;
#pragma unroll
                for (int e = 0; e < 8; ++e) { v[e] -= mu; s2 += v[e] * v[e]; }
                const float rstd = rsqrtf(wave_sum(s2) * (1.f / 512.f) + EPS);
                if (half) {
#pragma unroll
                    for (int e = 0; e < 4; ++e) *(LAS bf16_t*)(VT + (lane + 64 * e) * VTS + q * 2) = (bf16_t)f2bf(v[e + 4] * rstd * lg4[e] + lb4[e]);
                } else {
#pragma unroll
                    for (int e = 0; e < 4; ++e) *(LAS bf16_t*)(VT + (lane + 64 * e) * VTS + q * 2) = (bf16_t)f2bf(v[e] * rstd * lg4[e] + lb4[e]);
                }
            }
        }
        __syncthreads();
#pragma unroll
        for (int gl = 0; gl < 4; ++gl) {
            const int g = 4 * half + gl;
            f32x4 acc[4];
#pragma unroll
            for (int nf = 0; nf < 4; ++nf) acc[nf] = (f32x4){0.f, 0.f, 0.f, 0.f};
#pragma unroll
            for (int ks = 0; ks < 4; ++ks)
#pragma unroll
                for (int nf = 0; nf < 4; ++nf) {
                    const bf16x8 vf = *(const LAS bf16x8*)(VT + (gl * 64 + nf * 16 + (lane & 15)) * VTS + (32 * ks + 8 * kq) * 2);
                    acc[nf] = __builtin_amdgcn_mfma_f32_16x16x32_bf16(vf, wf[gl][ks], acc[nf], 0, 0, 0);
                }
#pragma unroll
            for (int nf = 0; nf < 4; ++nf) {
                const int c = g * 64 + nf * 16 + 4 * kq;
                const f32x2 u01 = gelu_pk((f32x2){bflo(uu[gl][nf].x), bfhi(uu[gl][nf].x)}), u23 = gelu_pk((f32x2){bflo(uu[gl][nf].y), bfhi(uu[gl][nf].y)});
                u32x2 o; o.x = pk2(u01.x * (acc[nf][0] + bs[gl]), u01.y * (acc[nf][1] + bs[gl])); o.y = pk2(u23.x * (acc[nf][2] + bs[gl]), u23.y * (acc[nf][3] + bs[gl]));
                *(u32x2*)(CAT + (row0 + p) * D + c) = o;
            }
        }
    }
    __syncthreads();
}

struct NaHook {
    const LAS float* rpbl;
    int nA, rs_lo, r, c, hi; unsigned vmask;
    __device__ __forceinline__ void init() {
        const int cs = min(max(c - 8, 0), 48); unsigned m = 0u;
#pragma unroll
        for (int i = 0; i < 16; ++i) { const int kc = ab::crow(i, hi); if (kc >= cs && kc < cs + 16) m |= 1u << i; if (kc + 32 >= cs && kc + 32 < cs + 16) m |= 1u << (16 + i); }
        vmask = m;
    }
    __device__ __forceinline__ void operator()(ab::f32x16& p0, ab::f32x16& p1, int t) const {
        if (t < nA) return;
        const int R = rs_lo + (t - nA);
        const int rs = min(max(r - 4, 0), 24);
        if (R < rs || R >= rs + 8) {
#pragma unroll
            for (int i = 0; i < 16; ++i) { p0[i] = -INFINITY; p1[i] = -INFINITY; }
            return;
        }
        const LAS float* tb = rpbl + ((R - r + 7) * 31 - c + 15 + 4 * hi);
#pragma unroll
        for (int i0 = 0; i0 < 16; i0 += 8) {
            float b[8];
#pragma unroll
            for (int i = 0; i < 8; ++i) b[i] = tb[((i0 + i) & 3) + 8 * ((i0 + i) >> 2)];
#pragma unroll
            for (int i = 0; i < 8; ++i) p0[i0 + i] = ((vmask >> (i0 + i)) & 1u) ? p0[i0 + i] + b[i] : -INFINITY;
            asm volatile("" ::: "memory");
#pragma unroll
            for (int i = 0; i < 8; ++i) b[i] = tb[32 + ((i0 + i) & 3) + 8 * ((i0 + i) >> 2)];
#pragma unroll
            for (int i = 0; i < 8; ++i) p1[i0 + i] = ((vmask >> (16 + i0 + i)) & 1u) ? p1[i0 + i] + b[i] : -INFINITY;
            asm volatile("" ::: "memory");
        }
    }
};
__device__ __forceinline__ void phase_na(const Frame& F, const In& in, char* shm, const bf16_t* Z1, bf16_t* CAT) {
    LAS float* rpbl = (LAS float*)(F.lds + LDSX_OFF + 4096);
    constexpr int CV0 = (2 * CVT32_ITEMS) / 3;
    if ((F.vcu & 1) == 0) cvt_wgu_part(F, in, 1, CV0, CVT32_ITEMS, 0, F.G, ATTN_CVT_SCR);
    for (int u = F.vcu; u < 512; u += F.G) {
        const int rg = u & 7, h = (u >> 3) & 7, b = u >> 6, r0 = 4 * rg;
        const int rs_lo = min(max(r0 - 4, 0), 24);
        const int nnb = (rg == 0 || rg == 7) ? 8 : 12;
        __syncthreads();
        for (int i = F.tid; i < 15 * 31; i += NTHREADS) rpbl[i] = in.na_rpb[h * 465 + i] * 1.4426950408889634f;
        __syncthreads();
        const size_t row0 = (size_t)b * T + r0 * 64;
        ab::TileMap tm{4, NLAT + b * NC, b * T + rs_lo * 64};
        NaHook hook{rpbl, 4, rs_lo, r0 + (F.wave >> 1), (F.wave & 1) * 32 + (F.lane & 31), F.lane >> 5, 0u}; hook.init();
        ab::attn_unit<8, NaHook>(Z1 + row0 * 2560 + 1024 + h * 64, 2560, Z1 + 1536 + h * 64, Z1 + 2048 + h * 64, 2560, tm, 4 + nnb,
                                 CAT + row0 * D + 512 + h * 64, D, shm, hook);
    }
    if (F.vcu & 1) { __syncthreads(); cvt_wgu_part(F, in, 1, CV0, CVT32_ITEMS, 0, F.G, ATTN_CVT_SCR); }
}

__device__ __forceinline__ void phase_adaln(const Frame& F, const In& in, float* MOD) {
    LAS float* sc = (LAS float*)F.lds;
    LAS float* red = sc + 9 * 1024;
    for (int i = F.tid; i < 9 * 1024; i += NTHREADS) { const float x = i < 8 * 1024 ? in.c[i] : in.c_ctx[i - 8 * 1024]; sc[i] = x / (1.f + __expf(-x)); }
    __syncthreads();
    const int ks = F.tid >> 6, cl = F.tid & 63;
    for (int it = F.vcu; it < 2 * 96; it += F.G) {
        const int l = it / 96, c0 = (it % 96) * 64;
        const float* w = in.w_ada + (size_t)l * D * 6144 + c0 + cl;
        float acc[9];
#pragma unroll
        for (int j = 0; j < 9; ++j) acc[j] = 0.f;
#pragma unroll 8
        for (int k = ks * 128; k < ks * 128 + 128; ++k) { const float wv = w[(size_t)k * 6144];
#pragma unroll
            for (int j = 0; j < 9; ++j) acc[j] += sc[j * 1024 + k] * wv; }
        __syncthreads();
#pragma unroll
        for (int j = 0; j < 9; ++j) red[(ks * 9 + j) * 64 + cl] = acc[j];
        __syncthreads();
        for (int o = F.tid; o < 9 * 64; o += NTHREADS) { const int j = o >> 6, cc = o & 63; float s = in.b_ada[l * 6144 + c0 + cc];
#pragma unroll
            for (int q = 0; q < 8; ++q) s += red[(q * 9 + j) * 64 + cc];
            MOD[((size_t)l * 9 + j) * 6144 + c0 + cc] = s; }
    }
    __syncthreads();
}
enum Phase { PH_INIT = 0, PH_NORM0, PH_IN0, PH_PREP0, PH_ATTN0, PH_OUT0, PH_ROUTE0, PH_UP0, PH_DOWN0, PH_COMB0,
             PH_IN1, PH_MIX1, PH_OUT1, PH_ROUTE1, PH_UP1, PH_DOWN1, PH_COMB1, PH_COUNT };

__global__ void __launch_bounds__(NTHREADS, 2) mk_fwd(Args args) {
    extern __shared__ __attribute__((aligned(16))) unsigned char lds_raw[];
    Frame F;
    F.lds = (LAS unsigned char*)lds_raw; F.ws = args.ws;
    F.tid = threadIdx.x; F.lane = F.tid & 63; F.wave = __builtin_amdgcn_readfirstlane(F.tid >> 6);
    F.G = gridDim.x; { const int bx = blockIdx.x; F.vcu = (F.G % 8 == 0) ? (bx % 8) * (F.G / 8) + bx / 8 : bx; }
    volatile LAS unsigned* MISC = (volatile LAS unsigned*)(F.lds + MISC_OFF);
    for (int u = F.tid; u < (LDS_BYTES - MISC_OFF) / 4; u += NTHREADS) ((LAS unsigned*)(F.lds + MISC_OFF))[u] = 0u;
    __syncthreads();
    gu32* ctl = (gu32*)(args.ws + O_CTL);
    const bool multi = (args.ph_hi - args.ph_lo) > 1;
    XcdBarrier bar; bar.bar = (unsigned*)(ctl + CW_BAR) + args.li * XCD_BAR_WORDS; bar.x = 0; bar.st = nullptr;
    if (multi) bar = xcd_barrier_post((unsigned*)(ctl + CW_BAR) + args.li * XCD_BAR_WORDS, MISC + 8);
    typedef const __attribute__((address_space(4))) Args* ArgK;
    ArgK argp = (ArgK)__builtin_amdgcn_kernarg_segment_ptr();
    const int lo = args.ph_lo, hi = args.ph_hi;
    const bool dummy = args.pad != 0;
#define IN(k) (lo <= (k) && (k) < hi)
#define SEAM(k) do { if (IN((k) + 1)) xcd_barrier(bar); } while (0)

#if defined(__HIP_DEVICE_COMPILE__)
#define LOADARGS_() const Args al = *argp
#else
#define LOADARGS_() const Args al = args
#endif
#define LOADIN() LOADARGS_(); const In& inl = al.in; F.ws = al.ws; \
    float* const MOD = (float*)(al.ws + O_MOD); bf16_t* const X = (bf16_t*)(al.ws + O_X); \
    bf16_t* const A = (bf16_t*)(al.ws + O_A); bf16_t* const Z = (bf16_t*)(al.ws + O_Z); bf16_t* const CAT = (bf16_t*)(al.ws + O_CAT); \
    const float* const ZEROG = (const float*)(al.ws + O_CTL + 512 * 1024); (void)MOD; (void)X; (void)A; (void)Z; (void)CAT; (void)ZEROG
    if (IN(PH_INIT)) { LOADIN(); phase_adaln(F, inl, MOD); phase_cvt_mixer(F, inl); SEAM(PH_INIT); }
#define RELAUNDER() do { int t_ = threadIdx.x; asm volatile("" : "+v"(t_)); F.tid = t_; F.lane = t_ & 63; F.wave = __builtin_amdgcn_readfirstlane(t_ >> 6); int v_ = F.vcu; asm volatile("" : "+s"(v_)); F.vcu = v_; argp = (ArgK)__builtin_amdgcn_kernarg_segment_ptr(); asm volatile("" : "+s"(argp)); } while (0)
#define PH_IN(l, p1) \
    if (IN(p1)) { RELAUNDER(); LOADIN(); \
        DenseSched S{(const char*)(al.ws + (l == 0 ? O_WINAB : O_WINCD)), D, NR / 256, l == 0 ? 7 : 10, F.G, F.vcu, l == 0 ? NR / 256 : NLAT / 256, l == 0 ? 0 : 6}; \
        EpiZ E{Z, l == 0 ? 1792 : 2560, 0, 4, l == 0 ? 0 : 6}; \
        gemm_phase(F.lds, (const char*)A, D, S, E); \
        if (l == 1) { const int nu_ = 64 * 10 + 8 * 4, rem_ = nu_ % F.G; __syncthreads(); cvt_wgu_part(F, inl, 1, CVT32_ITEMS / 3, (2 * CVT32_ITEMS) / 3, rem_, F.G - rem_, 0); }     \
        SEAM(p1); }
#define PH_OUT_MOE(l, pb, nrows) \
    if (IN(pb)) { RELAUNDER(); LOADIN(); \
        const int gg_ = (l == 0 && F.G == 256) ? 144 : F.G;     \
        DenseSched S{(const char*)(al.ws + (l == 0 ? O_WOUTAB : O_WOUTCD)), D, (nrows) / 256, D / 256, gg_, F.vcu, (nrows) / 256, 0}; \
        EpiResid E{inl.x, inl.ctx, l == 0 ? nullptr : X, X, ((dummy && l == 1) ? ZEROG : MOD + (size_t)l * 9 * 6144) + 2 * D}; \
        gemm_phase(F.lds, (const char*)CAT, D, S, E); \
        if (l == 0) { __syncthreads(); const int c0_ = F.G == 256 ? 144 : 0; phase_cvt_down(F, inl, 0, c0_, F.G - c0_); __syncthreads(); cvt_wgu_part(F, inl, 0, 0, CVT32_ITEMS, c0_, F.G - c0_, 0); }     \
        SEAM(pb); } \
    if (IN(pb + 1)) { RELAUNDER(); LOADIN(); \
        const int ng_ = (nrows) / 16; const int g0 = (int)(((long)F.vcu * ng_) / F.G), g1 = (int)(((long)(F.vcu + 1) * ng_) / F.G); \
        phase_route(F, inl, l, g0, g1, X, MOD + (size_t)l * 9 * 6144, al.ws + O_A2, dummy);     \
        SEAM(pb + 1); } \
    if (IN(pb + 2)) { RELAUNDER(); LOADIN(); phase_moe_up(F, inl, l, nrows); SEAM(pb + 2); } \
    if (IN(pb + 3)) { RELAUNDER(); LOADIN(); phase_moe_down(F, inl, l, nrows); SEAM(pb + 3); } \
    if (IN(pb + 4)) { RELAUNDER(); LOADIN(); phase_combine(F, l, nrows, X, dummy ? ZEROG : MOD + (size_t)l * 9 * 6144, (const unsigned char*)(al.ws + O_Y), l == 1 ? al.out : nullptr, inl.g_final, l == 0 ? A : nullptr, inl.norm_g + 2 * D, MOD + (size_t)9 * 6144); \
        SEAM(pb + 4); }

    if (IN(PH_NORM0)) { RELAUNDER(); LOADIN(); phase_normmod(F, inl.x, inl.ctx, inl.norm_g, MOD, 0, A, NR); SEAM(PH_NORM0); }
    PH_IN(0, PH_IN0)
    if (IN(PH_PREP0)) { RELAUNDER(); LOADIN();
        phase_conv0(F, inl, Z, CAT);
        if (!dummy) phase_qkv0(F, inl, Z, (bf16_t*)(al.ws + O_Q), (bf16_t*)(al.ws + O_K), (bf16_t*)(al.ws + O_V));
        SEAM(PH_PREP0); }
    if (IN(PH_ATTN0)) { RELAUNDER(); LOADIN();
        phase_attn0(F, inl, (char*)lds_raw, (const bf16_t*)(al.ws + O_Q), (const bf16_t*)(al.ws + O_K), (const bf16_t*)(al.ws + O_V), CAT);
        SEAM(PH_ATTN0); }
    PH_OUT_MOE(0, PH_OUT0, NR)
    PH_IN(1, PH_IN1)
    if (IN(PH_MIX1)) { RELAUNDER(); LOADIN(); phase_sg(F, inl, Z, CAT); phase_na(F, inl, (char*)lds_raw, Z, CAT); SEAM(PH_MIX1); }
    PH_OUT_MOE(1, PH_OUT1, NLAT)
#undef IN
#undef SEAM
}

static int g_grid = 0;
inline bool mk_init() {
    if (g_grid != 0) return g_grid > 0;
    int dev = 0, cus = 0, per_cu = 0;
    if (hipGetDevice(&dev) != hipSuccess || hipDeviceGetAttribute(&cus, hipDeviceAttributeMultiprocessorCount, dev) != hipSuccess) { g_grid = -1; return false; }
    if (hipFuncSetAttribute((const void*)mk_fwd, hipFuncAttributeMaxDynamicSharedMemorySize, LDS_BYTES) != hipSuccess) { fprintf(stderr, "hipFuncSetAttribute failed\n"); g_grid = -1; return false; }
    if (hipOccupancyMaxActiveBlocksPerMultiprocessor(&per_cu, (const void*)mk_fwd, NTHREADS, LDS_BYTES) != hipSuccess || per_cu < 1) { fprintf(stderr, "occupancy query: %d\n", per_cu); (void)hipGetLastError(); per_cu = 1; }
    if (cus != 256) { fprintf(stderr, "kernel_launch: built for a 256-CU MI355X (one workgroup per CU); this device reports %d CUs; nothing launched\n", cus); g_grid = -1; return false; }
    g_grid = cus;
    return true;
}
inline void mk_launch(hipStream_t st, const In& in, float* out, unsigned char* ws, int lo, int hi, int li, int dummy = 0) {
    Args a{}; a.in = in; a.out = out; a.ws = ws; a.ph_lo = lo; a.ph_hi = hi; a.li = li; a.pad = dummy;
    hipLaunchKernelGGL(mk_fwd, dim3(g_grid), dim3(NTHREADS), LDS_BYTES, st, a);
}
}
extern "C" void kernel_launch(void* const* d_in, const int* in_sizes, int n_in, void* d_out, int out_size, void* d_ws, size_t ws_size, hipStream_t stream) {
    if (n_in != 31 || ws_size < mk::O_END) { fprintf(stderr, "kernel_launch: unexpected n_in %d / ws %zu\n", n_in, ws_size); return; }
    if (!mk::mk_init()) return;
    mk::In min; const float** q = (const float**)&min;
    for (int i = 0; i < 31; ++i) q[i] = (const float*)d_in[i];
    unsigned char* ws = (unsigned char*)d_ws;
    (void)hipMemsetAsync(ws + mk::O_CTL, 0, 1 << 20, stream);
    mk::mk_launch(stream, min, (float*)d_out, ws, 0, mk::PH_COUNT, 0);
}
```
